# Optimizing an MI355X kernel written in HIP

```python
import math
import jax, jax.numpy as jnp
from jax import lax
import numpy as np

D_MODEL = 2048
BATCH = 8
SEQ = 2048
DEPTH = 2

CHUNK = 64
D_FF = 5632
CONV_K = 4
RMS_EPS = 1e-6

GDN_HEADS = 6
GDN_DK = 128
GDN_DV = 128
GDN_QK = GDN_HEADS * GDN_DK
GDN_V = GDN_HEADS * GDN_DV
GDN_QKV = 2 * GDN_QK + GDN_V
GDN_IN = GDN_QKV + GDN_V + 2 * GDN_HEADS

SSD_HEADS = 12
SSD_HEAD_DIM = 64
SSD_GROUPS = 2
SSD_STATE = 128
SSD_HPG = SSD_HEADS // SSD_GROUPS
SSD_INNER = SSD_HEADS * SSD_HEAD_DIM
SSD_BC = SSD_GROUPS * SSD_STATE
SSD_CONV_DIM = SSD_INNER + 2 * SSD_BC
SSD_IN = SSD_INNER + SSD_CONV_DIM + SSD_HEADS

S5_WIDTH = 512
S5_GROUP = 16
S5_GROUPS = S5_WIDTH // S5_GROUP
S5_STATE = 64

D_MIX = GDN_V + SSD_INNER + S5_WIDTH
P_IN = GDN_IN + SSD_IN + S5_WIDTH

kernel_name = "hybrid_gdn_ssd_s5_macaron"


def rms_norm(x, w):
    xf = x.astype(jnp.float32)
    y = xf * lax.rsqrt(jnp.mean(xf * xf, axis=-1, keepdims=True) + RMS_EPS)
    return (y * w.astype(jnp.float32)).astype(x.dtype)


def l2_norm(x):
    return x * lax.rsqrt(jnp.sum(x * x, axis=-1, keepdims=True) + RMS_EPS)


def causal_dwconv(x, w):
    k = w.shape[0]
    seqlen = x.shape[1]
    xp = jnp.pad(x, ((0, 0), (k - 1, 0), (0, 0)))
    out = xp[:, 0:seqlen] * w[0]
    for i in range(1, k):
        out = out + xp[:, i:i + seqlen] * w[i]
    return out


def swiglu(x, w_gate, w_up, w_down):
    return (jax.nn.silu(x @ w_gate) * (x @ w_up)) @ w_down


def causal_decay(G):
    mask = jnp.tril(jnp.ones((CHUNK, CHUNK), dtype=bool))
    diff = G[..., :, None] - G[..., None, :]
    return jnp.where(mask, jnp.exp(jnp.where(mask, diff, 0.0)), 0.0)


def gated_deltanet(proj, conv_w, a_log, dt_bias, norm_w):
    f32 = jnp.float32
    bsz, seqlen, _ = proj.shape
    n = seqlen // CHUNK
    qkv, z, b_raw, a_raw = jnp.split(proj, [GDN_QKV, GDN_QKV + GDN_V, GDN_QKV + GDN_V + GDN_HEADS], axis=-1)
    qkv = jax.nn.silu(causal_dwconv(qkv, conv_w)).astype(f32)
    q, k, v = jnp.split(qkv, [GDN_QK, 2 * GDN_QK], axis=-1)
    q = l2_norm(q.reshape(bsz, seqlen, GDN_HEADS, GDN_DK)) * (GDN_DK ** -0.5)
    k = l2_norm(k.reshape(bsz, seqlen, GDN_HEADS, GDN_DK))
    v = v.reshape(bsz, seqlen, GDN_HEADS, GDN_DV)
    beta = jax.nn.sigmoid(b_raw.astype(f32))
    g = -jnp.exp(a_log.astype(f32)) * jax.nn.softplus(a_raw.astype(f32) + dt_bias.astype(f32))

    def chunks4(t):
        return t.reshape(bsz, n, CHUNK, GDN_HEADS, -1).transpose(0, 3, 1, 2, 4)

    def chunks3(t):
        return t.reshape(bsz, n, CHUNK, GDN_HEADS).transpose(0, 3, 1, 2)

    q, k, v = chunks4(q), chunks4(k), chunks4(v)
    beta, G = chunks3(beta), jnp.cumsum(chunks3(g), axis=-1)
    decay = causal_decay(G)
    kb = k * beta[..., None]
    strict = jnp.tril(jnp.ones((CHUNK, CHUNK), dtype=bool), k=-1)
    lower = jnp.where(strict, jnp.einsum('bhnid,bhnjd->bhnij', kb, k) * decay, 0.0)
    eye = jnp.eye(CHUNK, dtype=f32)
    T = lax.linalg.triangular_solve(lower + eye, jnp.broadcast_to(eye, lower.shape),
                                    left_side=True, lower=True, unit_diagonal=True)
    u = T @ (v * beta[..., None])
    w = T @ (kb * jnp.exp(G)[..., None])
    attn = jnp.einsum('bhnid,bhnjd->bhnij', q, k) * decay
    q_dec = q * jnp.exp(G)[..., None]
    G_last = G[..., -1]
    k_dec = k * jnp.exp(G_last[..., None] - G)[..., None]

    def step(S, xs):
        u_c, w_c, attn_c, q_c, k_c, gl = xs
        v_new = u_c - jnp.einsum('bhid,bhde->bhie', w_c, S)
        o = jnp.einsum('bhid,bhde->bhie', q_c, S) + jnp.einsum('bhij,bhje->bhie', attn_c, v_new)
        S = S * jnp.exp(gl)[..., None, None] + jnp.einsum('bhid,bhie->bhde', k_c, v_new)
        return S, o

    xs = tuple(jnp.moveaxis(t, 2, 0) for t in (u, w, attn, q_dec, k_dec, G_last))
    S0 = jnp.zeros((bsz, GDN_HEADS, GDN_DK, GDN_DV), f32)
    _, o = lax.scan(step, S0, xs)
    o = o.transpose(1, 0, 3, 2, 4).reshape(bsz, seqlen, GDN_HEADS, GDN_DV)
    z = z.astype(f32).reshape(bsz, seqlen, GDN_HEADS, GDN_DV)
    o = rms_norm(o, norm_w) * jax.nn.silu(z)
    return o.reshape(bsz, seqlen, GDN_V)


def mamba2_ssd(proj, conv_w, conv_b, a_log, dt_bias, d_skip, norm_w):
    f32 = jnp.float32
    bsz, seqlen, _ = proj.shape
    n = seqlen // CHUNK
    z, xbc, dt_raw = jnp.split(proj, [SSD_INNER, SSD_INNER + SSD_CONV_DIM], axis=-1)
    xbc = jax.nn.silu(causal_dwconv(xbc, conv_w) + conv_b).astype(f32)
    xs, Bm, Cm = jnp.split(xbc, [SSD_INNER, SSD_INNER + SSD_BC], axis=-1)
    dt = jax.nn.softplus(dt_raw.astype(f32) + dt_bias.astype(f32))
    A = -jnp.exp(a_log.astype(f32)).reshape(SSD_GROUPS, SSD_HPG)
    x = xs.reshape(bsz, n, CHUNK, SSD_GROUPS, SSD_HPG, SSD_HEAD_DIM)
    dtc = dt.reshape(bsz, n, CHUNK, SSD_GROUPS, SSD_HPG)
    Bc = Bm.reshape(bsz, n, CHUNK, SSD_GROUPS, SSD_STATE)
    Cc = Cm.reshape(bsz, n, CHUNK, SSD_GROUPS, SSD_STATE)
    acum = jnp.cumsum((dtc * A).transpose(0, 1, 3, 4, 2), axis=-1)
    Lm = causal_decay(acum)
    xdt = x * dtc[..., None]
    CB = jnp.einsum('bnigk,bnjgk->bngij', Cc, Bc)
    y_diag = jnp.einsum('bnghij,bnjghp->bnighp', CB[:, :, :, None] * Lm, xdt)
    decay_states = jnp.exp(acum[..., -1:] - acum).transpose(0, 1, 4, 2, 3)
    states = jnp.einsum('bnjgk,bnjghp->bnghpk', Bc, xdt * decay_states[..., None])
    chunk_decay = jnp.exp(acum[..., -1])

    def step(S, inp):
        st, dec = inp
        return S * dec[..., None, None] + st, S

    S0 = jnp.zeros((bsz, SSD_GROUPS, SSD_HPG, SSD_HEAD_DIM, SSD_STATE), f32)
    _, S_prev = lax.scan(step, S0, (jnp.moveaxis(states, 1, 0), jnp.moveaxis(chunk_decay, 1, 0)))
    S_prev = jnp.moveaxis(S_prev, 0, 1)
    y_off = jnp.einsum('bnigk,bnghpk->bnighp', Cc, S_prev) * \
        jnp.exp(acum).transpose(0, 1, 4, 2, 3)[..., None]
    y = (y_diag + y_off).reshape(bsz, seqlen, SSD_HEADS, SSD_HEAD_DIM)
    y = y + d_skip.astype(f32)[:, None] * xs.reshape(bsz, seqlen, SSD_HEADS, SSD_HEAD_DIM)
    y = y.reshape(bsz, seqlen, SSD_INNER) * jax.nn.silu(z.astype(f32))
    y = rms_norm(y.reshape(bsz, seqlen, SSD_GROUPS, SSD_INNER // SSD_GROUPS),
                 norm_w.reshape(SSD_GROUPS, SSD_INNER // SSD_GROUPS))
    return y.reshape(bsz, seqlen, SSD_INNER)


def s5_mixer(u, a_re, a_im, b_re, b_im, c_re, c_im, d_skip, log_dt, glu_w, glu_b):
    f32 = jnp.float32
    bsz, seqlen, _ = u.shape
    uf = u.astype(f32)
    ug = uf.reshape(bsz, seqlen, S5_GROUPS, S5_GROUP)
    a_re, a_im = a_re.astype(f32), a_im.astype(f32)
    b_re, b_im = b_re.astype(f32), b_im.astype(f32)
    delta = jnp.exp(log_dt.astype(f32))[:, None]
    mag = jnp.exp(a_re * delta)
    ab_re, ab_im = mag * jnp.cos(a_im * delta), mag * jnp.sin(a_im * delta)
    den = a_re * a_re + a_im * a_im
    p_re, p_im = ab_re - 1.0, ab_im
    f_re = (p_re * a_re + p_im * a_im) / den
    f_im = (p_im * a_re - p_re * a_im) / den
    bb_re = f_re[..., None] * b_re - f_im[..., None] * b_im
    bb_im = f_re[..., None] * b_im + f_im[..., None] * b_re
    bu_re = jnp.einsum('blgi,gni->blgn', ug, bb_re)
    bu_im = jnp.einsum('blgi,gni->blgn', ug, bb_im)
    shape = bu_re.shape
    elems = (jnp.broadcast_to(ab_re, shape), jnp.broadcast_to(ab_im, shape), bu_re, bu_im)

    def combine(e1, e2):
        a1r, a1i, b1r, b1i = e1
        a2r, a2i, b2r, b2i = e2
        return (a2r * a1r - a2i * a1i, a2r * a1i + a2i * a1r,
                a2r * b1r - a2i * b1i + b2r, a2r * b1i + a2i * b1r + b2i)

    _, _, h_re, h_im = lax.associative_scan(combine, elems, axis=1)
    y = jnp.einsum('blgn,gin->blgi', h_re, c_re.astype(f32)) - \
        jnp.einsum('blgn,gin->blgi', h_im, c_im.astype(f32))
    y = y.reshape(bsz, seqlen, S5_WIDTH) + d_skip.astype(f32) * uf
    g = jax.nn.gelu(y)
    return g * jax.nn.sigmoid(g @ glu_w.astype(f32) + glu_b.astype(f32))


def setup_inputs(seed: int = 0) -> dict:
    key = jax.random.key(seed)
    ks = iter(jax.random.split(key, 48))
    f32 = jnp.float32
    L = DEPTH

    def nrm(shape, scale):
        return jax.random.normal(next(ks), shape, f32) * scale

    def gain(shape):
        return 1.0 + nrm(shape, 0.02)

    def unif(shape, lo, hi):
        return jax.random.uniform(next(ks), shape, f32, lo, hi)

    def dt_bias(shape):
        dt = jnp.exp(unif(shape, math.log(1e-3), math.log(1e-1)))
        return dt + jnp.log(-jnp.expm1(-dt))

    return {
        'x': nrm((BATCH, SEQ, D_MODEL), 1.0),
        'ffn1_norm': gain((L, D_MODEL)),
        'ffn1_w_gate': nrm((L, D_MODEL, D_FF), D_MODEL ** -0.5),
        'ffn1_w_up': nrm((L, D_MODEL, D_FF), D_MODEL ** -0.5),
        'ffn1_w_down': nrm((L, D_FF, D_MODEL), D_FF ** -0.5),
        'mix_norm': gain((L, D_MODEL)),
        'w_in': nrm((L, D_MODEL, P_IN), D_MODEL ** -0.5),
        'gdn_conv_w': nrm((L, CONV_K, GDN_QKV), CONV_K ** -0.5),
        'gdn_a_log': jnp.log(unif((L, GDN_HEADS), 1.0, 16.0)),
        'gdn_dt_bias': dt_bias((L, GDN_HEADS)),
        'gdn_norm': gain((L, GDN_DV)),
        'ssd_conv_w': nrm((L, CONV_K, SSD_CONV_DIM), CONV_K ** -0.5),
        'ssd_conv_b': nrm((L, SSD_CONV_DIM), 0.01),
        'ssd_a_log': jnp.log(unif((L, SSD_HEADS), 1.0, 16.0)),
        'ssd_dt_bias': dt_bias((L, SSD_HEADS)),
        'ssd_d': gain((L, SSD_HEADS)),
        'ssd_norm': gain((L, SSD_INNER)),
        's5_a_re': -0.5 + nrm((L, S5_GROUPS, S5_STATE), 0.01),
        's5_a_im': jnp.pi * jnp.arange(S5_STATE, dtype=f32) + nrm((L, S5_GROUPS, S5_STATE), 0.01),
        's5_b_re': nrm((L, S5_GROUPS, S5_STATE, S5_GROUP), (2.0 * S5_GROUP) ** -0.5),
        's5_b_im': nrm((L, S5_GROUPS, S5_STATE, S5_GROUP), (2.0 * S5_GROUP) ** -0.5),
        's5_c_re': nrm((L, S5_GROUPS, S5_GROUP, S5_STATE), S5_STATE ** -0.5),
        's5_c_im': nrm((L, S5_GROUPS, S5_GROUP, S5_STATE), S5_STATE ** -0.5),
        's5_d': nrm((L, S5_WIDTH), 1.0),
        's5_log_dt': unif((L, S5_GROUPS), math.log(1e-3), math.log(1e-1)),
        's5_glu_w': nrm((L, S5_WIDTH, S5_WIDTH), S5_WIDTH ** -0.5),
        's5_glu_b': nrm((L, S5_WIDTH), 0.01),
        'w_out': nrm((L, D_MIX, D_MODEL), D_MIX ** -0.5),
        'ffn2_norm': gain((L, D_MODEL)),
        'ffn2_w_gate': nrm((L, D_MODEL, D_FF), D_MODEL ** -0.5),
        'ffn2_w_up': nrm((L, D_MODEL, D_FF), D_MODEL ** -0.5),
        'ffn2_w_down': nrm((L, D_FF, D_MODEL), D_FF ** -0.5),
        'final_norm': gain((D_MODEL,)),
    }


def reference(x, ffn1_norm, ffn1_w_gate, ffn1_w_up, ffn1_w_down, mix_norm, w_in,
              gdn_conv_w, gdn_a_log, gdn_dt_bias, gdn_norm,
              ssd_conv_w, ssd_conv_b, ssd_a_log, ssd_dt_bias, ssd_d, ssd_norm,
              s5_a_re, s5_a_im, s5_b_re, s5_b_im, s5_c_re, s5_c_im, s5_d, s5_log_dt,
              s5_glu_w, s5_glu_b, w_out, ffn2_norm, ffn2_w_gate, ffn2_w_up, ffn2_w_down,
              final_norm):
    h = x
    for i in range(DEPTH):
        h = h + 0.5 * swiglu(rms_norm(h, ffn1_norm[i]), ffn1_w_gate[i], ffn1_w_up[i], ffn1_w_down[i])
        u = rms_norm(h, mix_norm[i])
        proj = u @ w_in[i]
        p_gdn, p_ssd, p_s5 = jnp.split(proj, [GDN_IN, GDN_IN + SSD_IN], axis=-1)
        o_gdn = gated_deltanet(p_gdn, gdn_conv_w[i], gdn_a_log[i], gdn_dt_bias[i], gdn_norm[i])
        o_ssd = mamba2_ssd(p_ssd, ssd_conv_w[i], ssd_conv_b[i], ssd_a_log[i], ssd_dt_bias[i],
                           ssd_d[i], ssd_norm[i])
        o_s5 = s5_mixer(p_s5, s5_a_re[i], s5_a_im[i], s5_b_re[i], s5_b_im[i], s5_c_re[i], s5_c_im[i],
                        s5_d[i], s5_log_dt[i], s5_glu_w[i], s5_glu_b[i])
        mixed = jnp.concatenate([o_gdn, o_ssd, o_s5], axis=-1).astype(h.dtype)
        h = h + mixed @ w_out[i]
        h = h + 0.5 * swiglu(rms_norm(h, ffn2_norm[i]), ffn2_w_gate[i], ffn2_w_up[i], ffn2_w_down[i])
    return rms_norm(h, final_norm)
```

```cpp
#include <hip/hip_runtime.h>
#include <hip/hip_cooperative_groups.h>
#include <cstdio>
#include <cstdint>
namespace cg = cooperative_groups;
#ifndef MK_MULTI
#define MK_MULTI 0
#endif
#ifndef MIXSEL
#define MIXSEL 7
#endif
namespace pg8 {
#define PG8_LAS __attribute__((address_space(3)))
typedef unsigned short bf16_t;
typedef short bf16x8 __attribute__((ext_vector_type(8)));
typedef float f32x4 __attribute__((ext_vector_type(4)));
typedef unsigned u32x4 __attribute__((ext_vector_type(4)));
constexpr int BM = 256, BK = 64, HALF = 128, HTB = HALF * BK * 2  , STAGE_BYTES = 8 * HTB, NXCD = 8, WGM = 8;

__host__ __device__ __forceinline__ int lds_byte(int r, int c) { const int st = (r >> 4) * 2 + (c >> 5), rr = r & 15, cc = c & 31, ob = rr * 64 + cc * 2; return st * 1024 + (ob ^ (((ob >> 9) & 1) << 5)); }
__host__ __device__ __forceinline__ void stage_rc(int b, int& R, int& C) { const int st = b / 1024, sb = b % 1024, swz = sb ^ (((sb >> 9) & 1) << 5); R = (st >> 1) * 16 + swz / 64; C = (st & 1) * 32 + (swz % 64) / 2; }
__host__ __device__ __forceinline__ int perm32(int rho) { const int n = rho >> 4, i = rho & 15; return 8 * (i >> 2) + 4 * n + (i & 3); }

struct Unit { int pm, pn; };
struct Gemm { const bf16_t* A; const bf16_t* Bt; int M, N, K; };

struct StaticOrder {
    int nM, nN, nwg, G, c;
    __host__ __device__ void init(int M, int N, int G_, int c_) { nM = M / BM; nN = N / BM; nwg = nM * nN; G = G_; c = c_; }
    __host__ __device__ bool next(int i, Unit& u) const {
        const long L = (long)i * G + c; if (L >= nwg) return false;
        int wgid = (int)L; { const int q = nwg / NXCD, r = nwg % NXCD, xcd = wgid % NXCD, off = wgid / NXCD; wgid = (xcd < r ? xcd * (q + 1) : r * (q + 1) + (xcd - r) * q) + off; }
        const int nig = WGM * nN, gid = wgid / nig, fm = gid * WGM, gsz = (nM - fm) < WGM ? (nM - fm) : WGM;
        u.pm = fm + ((wgid % nig) % gsz); u.pn = (wgid % nig) / gsz; return true;
    }
    __device__ __forceinline__ void a_ready(const Unit&) const {}
    __device__ __forceinline__ void done(const Unit&) const {}
};

typedef __bf16 bf16v2_t __attribute__((ext_vector_type(2)));
typedef float f32x2c_t __attribute__((ext_vector_type(2)));
__device__ __forceinline__ unsigned cvt_pk_bf16(float lo, float hi) { const bf16v2_t v = __builtin_convertvector((f32x2c_t){lo, hi}, bf16v2_t); return __builtin_bit_cast(unsigned, v); }
typedef float f32x2 __attribute__((ext_vector_type(2)));
typedef unsigned u32x2 __attribute__((ext_vector_type(2)));
__device__ __forceinline__ float fsilu(float x) { return x / (1.f + __expf(-x)); }
__device__ __forceinline__ float fsigmoid(float x) { return 1.f / (1.f + __expf(-x)); }
template <class Sched>
__device__ __forceinline__ void rstd_table(const Sched& S, const float* ssq, PG8_LAS float* rtab) {
    const int t = threadIdx.x, row = t >> 1, half = t & 1; unsigned done = 0u; Unit u;
    for (int i = 0; S.next(i, u); ++i) { const unsigned bit = 1u << (u.pm & 15); if (done & bit) continue; done |= bit;
        const f32x4* q = (const f32x4*)(ssq + (size_t)(u.pm * BM + row) * 32 + half * 16);
        f32x4 a = (q[0] + q[1]) + (q[2] + q[3]); float s = (a[0] + a[1]) + (a[2] + a[3]); s += __shfl_xor(s, 1);
        if (half == 0) rtab[(u.pm & 15) * 256 + row] = rsqrtf(s * (1.f / 2048.f) + 1e-6f); }
    __syncthreads();
}
struct EpiBf16 {
    static constexpr bool PERM = true, AFTER_DRAIN = false;
    bf16_t* O; int ldc; const PG8_LAS float* rtab;
    __device__ __forceinline__ void operator()(const f32x4 (&acc)[2][2][4][2], const Unit& u, int wr, int wc, int fr, int fq) const {
        const int row0 = u.pm * BM + wr * 64 + fr, col0 = u.pn * BM + wc * 32 + 8 * fq;
#pragma unroll
        for (int ai = 0; ai < 2; ++ai)
#pragma unroll
            for (int m = 0; m < 4; ++m) { bf16_t* rowp = O + (size_t)(row0 + ai * HALF + m * 16) * ldc + col0;
                const float rs = rtab[(u.pm & 15) * 256 + wr * 64 + fr + ai * HALF + m * 16];
#pragma unroll
                for (int bj = 0; bj < 2; ++bj) { const f32x4 v0 = acc[ai][bj][m][0] * rs, v1 = acc[ai][bj][m][1] * rs;
                    u32x4 w; w.x = cvt_pk_bf16(v0[0], v0[1]); w.y = cvt_pk_bf16(v0[2], v0[3]); w.z = cvt_pk_bf16(v1[0], v1[1]); w.w = cvt_pk_bf16(v1[2], v1[3]);
                    *(u32x4*)(rowp + bj * HALF) = w; } }
    }
};
struct EpiSwiGLU {
    static constexpr bool PERM = true, AFTER_DRAIN = false;
    bf16_t* O; int ldc; const PG8_LAS float* rtab;
    __device__ __forceinline__ void operator()(const f32x4 (&acc)[2][2][4][2], const Unit& u, int wr, int wc, int fr, int fq) const {
        const int row0 = u.pm * BM + wr * 64 + fr, col0 = u.pn * HALF + wc * 32 + 8 * fq;
#pragma unroll
        for (int ai = 0; ai < 2; ++ai)
#pragma unroll
            for (int m = 0; m < 4; ++m) { bf16_t* rowp = O + (size_t)(row0 + ai * HALF + m * 16) * ldc + col0;
                const float rs = rtab[(u.pm & 15) * 256 + wr * 64 + fr + ai * HALF + m * 16];
                const f32x4 g0 = acc[ai][0][m][0] * rs, g1 = acc[ai][0][m][1] * rs, u0 = acc[ai][1][m][0] * rs, u1 = acc[ai][1][m][1] * rs;
                u32x4 w; w.x = cvt_pk_bf16(fsilu(g0[0]) * u0[0], fsilu(g0[1]) * u0[1]); w.y = cvt_pk_bf16(fsilu(g0[2]) * u0[2], fsilu(g0[3]) * u0[3]);
                w.z = cvt_pk_bf16(fsilu(g1[0]) * u1[0], fsilu(g1[1]) * u1[1]); w.w = cvt_pk_bf16(fsilu(g1[2]) * u1[2], fsilu(g1[3]) * u1[3]);
                *(u32x4*)rowp = w; }
    }
};
struct EpiResid {
    static constexpr bool PERM = false, AFTER_DRAIN = false;
    const float* base; float* out; int ldc; float s;
    __device__ __forceinline__ void operator()(const f32x4 (&acc)[2][2][4][2], const Unit& u, int wr, int wc, int fr, int fq) const {
        const int row0 = u.pm * BM + wr * 64 + fr, col0 = u.pn * BM + wc * 32 + 4 * fq;
#pragma unroll
        for (int ai = 0; ai < 2; ++ai)
#pragma unroll
            for (int m = 0; m < 4; ++m) { const size_t off = (size_t)(row0 + ai * HALF + m * 16) * ldc + col0;
#pragma unroll
                for (int bj = 0; bj < 2; ++bj)
#pragma unroll
                    for (int n = 0; n < 2; ++n) { const f32x4 b = *(const f32x4*)(base + off + bj * HALF + n * 16);
                        *(f32x4*)(out + off + bj * HALF + n * 16) = b + acc[ai][bj][m][n] * s; } }
    }
};
struct EpiResidH {
    static constexpr bool PERM = false, AFTER_DRAIN = false;
    const float* basef; bf16_t* H; int ldc; float s; float* ssq;
    __device__ __forceinline__ void operator()(const f32x4 (&acc)[2][2][4][2], const Unit& u, int wr, int wc, int fr, int fq) const {
        const int row0 = u.pm * BM + wr * 64 + fr, col0 = u.pn * BM + wc * 32 + 4 * fq;
#pragma unroll
        for (int ai = 0; ai < 2; ++ai)
#pragma unroll
            for (int m = 0; m < 4; ++m) { const int row = row0 + ai * HALF + m * 16; const size_t off = (size_t)row * ldc + col0; float ss = 0.f;
#pragma unroll
                for (int bj = 0; bj < 2; ++bj)
#pragma unroll
                    for (int n = 0; n < 2; ++n) { const int co = bj * HALF + n * 16; f32x4 b;
                        if (basef) b = *(const f32x4*)(basef + off + co);
                        else { const u32x2 hb = *(const u32x2*)(H + off + co); b[0] = __uint_as_float(hb.x << 16); b[1] = __uint_as_float(hb.x & 0xffff0000u); b[2] = __uint_as_float(hb.y << 16); b[3] = __uint_as_float(hb.y & 0xffff0000u); }
                        const f32x4 o = b + acc[ai][bj][m][n] * s;
                        ss += (o[0] * o[0] + o[1] * o[1]) + (o[2] * o[2] + o[3] * o[3]);
                        u32x2 q; q.x = cvt_pk_bf16(o[0], o[1]); q.y = cvt_pk_bf16(o[2], o[3]);
                        *(u32x2*)(H + off + co) = q; }
                ss += __shfl_xor(ss, 16); ss += __shfl_xor(ss, 32);
                if (fq == 0) ssq[(size_t)row * 32 + u.pn * 4 + wc] = ss; }
    }
};
struct EpiResidOut {
    static constexpr bool PERM = false, AFTER_DRAIN = false;
    const bf16_t* H; float* out; int ldc; float s;
    __device__ __forceinline__ void operator()(const f32x4 (&acc)[2][2][4][2], const Unit& u, int wr, int wc, int fr, int fq) const {
        const int row0 = u.pm * BM + wr * 64 + fr, col0 = u.pn * BM + wc * 32 + 4 * fq;
#pragma unroll
        for (int ai = 0; ai < 2; ++ai)
#pragma unroll
            for (int m = 0; m < 4; ++m) { const size_t off = (size_t)(row0 + ai * HALF + m * 16) * ldc + col0;
#pragma unroll
                for (int bj = 0; bj < 2; ++bj)
#pragma unroll
                    for (int n = 0; n < 2; ++n) { const int co = bj * HALF + n * 16; const u32x2 hb = *(const u32x2*)(H + off + co);
                        f32x4 b; b[0] = __uint_as_float(hb.x << 16); b[1] = __uint_as_float(hb.x & 0xffff0000u); b[2] = __uint_as_float(hb.y << 16); b[3] = __uint_as_float(hb.y & 0xffff0000u);
                        *(f32x4*)(out + off + co) = b + acc[ai][bj][m][n] * s; } }
    }
};
struct EpiGlu {
    static constexpr bool PERM = true, AFTER_DRAIN = false;
    const bf16_t* G; int ldg; bf16_t* O; int ldo, ocol; const float* bias;
    __device__ __forceinline__ void operator()(const f32x4 (&acc)[2][2][4][2], const Unit& u, int wr, int wc, int fr, int fq) const {
        const int row0 = u.pm * BM + wr * 64 + fr, col0 = u.pn * BM + wc * 32 + 8 * fq;
#pragma unroll
        for (int ai = 0; ai < 2; ++ai)
#pragma unroll
            for (int m = 0; m < 4; ++m) { const int row = row0 + ai * HALF + m * 16;
#pragma unroll
                for (int bj = 0; bj < 2; ++bj) { const int c = col0 + bj * HALF;
                    const f32x4 b0 = *(const f32x4*)(bias + c), b1 = *(const f32x4*)(bias + c + 4);
                    const u32x4 gv = *(const u32x4*)(G + (size_t)row * ldg + c);
                    const f32x4 v0 = acc[ai][bj][m][0] + b0, v1 = acc[ai][bj][m][1] + b1;
                    float g[8]; g[0] = __uint_as_float(gv.x << 16); g[1] = __uint_as_float(gv.x & 0xffff0000u); g[2] = __uint_as_float(gv.y << 16); g[3] = __uint_as_float(gv.y & 0xffff0000u);
                    g[4] = __uint_as_float(gv.z << 16); g[5] = __uint_as_float(gv.z & 0xffff0000u); g[6] = __uint_as_float(gv.w << 16); g[7] = __uint_as_float(gv.w & 0xffff0000u);
                    u32x4 w; w.x = cvt_pk_bf16(g[0] * fsigmoid(v0[0]), g[1] * fsigmoid(v0[1])); w.y = cvt_pk_bf16(g[2] * fsigmoid(v0[2]), g[3] * fsigmoid(v0[3]));
                    w.z = cvt_pk_bf16(g[4] * fsigmoid(v1[0]), g[5] * fsigmoid(v1[1])); w.w = cvt_pk_bf16(g[6] * fsigmoid(v1[2]), g[7] * fsigmoid(v1[3]));
                    *(u32x4*)(O + (size_t)row * ldo + ocol + c) = w; } }
    }
};

template <int NM, int NN> struct FixedOrder {
    int G, c;
    __device__ __forceinline__ bool next(int i, Unit& u) const {
        constexpr int nwg = NM * NN, q = nwg / 8, r = nwg % 8, nig = 8 * NN;
        const int L = i * G + c; if (L >= nwg) return false;
        const int xcd = L & 7, off = L >> 3;
        const int wgid = (xcd < r ? xcd * (q + 1) : r * (q + 1) + (xcd - r) * q) + off;
        const int gid = wgid / nig, rem = wgid % nig;
        u.pm = gid * 8 + (rem & 7); u.pn = rem >> 3; return true;
    }
    __device__ __forceinline__ void a_ready(const Unit&) const {}
    __device__ __forceinline__ void done(const Unit&) const {}
};

template <class Epi, class Sched, bool ALIGN_EPI = false, bool SP2 = false>
__device__ __forceinline__ void gemm_phase(PG8_LAS unsigned char* lds, const Gemm g, const Sched& S, const Epi& E) {
    int tid_ = threadIdx.x; asm volatile("" : "+v"(tid_));
    const int tid = tid_, wid = __builtin_amdgcn_readfirstlane(tid >> 6), lane = tid & 63, wr = wid >> 2, wc = wid & 3, fr = lane & 15, fq = lane >> 4;
    const int K = g.K, nt = K / BK;
    unsigned voffA[2], voffB[2];
#pragma unroll
    for (int i = 0; i < 2; ++i) { int R, C; stage_rc(tid * 16 + i * 8192, R, C); const int Rb = Epi::PERM ? ((R & ~31) + perm32(R & 31)) : R;
        voffA[i] = (unsigned)(R * K + C) * 2u; voffB[i] = (unsigned)(Rb * K + C) * 2u; }
    const size_t kstep = (size_t)(BK * 2);
    const size_t hstep = (size_t)HALF * K * 2;
    const size_t tstep = 2 * hstep;
    const unsigned ldsw = (unsigned)wid * 1024u;
    const int aoff = lds_byte(wr * 64 + fr, fq * 8), boff = lds_byte(wc * 32 + fr, fq * 8);
#define PG8_SA(b, h) (((b) * 2 + (h)) * HTB)
#define PG8_SB(b, h) ((4 + (b) * 2 + (h)) * HTB)
#define PG8_STAGE(bufoff, gbase, voff) do { _Pragma("unroll") for (int _i = 0; _i < 2; ++_i) \
        __builtin_amdgcn_global_load_lds((const unsigned*)((const char*)(gbase) + (voff)[_i]), (PG8_LAS unsigned*)(lds + (bufoff) + ldsw + _i * 8192), 16, 0, 0); } while (0)
#define PG8_LDA(dst, b, h) do { _Pragma("unroll") for (int m = 0; m < 4; ++m) _Pragma("unroll") for (int k = 0; k < 2; ++k) dst[m][k] = *(const PG8_LAS bf16x8*)(lds + PG8_SA(b, h) + aoff + m * 2048 + k * 1024); } while (0)
#define PG8_LDB(dst, b, h) do { _Pragma("unroll") for (int n = 0; n < 2; ++n) _Pragma("unroll") for (int k = 0; k < 2; ++k) dst[n][k] = *(const PG8_LAS bf16x8*)(lds + PG8_SB(b, h) + boff + n * 2048 + k * 1024); } while (0)
#define PG8_MMA(ai, bj, At, Bt) do { __builtin_amdgcn_s_setprio(1); _Pragma("unroll") for (int m = 0; m < 4; ++m) _Pragma("unroll") for (int n = 0; n < 2; ++n) _Pragma("unroll") for (int k = 0; k < 2; ++k) \
        acc[ai][bj][m][n] = __builtin_amdgcn_mfma_f32_16x16x32_bf16(Bt[n][k], At[m][k], acc[ai][bj][m][n], 0, 0, 0); __builtin_amdgcn_s_setprio(0); } while (0)
#define PG8_WAIT_V(n) asm volatile("s_waitcnt vmcnt(" #n ")" ::: "memory")
#define PG8_WAIT_L(n) asm volatile("s_waitcnt lgkmcnt(" #n ")" ::: "memory")
#define PG8_BAR __builtin_amdgcn_s_barrier()
#define PG8_SCHED __builtin_amdgcn_sched_barrier(0)
    Unit cur, nxt; int ui = 0;
    if (!S.next(0, cur)) return;
    f32x4 acc[2][2][4][2];
#pragma unroll
    for (int a = 0; a < 2; ++a)
#pragma unroll
        for (int b = 0; b < 2; ++b)
#pragma unroll
            for (int m = 0; m < 4; ++m)
#pragma unroll
                for (int n = 0; n < 2; ++n) acc[a][b][m][n] = (f32x4){0.f, 0.f, 0.f, 0.f};
    bf16x8 At[4][2], B0[2][2], B1[2][2];
    const char* cA = (const char*)g.A + (size_t)cur.pm * tstep; const char* cB = (const char*)g.Bt + (size_t)cur.pn * tstep;
    S.a_ready(cur);
    if constexpr (SP2) {
        PG8_STAGE(PG8_SB(0, 0), cB, voffB); PG8_STAGE(PG8_SB(0, 1), cB + hstep, voffB); PG8_STAGE(PG8_SA(0, 0), cA, voffA); PG8_STAGE(PG8_SA(0, 1), cA + hstep, voffA);
        if (wr == 1) PG8_BAR;
        PG8_WAIT_V(2); PG8_BAR;
        PG8_STAGE(PG8_SB(1, 0), cB + kstep, voffB); PG8_STAGE(PG8_SA(1, 0), cA + kstep, voffA); PG8_STAGE(PG8_SB(1, 1), cB + hstep + kstep, voffB);
        PG8_WAIT_V(6); PG8_BAR;
    } else {
        PG8_STAGE(PG8_SB(0, 0), cB, voffB); PG8_STAGE(PG8_SA(0, 0), cA, voffA); PG8_STAGE(PG8_SB(0, 1), cB + hstep, voffB); PG8_STAGE(PG8_SA(0, 1), cA + hstep, voffA);
        if (wr == 1) PG8_BAR;
        PG8_WAIT_V(4); PG8_BAR;
        PG8_STAGE(PG8_SB(1, 0), cB + kstep, voffB); PG8_STAGE(PG8_SA(1, 0), cA + kstep, voffA); PG8_STAGE(PG8_SB(1, 1), cB + hstep + kstep, voffB);
        PG8_WAIT_V(6); PG8_BAR;
    }
    for (;;) {
        const bool has_next = S.next(ui + 1, nxt);
        const char* nA = has_next ? (const char*)g.A + (size_t)nxt.pm * tstep : cA; const char* nB = has_next ? (const char*)g.Bt + (size_t)nxt.pn * tstep : cB;
        for (int t = 0; t < nt; t += 2) {
            const bool last = (t == nt - 2);
            const char* a1 = cA + (size_t)(t + 1) * kstep;
            const char* a2 = last ? nA : cA + (size_t)(t + 2) * kstep; const char* b2 = last ? nB : cB + (size_t)(t + 2) * kstep;
            const char* a3 = a2 + kstep; const char* b3 = b2 + kstep;
            if (last && has_next) S.a_ready(nxt);
            if constexpr (SP2) {
            PG8_LDB(B0, 0, 0); PG8_LDB(B1, 0, 1); PG8_SCHED; PG8_LDA(At, 0, 0); PG8_STAGE(PG8_SA(1, 1), a1 + hstep, voffA);
            PG8_WAIT_V(8); PG8_WAIT_L(0); PG8_BAR; PG8_MMA(0, 0, At, B0); PG8_MMA(0, 1, At, B1); PG8_BAR; PG8_SCHED;
            PG8_LDA(At, 0, 1); PG8_STAGE(PG8_SB(0, 0), b2, voffB); PG8_STAGE(PG8_SB(0, 1), b2 + hstep, voffB); PG8_STAGE(PG8_SA(0, 0), a2, voffA);
            PG8_WAIT_V(8); PG8_WAIT_L(0); PG8_BAR; PG8_MMA(1, 0, At, B0); PG8_MMA(1, 1, At, B1); PG8_BAR; PG8_SCHED;
            PG8_LDB(B0, 1, 0); PG8_LDB(B1, 1, 1); PG8_SCHED; PG8_LDA(At, 1, 0); PG8_STAGE(PG8_SA(0, 1), a2 + hstep, voffA);
            PG8_WAIT_V(8); PG8_WAIT_L(0); PG8_BAR; PG8_MMA(0, 0, At, B0); PG8_MMA(0, 1, At, B1); PG8_BAR; PG8_SCHED;
            PG8_LDA(At, 1, 1); PG8_STAGE(PG8_SB(1, 0), b3, voffB); PG8_STAGE(PG8_SB(1, 1), b3 + hstep, voffB); PG8_STAGE(PG8_SA(1, 0), a3, voffA);
            PG8_WAIT_V(8); PG8_WAIT_L(0); PG8_BAR; PG8_MMA(1, 0, At, B0); PG8_MMA(1, 1, At, B1); PG8_BAR; PG8_SCHED;
            } else {
            PG8_LDB(B0, 0, 0); PG8_SCHED; PG8_LDA(At, 0, 0); PG8_STAGE(PG8_SA(1, 1), a1 + hstep, voffA);
            PG8_WAIT_L(8); PG8_BAR; PG8_WAIT_L(0); PG8_MMA(0, 0, At, B0); PG8_BAR; PG8_SCHED;
            PG8_LDB(B1, 0, 1); PG8_STAGE(PG8_SB(0, 0), b2, voffB);
            PG8_BAR; PG8_WAIT_L(0); PG8_MMA(0, 1, At, B1); PG8_BAR;
            PG8_LDA(At, 0, 1); PG8_STAGE(PG8_SA(0, 0), a2, voffA);
            PG8_BAR; PG8_WAIT_L(0); PG8_MMA(1, 0, At, B0); PG8_BAR; PG8_SCHED;
            PG8_STAGE(PG8_SB(0, 1), b2 + hstep, voffB);
            PG8_WAIT_V(6); PG8_BAR; PG8_MMA(1, 1, At, B1); PG8_BAR;
            PG8_LDB(B0, 1, 0); PG8_SCHED; PG8_LDA(At, 1, 0); PG8_STAGE(PG8_SA(0, 1), a2 + hstep, voffA);
            PG8_WAIT_L(8); PG8_BAR; PG8_WAIT_L(0); PG8_MMA(0, 0, At, B0); PG8_BAR; PG8_SCHED;
            PG8_LDB(B1, 1, 1); PG8_STAGE(PG8_SB(1, 0), b3, voffB);
            PG8_BAR; PG8_WAIT_L(0); PG8_MMA(0, 1, At, B1); PG8_BAR;
            PG8_LDA(At, 1, 1); PG8_STAGE(PG8_SA(1, 0), a3, voffA);
            PG8_BAR; PG8_WAIT_L(0); PG8_MMA(1, 0, At, B0); PG8_BAR; PG8_SCHED;
            PG8_STAGE(PG8_SB(1, 1), b3 + hstep, voffB);
            PG8_WAIT_V(6); PG8_BAR; PG8_MMA(1, 1, At, B1); PG8_BAR;
            }
        }
        if constexpr (ALIGN_EPI) { if (wr == 0) PG8_BAR; }
        if constexpr (!Epi::AFTER_DRAIN) { E(acc, cur, wr, wc, fr, fq); S.done(cur); }
        if (!has_next) break;
#pragma unroll
        for (int a = 0; a < 2; ++a)
#pragma unroll
            for (int b = 0; b < 2; ++b)
#pragma unroll
                for (int m = 0; m < 4; ++m)
#pragma unroll
                    for (int n = 0; n < 2; ++n) acc[a][b][m][n] = (f32x4){0.f, 0.f, 0.f, 0.f};
        cur = nxt; cA = nA; cB = nB; ++ui;
        if constexpr (ALIGN_EPI) { if (wr == 1) PG8_BAR; }
    }
    PG8_WAIT_V(0);
    if constexpr (!ALIGN_EPI) { if (wr == 0) PG8_BAR; }
    PG8_BAR;
    if constexpr (Epi::AFTER_DRAIN) { E.fused(acc, cur, wr, wc, fr, fq, lds, wid, lane); S.done(cur); }
#undef PG8_SA
#undef PG8_SB
#undef PG8_STAGE
#undef PG8_LDA
#undef PG8_LDB
#undef PG8_MMA
#undef PG8_WAIT_V
#undef PG8_WAIT_L
#undef PG8_BAR
#undef PG8_SCHED
}
}

#define LAS __attribute__((address_space(3)))
typedef unsigned short bf16_t;
typedef short bf16x8 __attribute__((ext_vector_type(8)));
typedef float f32x4 __attribute__((ext_vector_type(4)));
typedef float f32x2 __attribute__((ext_vector_type(2)));
typedef unsigned u32x4 __attribute__((ext_vector_type(4)));
typedef unsigned u32x2 __attribute__((ext_vector_type(2)));

constexpr int M = 16384, D = 2048, FF = 5632, SEQ = 2048, NBATCH = 8, NCH = 32, CH = 64;
constexpr int PIN = 5656, PINP = 5888;
constexpr int PQ = 0, PK = 768, PV = 1536, PZ = 2304;
constexpr int PSZ = 3072, PSX = 3840, PSB = 4608, PSC = 4864;
constexpr int PU = 5120;
constexpr int PGB = 5632, PGA = 5638, PSDT = 5648;
constexpr float EPS = 1e-6f;
constexpr size_t MiB = 1u << 20;
constexpr size_t WS_CTL = 0, WS_GL = 64 * 1024, WS_CD = 128 * 1024;
constexpr size_t WS_WGU1 = 1 * MiB, WS_WD1 = 45 * MiB, WS_WIN = 67 * MiB, WS_WGLU = 90 * MiB, WS_WOUT = 91 * MiB, WS_WGU2 = 99 * MiB, WS_WD2 = 143 * MiB;
constexpr size_t WS_XN = 166 * MiB;
constexpr size_t WS_AP = 230 * MiB;
constexpr size_t WS_MIX = 414 * MiB;
constexpr size_t WS_GT = 478 * MiB;
constexpr size_t WS_GO = 586 * MiB;
constexpr size_t WS_ST = 610 * MiB;
constexpr size_t WS_G5 = 658 * MiB;
constexpr size_t WS_E5 = 674 * MiB;
constexpr size_t WS_SSQ = 678 * MiB;
constexpr size_t WS_H = 690 * MiB;
constexpr size_t WS_END = 754 * MiB;
constexpr int GT_UNIT = 73728, GT_U = 0, GT_W = 16384, GT_QD = 32768, GT_KDT = 49152, GT_ATT = 65536;
constexpr int LDS_BYTES = 155648;

__device__ __forceinline__ float bf2f(unsigned v) { return __uint_as_float(v << 16); }
__device__ __forceinline__ unsigned f2bf(float f) { unsigned u = __float_as_uint(f); return (u + 0x7fffu + ((u >> 16) & 1u)) >> 16; }
__device__ __forceinline__ unsigned pk2(float lo, float hi) { return pg8::cvt_pk_bf16(lo, hi); }
__device__ __forceinline__ float fsilu(float x) { return x / (1.f + __expf(-x)); }
__device__ __forceinline__ float fsigmoid(float x) { return 1.f / (1.f + __expf(-x)); }
__device__ __forceinline__ float fsoftplus(float x) { return x > 20.f ? x : log1pf(expf(x)); }
__device__ __forceinline__ void unpack8(const u32x4 v, float* f) {
    f[0] = __uint_as_float(v.x << 16); f[1] = __uint_as_float(v.x & 0xffff0000u); f[2] = __uint_as_float(v.y << 16); f[3] = __uint_as_float(v.y & 0xffff0000u);
    f[4] = __uint_as_float(v.z << 16); f[5] = __uint_as_float(v.z & 0xffff0000u); f[6] = __uint_as_float(v.w << 16); f[7] = __uint_as_float(v.w & 0xffff0000u); }
__device__ __forceinline__ float wave_sum(float v) {
#pragma unroll
    for (int o = 1; o < 64; o <<= 1) v += __shfl_xor(v, o);
    return v;
}
__device__ __forceinline__ float wave_incl_scan(float v, int lane) {
#pragma unroll
    for (int o = 1; o < 64; o <<= 1) { const float t = __shfl_up(v, o); if (lane >= o) v += t; }
    return v;
}
__device__ __forceinline__ f32x4 mm16(const LAS bf16_t* X, int ldx, const LAS bf16_t* Y, int ldy, int K, f32x4 acc, int fr, int fq) {
    const LAS bf16_t* xp = X + fr * ldx + fq * 8; const LAS bf16_t* yp = Y + fr * ldy + fq * 8;
#if defined(MM16_NAIVE)
    for (int k = 0; k < K; ++k) { const float xv = bf2f(X[fr * ldx + k]);
#pragma unroll
        for (int j = 0; j < 4; ++j) acc[j] += xv * bf2f(Y[(4 * fq + j) * ldy + k]); }
    (void)xp; (void)yp;
#else
    for (int k = 0; k < K; k += 32) { const bf16x8 x = *(const LAS bf16x8*)(xp + k); const bf16x8 y = *(const LAS bf16x8*)(yp + k);
        acc = __builtin_amdgcn_mfma_f32_16x16x32_bf16(y, x, acc, 0, 0, 0);
        asm volatile("" :: "v"(x), "v"(y)); }
#endif
    return acc;
}
#define WG_SYNC() do { asm volatile("s_waitcnt lgkmcnt(0)" ::: "memory"); __builtin_amdgcn_s_barrier(); asm volatile("" ::: "memory"); } while (0)

struct KP { const float* in[33]; float* out; unsigned char* ws; int ph_lo, ph_hi; };
#define AS4 __attribute__((address_space(4)))
struct KPV {
    const AS4 KP* k;
    __device__ __forceinline__ const float* in(int i) const { return k->in[i]; }
    __device__ __forceinline__ unsigned char* ws() const { return k->ws; }
    __device__ __forceinline__ float* out() const { return k->out; }
};

__device__ __forceinline__ int map_row(int mode, int n) {
    if (mode == 0) return n;
    if (mode == 1) return ((n >> 7) << 8) + (n & 127);
    if (mode == 2) return ((n >> 7) << 8) + 128 + (n & 127);
    if (n < 3072) return n;
    if (n < 3084) return PGB + (n - 3072);
    if (n < 5132) return 3072 + (n - 3084);
    if (n < 5144) return PSDT + (n - 5132);
    return PU + (n - 5144);
}
__device__ __forceinline__ void transpose_item(const float* W, int K, int N, bf16_t* WT, int mode, LAS float* scr, int item, int lane, const float* nw = nullptr) {
    const int nblk = (N + 31) / 32, kb = item / nblk, nb = item % nblk, k0 = 64 * kb, n0 = 32 * nb;
    const int nn = n0 + (lane & 31); const bool ok = nn < N;
    float wv[32];
#pragma unroll
    for (int i = 0; i < 32; ++i) { const int kk = 2 * i + (lane >> 5); wv[i] = ok ? __builtin_nontemporal_load(W + (size_t)(k0 + kk) * N + nn) : 0.f; }
#pragma unroll
    for (int i = 0; i < 32; ++i) { const int kk = 2 * i + (lane >> 5); scr[kk * 33 + (lane & 31)] = nw ? wv[i] * nw[k0 + kk] : wv[i]; }
    asm volatile("s_waitcnt lgkmcnt(0)" ::: "memory"); __builtin_amdgcn_wave_barrier();
    const int c = lane & 7;
#pragma unroll
    for (int j = 0; j < 4; ++j) { const int n = (lane >> 3) + 8 * j; const LAS float* s = scr + (8 * c) * 33 + n;
        u32x4 o; o.x = pk2(s[0 * 33], s[1 * 33]); o.y = pk2(s[2 * 33], s[3 * 33]); o.z = pk2(s[4 * 33], s[5 * 33]); o.w = pk2(s[6 * 33], s[7 * 33]);
        if (n0 + n < N) *(u32x4*)(WT + (size_t)map_row(mode, n0 + n) * K + k0 + 8 * c) = o; }
    asm volatile("s_waitcnt lgkmcnt(0)" ::: "memory"); __builtin_amdgcn_wave_barrier();
}
__device__ __forceinline__ void convert_phase(const KPV& p, int layer, LAS unsigned char* lds, int gw, int NGW, int wave, int lane) {
    LAS float* scr = (LAS float*)(lds + wave * 16384);
    unsigned char* ws = p.ws();
    constexpr int I_GU = (D / 64) * (FF / 32), I_DN = (FF / 64) * (D / 32), I_IN = (D / 64) * ((PIN + 31) / 32), I_GLU = (512 / 64) * (512 / 32), I_OUT = (D / 64) * (D / 32);
    constexpr int NITEMS = 4 * I_GU + 2 * I_DN + I_IN + I_GLU + I_OUT;
    for (int it = gw; it < NITEMS; it += NGW) {
        int r = it;
        if (r < I_GU) { transpose_item(p.in(2) + (size_t)layer * D * FF, D, FF, (bf16_t*)(ws + WS_WGU1), 1, scr, r, lane, p.in(1) + layer * D); continue; } r -= I_GU;
        if (r < I_GU) { transpose_item(p.in(3) + (size_t)layer * D * FF, D, FF, (bf16_t*)(ws + WS_WGU1), 2, scr, r, lane, p.in(1) + layer * D); continue; } r -= I_GU;
        if (r < I_DN) { transpose_item(p.in(4) + (size_t)layer * D * FF, FF, D, (bf16_t*)(ws + WS_WD1), 0, scr, r, lane); continue; } r -= I_DN;
        if (r < I_IN) { transpose_item(p.in(6) + (size_t)layer * D * PIN, D, PIN, (bf16_t*)(ws + WS_WIN), 3, scr, r, lane, p.in(5) + layer * D); continue; } r -= I_IN;
        if (r < I_GLU) { transpose_item(p.in(25) + (size_t)layer * 512 * 512, 512, 512, (bf16_t*)(ws + WS_WGLU), 0, scr, r, lane); continue; } r -= I_GLU;
        if (r < I_OUT) { transpose_item(p.in(27) + (size_t)layer * D * D, D, D, (bf16_t*)(ws + WS_WOUT), 0, scr, r, lane); continue; } r -= I_OUT;
        if (r < I_GU) { transpose_item(p.in(29) + (size_t)layer * D * FF, D, FF, (bf16_t*)(ws + WS_WGU2), 1, scr, r, lane, p.in(28) + layer * D); continue; } r -= I_GU;
        if (r < I_GU) { transpose_item(p.in(30) + (size_t)layer * D * FF, D, FF, (bf16_t*)(ws + WS_WGU2), 2, scr, r, lane, p.in(28) + layer * D); continue; } r -= I_GU;
        transpose_item(p.in(31) + (size_t)layer * D * FF, FF, D, (bf16_t*)(ws + WS_WD2), 0, scr, r, lane);
    }
}
__device__ __forceinline__ void norm_raw_phase(const float* h, const float* w, bf16_t* xn, float* ssq, int gw, int NGW, int lane) {
    for (int row = gw; row < M; row += NGW) {
        const f32x4* xr = (const f32x4*)(h + (size_t)row * D) + lane; float s = 0.f;
#pragma unroll
        for (int j = 0; j < 8; ++j) { const f32x4 v = xr[64 * j]; s += (v.x * v.x + v.y * v.y) + (v.z * v.z + v.w * v.w);
            u32x2 q; q.x = pk2(v.x, v.y); q.y = pk2(v.z, v.w);
            *((u32x2*)(xn + (size_t)row * D) + lane + 64 * j) = q; }
        s = wave_sum(s); if (lane < 32) ssq[(size_t)row * 32 + lane] = (lane == 0) ? s : 0.f;
    }
}
template <bool FINAL>
__device__ __forceinline__ void norm_phase(const float* h, const float* w, bf16_t* xn, float* fout, int gw, int NGW, int lane) {
    for (int row = gw; row < M; row += NGW) {
        const f32x4* xr = (const f32x4*)(h + (size_t)row * D) + lane;
        f32x4 v[8]; float s = 0.f;
#pragma unroll
        for (int j = 0; j < 8; ++j) { v[j] = xr[64 * j]; s += (v[j].x * v[j].x + v[j].y * v[j].y) + (v[j].z * v[j].z + v[j].w * v[j].w); }
        const float rstd = rsqrtf(wave_sum(s) * (1.f / D) + EPS);
#pragma unroll
        for (int j = 0; j < 8; ++j) { const f32x4 wv = *((const f32x4*)w + lane + 64 * j); const f32x4 o = v[j] * rstd * wv;
            if (FINAL) *((f32x4*)(fout + (size_t)row * D) + lane + 64 * j) = o;
            else { u32x2 q; q.x = pk2(o.x, o.y); q.y = pk2(o.z, o.w); *((u32x2*)(xn + (size_t)row * D) + lane + 64 * j) = q; } }
    }
}

constexpr int G_RAW = 0;
constexpr int G_LF = 0, G_TS = 17408, G_TF = 26624;
constexpr int G_QS = 51456, G_KS = 68864, G_KDT = 86272, G_VBT = 104704, G_KGT = 123136, G_GATE = 141568;
struct S5Par;
__device__ __forceinline__ void s5_shadow_unit(const KPV& p, int layer, int wu, LAS unsigned char* wl, int lane);
__device__ __forceinline__ void gdn_pre_unit(const KPV& p, int layer, int unit, LAS unsigned char* lds, int tid, int wave, int lane, int s5_wu = -1) {
    asm volatile("" : "+v"(tid)); lane = tid & 63;
    const int b = unit / (6 * NCH), h = (unit / NCH) % 6, n = unit % NCH;
    const int tok0 = b * SEQ + n * CH;
    const bf16_t* proj = (const bf16_t*)(p.ws() + WS_AP);
    unsigned char* gt = p.ws() + WS_GT + (size_t)unit * GT_UNIT;
    LAS bf16_t* raw = (LAS bf16_t*)(lds + G_RAW);
    LAS float* Gs = (LAS float*)(lds + G_GATE); LAS float* Bt = Gs + 64;
    { u32x4 rv[7];
#pragma unroll
      for (int k = 0; k < 7; ++k) { const int c = tid + 512 * k, part = c / (67 * 16), rc = c % (67 * 16), r = rc >> 4, ch = rc & 15;
          rv[k] = (u32x4){0u, 0u, 0u, 0u};
          if (c < 3 * 67 * 16 && (n > 0 || r >= 3)) rv[k] = *(const u32x4*)(proj + (size_t)(tok0 + r - 3) * PINP + part * 768 + h * 128 + ch * 8); }
#pragma unroll
      for (int k = 0; k < 7; ++k) { const int c = tid + 512 * k, part = c / (67 * 16), rc = c % (67 * 16), r = rc >> 4, ch = rc & 15;
          if (c < 3 * 67 * 16) *(LAS u32x4*)(raw + (part * 67 + r) * 128 + ch * 8) = rv[k]; } }
    if (wave == 0) { const size_t ro = (size_t)(tok0 + lane) * PINP;
        const float braw = bf2f(proj[ro + PGB + h]), araw = bf2f(proj[ro + PGA + h]);
        const float g = -expf(p.in(8)[layer * 6 + h]) * fsoftplus(araw + p.in(9)[layer * 6 + h]);
        Gs[lane] = wave_incl_scan(g, lane); Bt[lane] = 1.f / (1.f + expf(-braw)); }
    WG_SYNC();
    { const int tok = tid >> 3, sub = tid & 7, c0 = sub * 16;
      const float* cw = p.in(7) + (size_t)layer * 4 * 2304 + h * 128 + c0;
      const float G = Gs[tok], beta = Bt[tok], Glast = Gs[63];
      const float eG = expf(G), eGl = expf(Glast - G);
      LAS bf16_t* Qs = (LAS bf16_t*)(lds + G_QS); LAS bf16_t* Ks = (LAS bf16_t*)(lds + G_KS);
      LAS bf16_t* KdT = (LAS bf16_t*)(lds + G_KDT); LAS bf16_t* VbT = (LAS bf16_t*)(lds + G_VBT); LAS bf16_t* KgT = (LAS bf16_t*)(lds + G_KGT);
#pragma unroll 1
      for (int part = 0; part < 3; ++part) {
          float acc[16];
#pragma unroll
          for (int i = 0; i < 16; ++i) acc[i] = 0.f;
#pragma unroll
          for (int tap = 0; tap < 4; ++tap) {
              const LAS bf16_t* rp = raw + (part * 67 + tok + tap) * 128 + c0;
              float x[16]; unpack8(*(const LAS u32x4*)rp, x); unpack8(*(const LAS u32x4*)(rp + 8), x + 8);
              const float* wp = cw + tap * 2304 + part * 768;
#pragma unroll
              for (int i4 = 0; i4 < 4; ++i4) { const f32x4 wv = *(const f32x4*)(wp + 4 * i4);
                  acc[4 * i4 + 0] += wv.x * x[4 * i4 + 0]; acc[4 * i4 + 1] += wv.y * x[4 * i4 + 1]; acc[4 * i4 + 2] += wv.z * x[4 * i4 + 2]; acc[4 * i4 + 3] += wv.w * x[4 * i4 + 3]; }
          }
          float ss = 0.f;
#pragma unroll
          for (int i = 0; i < 16; ++i) { acc[i] = fsilu(acc[i]); ss += acc[i] * acc[i]; }
          ss += __shfl_xor(ss, 1); ss += __shfl_xor(ss, 2); ss += __shfl_xor(ss, 4);
          const float r = (part == 2) ? 1.f : rsqrtf(ss + EPS) * (part == 0 ? 0.08838834764831845f : 1.f);
#pragma unroll
          for (int i = 0; i < 16; ++i) acc[i] *= r;
          u32x4 a, c;
          a.x = pk2(acc[0], acc[1]); a.y = pk2(acc[2], acc[3]); a.z = pk2(acc[4], acc[5]); a.w = pk2(acc[6], acc[7]);
          c.x = pk2(acc[8], acc[9]); c.y = pk2(acc[10], acc[11]); c.z = pk2(acc[12], acc[13]); c.w = pk2(acc[14], acc[15]);
          if (part == 0) {
              *(LAS u32x4*)(Qs + tok * 136 + c0) = a; *(LAS u32x4*)(Qs + tok * 136 + c0 + 8) = c;
              a.x = pk2(acc[0] * eG, acc[1] * eG); a.y = pk2(acc[2] * eG, acc[3] * eG); a.z = pk2(acc[4] * eG, acc[5] * eG); a.w = pk2(acc[6] * eG, acc[7] * eG);
              c.x = pk2(acc[8] * eG, acc[9] * eG); c.y = pk2(acc[10] * eG, acc[11] * eG); c.z = pk2(acc[12] * eG, acc[13] * eG); c.w = pk2(acc[14] * eG, acc[15] * eG);
              bf16_t* qd = (bf16_t*)(gt + GT_QD) + tok * 128 + c0; *(u32x4*)qd = a; *(u32x4*)(qd + 8) = c;
          } else if (part == 1) {
              *(LAS u32x4*)(Ks + tok * 136 + c0) = a; *(LAS u32x4*)(Ks + tok * 136 + c0 + 8) = c;
              const float kbg = beta * eG;
#pragma unroll
              for (int i = 0; i < 16; ++i) { KdT[(c0 + i) * 72 + tok] = (bf16_t)f2bf(acc[i] * eGl); KgT[(c0 + i) * 72 + tok] = (bf16_t)f2bf(acc[i] * kbg); }
          } else {
#pragma unroll
              for (int i = 0; i < 16; ++i) VbT[(c0 + i) * 72 + tok] = (bf16_t)f2bf(acc[i] * beta);
          }
      }
    }
    WG_SYNC();
    { LAS float* Lf = (LAS float*)(lds + G_LF);
      const LAS bf16_t* Qs = (const LAS bf16_t*)(lds + G_QS); const LAS bf16_t* Ks = (const LAS bf16_t*)(lds + G_KS);
      const int fr = lane & 15, fq = lane >> 4;
      for (int job = wave * 4; job < wave * 4 + 4; ++job) { const int mat = job >> 4, ti = (job >> 2) & 3, tj = job & 3;
          f32x4 acc = (f32x4){0.f, 0.f, 0.f, 0.f};
          acc = mm16((mat == 0 ? Ks : Qs) + ti * 16 * 136, 136, Ks + tj * 16 * 136, 136, 128, acc, fr, fq);
          const int i = ti * 16 + fr, j0 = tj * 16 + 4 * fq; const float Gi = Gs[i], bi = Bt[i];
          float o[4];
#pragma unroll
          for (int jj = 0; jj < 4; ++jj) { const int j = j0 + jj; const float dec = (i >= j) ? expf(Gi - Gs[j]) : 0.f;
              o[jj] = (mat == 0) ? ((i > j) ? acc[jj] * bi * dec : 0.f) : acc[jj] * dec; }
          if (mat == 0) { Lf[(j0 + 0) * 68 + i] = o[0]; Lf[(j0 + 1) * 68 + i] = o[1]; Lf[(j0 + 2) * 68 + i] = o[2]; Lf[(j0 + 3) * 68 + i] = o[3]; }
          else { u32x2 w; w.x = pk2(o[0], o[1]); w.y = pk2(o[2], o[3]); *(u32x2*)((bf16_t*)(gt + GT_ATT) + i * 64 + j0) = w; } }
    }
    WG_SYNC();
    if (wave == 0) { const LAS float* LfT = (const LAS float*)(lds + G_LF); LAS bf16_t* Ts = (LAS bf16_t*)(lds + G_TS); LAS float* Tf = (LAS float*)(lds + G_TF);
#pragma unroll 1
        for (int I = 0; I < 4; ++I) { float s[16];
#pragma unroll
            for (int ii = 0; ii < 16; ++ii) s[ii] = (16 * I + ii == lane) ? 1.f : 0.f;
#pragma unroll 2
            for (int j = 0; j < 16 * I; ++j) { const float tj = Tf[j * 64 + lane]; const LAS f32x4* lc = (const LAS f32x4*)(LfT + j * 68 + 16 * I);
#pragma unroll
                for (int q = 0; q < 4; ++q) { const f32x4 l = lc[q]; s[4 * q + 0] -= l.x * tj; s[4 * q + 1] -= l.y * tj; s[4 * q + 2] -= l.z * tj; s[4 * q + 3] -= l.w * tj; } }
#pragma unroll
            for (int jj = 0; jj < 16; ++jj) { const float t = s[jj]; Tf[(16 * I + jj) * 64 + lane] = t; Ts[(16 * I + jj) * 72 + lane] = (bf16_t)f2bf(t);
                const LAS f32x4* lc = (const LAS f32x4*)(LfT + (16 * I + jj) * 68 + 16 * I);
#pragma unroll
                for (int q = 0; q < 4; ++q) { if (4 * q + 3 > jj) { const f32x4 l = lc[q];
                    if (4 * q + 0 > jj) s[4 * q + 0] -= l.x * t; if (4 * q + 1 > jj) s[4 * q + 1] -= l.y * t; if (4 * q + 2 > jj) s[4 * q + 2] -= l.z * t; if (4 * q + 3 > jj) s[4 * q + 3] -= l.w * t; } } }
        }
        if (lane == 0) ((float*)(p.ws() + WS_GL))[unit] = expf(Gs[63]);
    } else { const LAS bf16_t* KdT = (const LAS bf16_t*)(lds + G_KDT);
        for (int c = tid - 64; c < 128 * 8; c += 448) { const int r = c >> 3, ch = c & 7; *(u32x4*)((bf16_t*)(gt + GT_KDT) + r * 64 + ch * 8) = *(const LAS u32x4*)(KdT + r * 72 + ch * 8); }
        if (s5_wu >= 0) s5_shadow_unit(p, layer, s5_wu, lds + G_QS + (wave - 1) * 4096, lane); }
    WG_SYNC();
    asm volatile("" : "+v"(tid)); lane = tid & 63;
    { const LAS bf16_t* Ts = (const LAS bf16_t*)(lds + G_TS); const LAS bf16_t* VbT = (const LAS bf16_t*)(lds + G_VBT); const LAS bf16_t* KgT = (const LAS bf16_t*)(lds + G_KGT);
      const int fr = lane & 15, fq = lane >> 4;
      for (int job = wave * 8; job < wave * 8 + 8; ++job) { const int mat = job >> 5, ti = (job >> 3) & 3, te = job & 7;
          f32x4 acc = (f32x4){0.f, 0.f, 0.f, 0.f};
          acc = mm16(Ts + ti * 16 * 72, 72, (mat == 0 ? VbT : KgT) + te * 16 * 72, 72, 64, acc, fr, fq);
          u32x2 w; w.x = pk2(acc[0], acc[1]); w.y = pk2(acc[2], acc[3]);
          *(u32x2*)((bf16_t*)(gt + (mat == 0 ? GT_U : GT_W)) + (ti * 16 + fr) * 128 + te * 16 + 4 * fq) = w; }
    }
    WG_SYNC();
}

constexpr int GS_BUF = 66560;
constexpr int GS_WB = 0, GS_QB = 17408, GS_KT = 34816, GS_AT = 53248, GS_UB = 62464;
constexpr int GS_ST = 2 * GS_BUF, GS_VNT = GS_ST + 8704;
__device__ __forceinline__ void gs_load(const unsigned char* gt, int es, int tid, u32x4 (&v)[8]) {
#pragma unroll
    for (int k = 0; k < 8; ++k) { const int c = tid + 512 * k; const bf16_t* src;
        if (k < 2) src = (const bf16_t*)(gt + GT_W) + (c >> 4) * 128 + (c & 15) * 8;
        else if (k < 4) { const int c2 = c - 1024; src = (const bf16_t*)(gt + GT_QD) + (c2 >> 4) * 128 + (c2 & 15) * 8; }
        else if (k < 6) { const int c2 = c - 2048; src = (const bf16_t*)(gt + GT_KDT) + (c2 >> 3) * 64 + (c2 & 7) * 8; }
        else if (k < 7) { const int c2 = c - 3072; src = (const bf16_t*)(gt + GT_ATT) + (c2 >> 3) * 64 + (c2 & 7) * 8; }
        else { const int c2 = (c - 3584) & 255; src = (const bf16_t*)(gt + GT_U) + (c2 >> 2) * 128 + es * 32 + (c2 & 3) * 8; }
        v[k] = *(const u32x4*)src; }
}
__device__ __forceinline__ void gs_store(LAS unsigned char* buf, int tid, const u32x4 (&v)[8]) {
#pragma unroll
    for (int k = 0; k < 8; ++k) { const int c = tid + 512 * k; LAS bf16_t* dst;
        if (k < 2) dst = (LAS bf16_t*)(buf + GS_WB) + (c >> 4) * 136 + (c & 15) * 8;
        else if (k < 4) { const int c2 = c - 1024; dst = (LAS bf16_t*)(buf + GS_QB) + (c2 >> 4) * 136 + (c2 & 15) * 8; }
        else if (k < 6) { const int c2 = c - 2048; dst = (LAS bf16_t*)(buf + GS_KT) + (c2 >> 3) * 72 + (c2 & 7) * 8; }
        else if (k < 7) { const int c2 = c - 3072; dst = (LAS bf16_t*)(buf + GS_AT) + (c2 >> 3) * 72 + (c2 & 7) * 8; }
        else { const int c2 = (c - 3584) & 255; dst = (LAS bf16_t*)(buf + GS_UB) + (c2 >> 2) * 32 + (c2 & 3) * 8; }
        if (k < 7 || tid < 256) *(LAS u32x4*)dst = v[k]; }
}
__device__ __forceinline__ void gdn_scan_step(LAS unsigned char* buf, LAS bf16_t* ST, LAS bf16_t* VnT, f32x4 (&sacc)[2], float gl, bf16_t* gop, int wave, int fr, int fq) {
    const int d0 = wave * 16, ti = wave >> 1, te = wave & 1, i0 = ti * 16, e0 = te * 16;
#pragma unroll
    for (int et = 0; et < 2; ++et)
#pragma unroll
        for (int jj = 0; jj < 4; ++jj) ST[(16 * et + 4 * fq + jj) * 136 + d0 + fr] = (bf16_t)f2bf(sacc[et][jj]);
    WG_SYNC();
    f32x4 accv = (f32x4){0.f, 0.f, 0.f, 0.f}, acco = accv;
    accv = mm16((const LAS bf16_t*)(buf + GS_WB) + i0 * 136, 136, ST + e0 * 136, 136, 128, accv, fr, fq);
    acco = mm16((const LAS bf16_t*)(buf + GS_QB) + i0 * 136, 136, ST + e0 * 136, 136, 128, acco, fr, fq);
    { const u32x2 uu = *(const LAS u32x2*)((const LAS bf16_t*)(buf + GS_UB) + (i0 + fr) * 32 + e0 + 4 * fq);
      const float u0 = bf2f(uu.x & 0xffffu), u1 = __uint_as_float(uu.x & 0xffff0000u), u2 = bf2f(uu.y & 0xffffu), u3 = __uint_as_float(uu.y & 0xffff0000u);
      accv[0] = u0 - accv[0]; accv[1] = u1 - accv[1]; accv[2] = u2 - accv[2]; accv[3] = u3 - accv[3]; }
#pragma unroll
    for (int jj = 0; jj < 4; ++jj) VnT[(e0 + 4 * fq + jj) * 72 + i0 + fr] = (bf16_t)f2bf(accv[jj]);
    WG_SYNC();
    acco = mm16((const LAS bf16_t*)(buf + GS_AT) + i0 * 72, 72, VnT + e0 * 72, 72, 64, acco, fr, fq);
    { u32x2 w; w.x = pk2(acco[0], acco[1]); w.y = pk2(acco[2], acco[3]); *(u32x2*)(gop + (size_t)(i0 + fr) * 768 + e0 + 4 * fq) = w; }
#pragma unroll
    for (int et = 0; et < 2; ++et) { sacc[et] = sacc[et] * gl;
        sacc[et] = mm16((const LAS bf16_t*)(buf + GS_KT) + d0 * 72, 72, VnT + 16 * et * 72, 72, 64, sacc[et], fr, fq); }
}
__device__ __forceinline__ void gdn_scan_unit(const KPV& p, int unit, LAS unsigned char* lds, int tid, int wave, int lane) {
    const int bh = unit >> 2, es = unit & 3, b = bh / 6, h = bh % 6;
    const unsigned char* gt0 = p.ws() + WS_GT + (size_t)bh * NCH * GT_UNIT;
    const float* GL = (const float*)(p.ws() + WS_GL) + bh * NCH;
    bf16_t* GO = (bf16_t*)(p.ws() + WS_GO) + (size_t)(b * SEQ) * 768 + h * 128 + es * 32;
    const int fr = lane & 15, fq = lane >> 4;
    LAS bf16_t* ST = (LAS bf16_t*)(lds + GS_ST); LAS bf16_t* VnT = (LAS bf16_t*)(lds + GS_VNT);
    u32x4 pa[8], pb[8];
    gs_load(gt0, es, tid, pa); gs_store(lds, tid, pa);
    gs_load(gt0 + (size_t)GT_UNIT, es, tid, pa);
    LAS float* GLs = (LAS float*)(lds + GS_VNT + 4608);
    if (tid < 32) GLs[tid] = GL[tid];
    f32x4 sacc[2]; sacc[0] = (f32x4){0.f, 0.f, 0.f, 0.f}; sacc[1] = sacc[0];
#pragma unroll 1
    for (int n = 0; n < NCH; n += 2) {
        if (n + 2 < NCH) gs_load(gt0 + (size_t)(n + 2) * GT_UNIT, es, tid, pb);
        gdn_scan_step(lds, ST, VnT, sacc, GLs[n], GO + (size_t)(n * CH) * 768, wave, fr, fq);
        gs_store(lds + GS_BUF, tid, pa);
        if (n + 3 < NCH) gs_load(gt0 + (size_t)(n + 3) * GT_UNIT, es, tid, pa);
        gdn_scan_step(lds + GS_BUF, ST, VnT, sacc, GLs[n + 1], GO + (size_t)((n + 1) * CH) * 768, wave, fr, fq);
        if (n + 2 < NCH) gs_store(lds, tid, pb);
    }
    WG_SYNC();
}

constexpr int S_RAWC = 0, S_RAWB = 17152, S_RAWX = 34304;
constexpr int S_CS = 42880, S_BS = 60288, S_SP = 77696;
constexpr int S_XDT = 95104, S_XSN = 104320, S_MS = 113536;
constexpr int S_F = 122752;
template <int W16, int NI>
__device__ __forceinline__ void ssd_raw_ld(const bf16_t* proj, int tok0, int n, int col, int tid, u32x4 (&v)[NI]) {
#pragma unroll
    for (int k = 0; k < NI; ++k) { const int c = tid + 512 * k, r = c / W16, ch = c % W16; v[k] = (u32x4){0u, 0u, 0u, 0u};
        if (c < 67 * W16 && (n > 0 || r >= 3)) v[k] = *(const u32x4*)(proj + (size_t)(tok0 + r - 3) * PINP + col + ch * 8); }
}
template <int W16, int NI>
__device__ __forceinline__ void ssd_raw_st(LAS bf16_t* dst, int tid, const u32x4 (&v)[NI]) {
#pragma unroll
    for (int k = 0; k < NI; ++k) { const int c = tid + 512 * k, r = c / W16, ch = c % W16;
        if (c < 67 * W16) *(LAS u32x4*)(dst + r * (W16 * 8) + ch * 8) = v[k]; }
}
__device__ __forceinline__ void ssd_conv8(const LAS bf16_t* raw, int rs, int tok, int ch0, const float* cw, const float* cb, int cidx, float* out) {
    const f32x4 b0 = *(const f32x4*)(cb + cidx), b1 = *(const f32x4*)(cb + cidx + 4);
    out[0] = b0.x; out[1] = b0.y; out[2] = b0.z; out[3] = b0.w; out[4] = b1.x; out[5] = b1.y; out[6] = b1.z; out[7] = b1.w;
#pragma unroll
    for (int tap = 0; tap < 4; ++tap) { float x[8]; unpack8(*(const LAS u32x4*)(raw + (tok + tap) * rs + ch0), x);
        const f32x4 w0 = *(const f32x4*)(cw + tap * 1280 + cidx), w1 = *(const f32x4*)(cw + tap * 1280 + cidx + 4);
        out[0] += w0.x * x[0]; out[1] += w0.y * x[1]; out[2] += w0.z * x[2]; out[3] += w0.w * x[3]; out[4] += w1.x * x[4]; out[5] += w1.y * x[5]; out[6] += w1.z * x[6]; out[7] += w1.w * x[7]; }
#pragma unroll
    for (int i = 0; i < 8; ++i) out[i] = fsilu(out[i]);
}
__device__ __forceinline__ void ssd_gates(const KPV& p, int layer, const bf16_t* proj, int tok0, int h, LAS float* F, int lane) {
    const float dtr = bf2f(proj[(size_t)(tok0 + lane) * PINP + PSDT + h]);
    const float dt = fsoftplus(dtr + p.in(14)[layer * 12 + h]);
    const float a = -expf(p.in(13)[layer * 12 + h]) * dt;
    F[lane] = wave_incl_scan(a, lane); F[64 + lane] = dt;
}
__device__ __forceinline__ void ssd_pre_unit(const KPV& p, int layer, int unit, LAS unsigned char* lds, int tid, int wave, int lane) {
    const int b = unit / (NCH * 12), n = (unit / 12) % NCH, h = unit % 12, g = h / 6;
    const int tok0 = b * SEQ + n * CH; const int u3 = (b * 12 + h) * NCH + n;
    const bf16_t* proj = (const bf16_t*)(p.ws() + WS_AP);
    LAS bf16_t* rawB = (LAS bf16_t*)(lds + S_RAWB); LAS bf16_t* rawX = (LAS bf16_t*)(lds + S_RAWX);
    LAS bf16_t* BT = (LAS bf16_t*)(lds + S_BS); LAS bf16_t* XdT = (LAS bf16_t*)(lds + S_XDT); LAS float* F = (LAS float*)(lds + S_F);
    { u32x4 vb[3], vx[2];
      ssd_raw_ld<16, 3>(proj, tok0, n, PSB + g * 128, tid, vb); ssd_raw_ld<8, 2>(proj, tok0, n, PSX + h * 64, tid, vx);
      if (wave == 0) ssd_gates(p, layer, proj, tok0, h, F, lane);
      ssd_raw_st<16, 3>(rawB, tid, vb); ssd_raw_st<8, 2>(rawX, tid, vx); }
    WG_SYNC();
    { const float* cw = p.in(11) + (size_t)layer * 4 * 1280; const float* cb = p.in(12) + (size_t)layer * 1280;
      const int tok = tid >> 3, sub = tid & 7; float o[8];
#pragma unroll
      for (int half = 0; half < 2; ++half) { const int ch0 = sub * 16 + half * 8;
          ssd_conv8(rawB, 128, tok, ch0, cw, cb, 768 + g * 128 + ch0, o);
#pragma unroll
          for (int i = 0; i < 8; ++i) BT[(ch0 + i) * 72 + tok] = (bf16_t)f2bf(o[i]); }
      const float sc = F[64 + tok] * expf(F[63] - F[tok]);
      ssd_conv8(rawX, 64, tok, sub * 8, cw, cb, h * 64 + sub * 8, o);
#pragma unroll
      for (int i = 0; i < 8; ++i) XdT[(sub * 8 + i) * 72 + tok] = (bf16_t)f2bf(o[i] * sc);
    }
    WG_SYNC();
    { const int fr = lane & 15, fq = lane >> 4; bf16_t* st = (bf16_t*)(p.ws() + WS_ST) + (size_t)u3 * 8192;
      for (int job = wave * 4; job < wave * 4 + 4; ++job) { const int pt = job >> 3, kt = job & 7;
          f32x4 acc = (f32x4){0.f, 0.f, 0.f, 0.f};
          acc = mm16(XdT + pt * 16 * 72, 72, BT + kt * 16 * 72, 72, 64, acc, fr, fq);
          u32x2 w; w.x = pk2(acc[0], acc[1]); w.y = pk2(acc[2], acc[3]);
          *(u32x2*)(st + (pt * 16 + fr) * 128 + kt * 16 + 4 * fq) = w; }
      if (tid == 0) ((float*)(p.ws() + WS_CD))[u3] = expf(F[63]);
    }
    WG_SYNC();
}
__device__ __forceinline__ void ssd_scan_items(const KPV& p, int first, int stride) {
    bf16_t* st = (bf16_t*)(p.ws() + WS_ST); const float* CD = (const float*)(p.ws() + WS_CD);
    for (int it = first; it < 96 * 1024; it += stride) { const int bh = it >> 10, vec = it & 1023;
        float S[8];
#pragma unroll
        for (int i = 0; i < 8; ++i) S[i] = 0.f;
        u32x4* base = (u32x4*)(st + ((size_t)bh * NCH * 8192 + vec * 8));
#pragma unroll 1
        for (int n0 = 0; n0 < NCH; n0 += 8) { u32x4 v[8]; float cd[8];
#pragma unroll
            for (int k = 0; k < 8; ++k) { v[k] = base[(size_t)(n0 + k) * 1024]; cd[k] = CD[bh * NCH + n0 + k]; }
#pragma unroll
            for (int k = 0; k < 8; ++k) { float x[8]; unpack8(v[k], x);
                u32x4 o; o.x = pk2(S[0], S[1]); o.y = pk2(S[2], S[3]); o.z = pk2(S[4], S[5]); o.w = pk2(S[6], S[7]); base[(size_t)(n0 + k) * 1024] = o;
#pragma unroll
                for (int i = 0; i < 8; ++i) S[i] = S[i] * cd[k] + x[i]; } }
    }
}
__device__ __forceinline__ void ssd_out_unit(const KPV& p, int layer, int unit, LAS unsigned char* lds, int tid, int wave, int lane) {
    const int b = unit / (NCH * 12), n = (unit / 12) % NCH, h = unit % 12, g = h / 6;
    const int tok0 = b * SEQ + n * CH; const int u3 = (b * 12 + h) * NCH + n;
    const bf16_t* proj = (const bf16_t*)(p.ws() + WS_AP);
    LAS bf16_t* rawC = (LAS bf16_t*)(lds + S_RAWC); LAS bf16_t* rawB = (LAS bf16_t*)(lds + S_RAWB); LAS bf16_t* rawX = (LAS bf16_t*)(lds + S_RAWX);
    LAS bf16_t* Cs = (LAS bf16_t*)(lds + S_CS); LAS bf16_t* Bs = (LAS bf16_t*)(lds + S_BS); LAS bf16_t* Sp = (LAS bf16_t*)(lds + S_SP);
    LAS bf16_t* XdT = (LAS bf16_t*)(lds + S_XDT); LAS bf16_t* XsN = (LAS bf16_t*)(lds + S_XSN); LAS bf16_t* Ms = (LAS bf16_t*)(lds + S_MS); LAS float* F = (LAS float*)(lds + S_F);
    { u32x4 vc[3], vb[3], vx[2], vs[2]; const bf16_t* st = (const bf16_t*)(p.ws() + WS_ST) + (size_t)u3 * 8192;
      ssd_raw_ld<16, 3>(proj, tok0, n, PSC + g * 128, tid, vc); ssd_raw_ld<16, 3>(proj, tok0, n, PSB + g * 128, tid, vb); ssd_raw_ld<8, 2>(proj, tok0, n, PSX + h * 64, tid, vx);
#pragma unroll
      for (int k = 0; k < 2; ++k) { const int c = tid + 512 * k; vs[k] = *(const u32x4*)(st + (c >> 4) * 128 + (c & 15) * 8); }
      if (wave == 0) ssd_gates(p, layer, proj, tok0, h, F, lane);
      ssd_raw_st<16, 3>(rawC, tid, vc); ssd_raw_st<16, 3>(rawB, tid, vb); ssd_raw_st<8, 2>(rawX, tid, vx);
#pragma unroll
      for (int k = 0; k < 2; ++k) { const int c = tid + 512 * k; *(LAS u32x4*)(Sp + (c >> 4) * 136 + (c & 15) * 8) = vs[k]; } }
    WG_SYNC();
    { const float* cw = p.in(11) + (size_t)layer * 4 * 1280; const float* cb = p.in(12) + (size_t)layer * 1280;
      const int tok = tid >> 3, sub = tid & 7; float o[8];
#pragma unroll
      for (int half = 0; half < 2; ++half) { const int ch0 = sub * 16 + half * 8; u32x4 w;
          ssd_conv8(rawC, 128, tok, ch0, cw, cb, 1024 + g * 128 + ch0, o);
          w.x = pk2(o[0], o[1]); w.y = pk2(o[2], o[3]); w.z = pk2(o[4], o[5]); w.w = pk2(o[6], o[7]); *(LAS u32x4*)(Cs + tok * 136 + ch0) = w;
          ssd_conv8(rawB, 128, tok, ch0, cw, cb, 768 + g * 128 + ch0, o);
          w.x = pk2(o[0], o[1]); w.y = pk2(o[2], o[3]); w.z = pk2(o[4], o[5]); w.w = pk2(o[6], o[7]); *(LAS u32x4*)(Bs + tok * 136 + ch0) = w; }
      const float dt = F[64 + tok];
      ssd_conv8(rawX, 64, tok, sub * 8, cw, cb, h * 64 + sub * 8, o);
      { u32x4 w; w.x = pk2(o[0], o[1]); w.y = pk2(o[2], o[3]); w.z = pk2(o[4], o[5]); w.w = pk2(o[6], o[7]); *(LAS u32x4*)(XsN + tok * 72 + sub * 8) = w; }
#pragma unroll
      for (int i = 0; i < 8; ++i) XdT[(sub * 8 + i) * 72 + tok] = (bf16_t)f2bf(o[i] * dt);
    }
    WG_SYNC();
    const int fr = lane & 15, fq = lane >> 4;
    for (int t = wave * 2; t < wave * 2 + 2; ++t) { const int ti = t >> 2, tj = t & 3;
        f32x4 acc = (f32x4){0.f, 0.f, 0.f, 0.f};
        acc = mm16(Cs + ti * 16 * 136, 136, Bs + tj * 16 * 136, 136, 128, acc, fr, fq);
        const int i = ti * 16 + fr, j0 = tj * 16 + 4 * fq; const float ai = F[i]; float o[4];
#pragma unroll
        for (int jj = 0; jj < 4; ++jj) o[jj] = (i >= j0 + jj) ? acc[jj] * expf(ai - F[j0 + jj]) : 0.f;
        u32x2 w; w.x = pk2(o[0], o[1]); w.y = pk2(o[2], o[3]); *(LAS u32x2*)(Ms + i * 72 + j0) = w; }
    WG_SYNC();
    { const float Dh = p.in(15)[layer * 12 + h]; float* YS = (float*)(p.ws() + WS_XN);
      for (int t = wave * 2; t < wave * 2 + 2; ++t) { const int ti = t >> 2, tp = t & 3;
          f32x4 yd = (f32x4){0.f, 0.f, 0.f, 0.f}, yo = yd;
          yd = mm16(Ms + ti * 16 * 72, 72, XdT + tp * 16 * 72, 72, 64, yd, fr, fq);
          yo = mm16(Cs + ti * 16 * 136, 136, Sp + tp * 16 * 136, 136, 128, yo, fr, fq);
          const int i = ti * 16 + fr, p0 = tp * 16 + 4 * fq; const float ea = expf(F[i]);
          const u32x2 xv = *(const LAS u32x2*)(XsN + i * 72 + p0);
          const u32x2 zv = *(const u32x2*)(proj + (size_t)(tok0 + i) * PINP + PSZ + h * 64 + p0);
          const float xs0 = bf2f(xv.x & 0xffffu), xs1 = __uint_as_float(xv.x & 0xffff0000u), xs2 = bf2f(xv.y & 0xffffu), xs3 = __uint_as_float(xv.y & 0xffff0000u);
          const float z0 = bf2f(zv.x & 0xffffu), z1 = __uint_as_float(zv.x & 0xffff0000u), z2 = bf2f(zv.y & 0xffffu), z3 = __uint_as_float(zv.y & 0xffff0000u);
          f32x4 y; y.x = (yd[0] + yo[0] * ea + Dh * xs0) * fsilu(z0); y.y = (yd[1] + yo[1] * ea + Dh * xs1) * fsilu(z1);
          y.z = (yd[2] + yo[2] * ea + Dh * xs2) * fsilu(z2); y.w = (yd[3] + yo[3] * ea + Dh * xs3) * fsilu(z3);
          *(f32x4*)(YS + (size_t)(tok0 + i) * 768 + h * 64 + p0) = y; }
    }
    WG_SYNC();
}

__device__ __forceinline__ void ssd_gates6(const KPV& p, int layer, const bf16_t* proj, int tok0, int g, LAS float* F, int wave, int lane) {
    if (wave < 6) { const int h = g * 6 + wave;
        const float dtr = bf2f(proj[(size_t)(tok0 + lane) * PINP + PSDT + h]);
        const float dt = fsoftplus(dtr + p.in(14)[layer * 12 + h]);
        const float a = -expf(p.in(13)[layer * 12 + h]) * dt;
        F[wave * 64 + lane] = wave_incl_scan(a, lane); F[384 + wave * 64 + lane] = dt; }
}
constexpr int SG_RAWB = 0, SG_RAWX = 17152, SG_BT = 68608, SG_XDT = 87040, SG_F = 142336;
__device__ __forceinline__ void ssd_pre_g(const KPV& p, int layer, int unit, LAS unsigned char* lds, int tid, int wave, int lane) {
    const int b = unit / (NCH * 2), n = (unit >> 1) % NCH, g = unit & 1;
    const int tok0 = b * SEQ + n * CH;
    const bf16_t* proj = (const bf16_t*)(p.ws() + WS_AP);
    LAS bf16_t* rawB = (LAS bf16_t*)(lds + SG_RAWB); LAS bf16_t* rawX = (LAS bf16_t*)(lds + SG_RAWX);
    LAS bf16_t* BT = (LAS bf16_t*)(lds + SG_BT); LAS bf16_t* XdT = (LAS bf16_t*)(lds + SG_XDT); LAS float* F = (LAS float*)(lds + SG_F);
    { u32x4 vb[3], vx[7];
      ssd_raw_ld<16, 3>(proj, tok0, n, PSB + g * 128, tid, vb); ssd_raw_ld<48, 7>(proj, tok0, n, PSX + g * 384, tid, vx);
      ssd_gates6(p, layer, proj, tok0, g, F, wave, lane);
      ssd_raw_st<16, 3>(rawB, tid, vb); ssd_raw_st<48, 7>(rawX, tid, vx); }
    WG_SYNC();
    { const float* cw = p.in(11) + (size_t)layer * 4 * 1280; const float* cb = p.in(12) + (size_t)layer * 1280;
      const int tok = tid >> 3, sub = tid & 7; float o[8];
#pragma unroll
      for (int half = 0; half < 2; ++half) { const int ch0 = sub * 16 + half * 8;
          ssd_conv8(rawB, 128, tok, ch0, cw, cb, 768 + g * 128 + ch0, o);
#pragma unroll
          for (int i = 0; i < 8; ++i) BT[(ch0 + i) * 72 + tok] = (bf16_t)f2bf(o[i]); }
#pragma unroll 1
      for (int hh = 0; hh < 6; ++hh) { const float sc = F[384 + hh * 64 + tok] * expf(F[hh * 64 + 63] - F[hh * 64 + tok]);
          ssd_conv8(rawX, 384, tok, hh * 64 + sub * 8, cw, cb, (g * 6 + hh) * 64 + sub * 8, o);
#pragma unroll
          for (int i = 0; i < 8; ++i) XdT[(hh * 64 + sub * 8 + i) * 72 + tok] = (bf16_t)f2bf(o[i] * sc); }
    }
    WG_SYNC();
    { const int fr = lane & 15, fq = lane >> 4; bf16_t* stb = (bf16_t*)(p.ws() + WS_ST);
      for (int job = wave * 24; job < wave * 24 + 24; ++job) { const int hh = job >> 5, pt = (job >> 3) & 3, kt = job & 7;
          f32x4 acc = (f32x4){0.f, 0.f, 0.f, 0.f};
          acc = mm16(XdT + (hh * 64 + pt * 16) * 72, 72, BT + kt * 16 * 72, 72, 64, acc, fr, fq);
          u32x2 w; w.x = pk2(acc[0], acc[1]); w.y = pk2(acc[2], acc[3]);
          *(u32x2*)(stb + (size_t)((b * 12 + g * 6 + hh) * NCH + n) * 8192 + (pt * 16 + fr) * 128 + kt * 16 + 4 * fq) = w; }
      if (tid < 6) ((float*)(p.ws() + WS_CD))[(b * 12 + g * 6 + tid) * NCH + n] = expf(F[tid * 64 + 63]);
    }
    WG_SYNC();
}
constexpr int OG_RAWC = 0, OG_RAWB = 17152, OG_RAWX = 34304, OG_CS = 85760, OG_BS = 103168, OG_XDT = 120576, OG_XSN = 129792, OG_F = 139008, OG_SP = 0, OG_MS = 17408;
__device__ __forceinline__ void ssd_out_g(const KPV& p, int layer, int unit, LAS unsigned char* lds, int tid, int wave, int lane) {
    const int b = unit / (NCH * 2), n = (unit >> 1) % NCH, g = unit & 1;
    const int tok0 = b * SEQ + n * CH;
    const bf16_t* proj = (const bf16_t*)(p.ws() + WS_AP);
    LAS bf16_t* rawC = (LAS bf16_t*)(lds + OG_RAWC); LAS bf16_t* rawB = (LAS bf16_t*)(lds + OG_RAWB); LAS bf16_t* rawX = (LAS bf16_t*)(lds + OG_RAWX);
    LAS bf16_t* Cs = (LAS bf16_t*)(lds + OG_CS); LAS bf16_t* Bs = (LAS bf16_t*)(lds + OG_BS); LAS bf16_t* Sp = (LAS bf16_t*)(lds + OG_SP);
    LAS bf16_t* XdT = (LAS bf16_t*)(lds + OG_XDT); LAS bf16_t* XsN = (LAS bf16_t*)(lds + OG_XSN); LAS bf16_t* Ms = (LAS bf16_t*)(lds + OG_MS); LAS float* F = (LAS float*)(lds + OG_F);
    const float* cw = p.in(11) + (size_t)layer * 4 * 1280; const float* cb = p.in(12) + (size_t)layer * 1280;
    const int tok = tid >> 3, sub = tid & 7, fr = lane & 15, fq = lane >> 4;
    { u32x4 vc[3], vb[3], vx[7];
      ssd_raw_ld<16, 3>(proj, tok0, n, PSC + g * 128, tid, vc); ssd_raw_ld<16, 3>(proj, tok0, n, PSB + g * 128, tid, vb); ssd_raw_ld<48, 7>(proj, tok0, n, PSX + g * 384, tid, vx);
      ssd_gates6(p, layer, proj, tok0, g, F, wave, lane);
      ssd_raw_st<16, 3>(rawC, tid, vc); ssd_raw_st<16, 3>(rawB, tid, vb); ssd_raw_st<48, 7>(rawX, tid, vx); }
    WG_SYNC();
    { float o[8];
#pragma unroll
      for (int half = 0; half < 2; ++half) { const int ch0 = sub * 16 + half * 8; u32x4 w;
          ssd_conv8(rawC, 128, tok, ch0, cw, cb, 1024 + g * 128 + ch0, o);
          w.x = pk2(o[0], o[1]); w.y = pk2(o[2], o[3]); w.z = pk2(o[4], o[5]); w.w = pk2(o[6], o[7]); *(LAS u32x4*)(Cs + tok * 136 + ch0) = w;
          ssd_conv8(rawB, 128, tok, ch0, cw, cb, 768 + g * 128 + ch0, o);
          w.x = pk2(o[0], o[1]); w.y = pk2(o[2], o[3]); w.z = pk2(o[4], o[5]); w.w = pk2(o[6], o[7]); *(LAS u32x4*)(Bs + tok * 136 + ch0) = w; } }
    WG_SYNC();
    f32x4 cbt[2];
#pragma unroll
    for (int q = 0; q < 2; ++q) { const int t = wave * 2 + q, ti = t >> 2, tj = t & 3; cbt[q] = (f32x4){0.f, 0.f, 0.f, 0.f};
        cbt[q] = mm16(Cs + ti * 16 * 136, 136, Bs + tj * 16 * 136, 136, 128, cbt[q], fr, fq); }
    const bf16_t* stb = (const bf16_t*)(p.ws() + WS_ST); float* YS = (float*)(p.ws() + WS_XN);
    u32x4 vs[2];
#pragma unroll
    for (int k = 0; k < 2; ++k) { const int c = tid + 512 * k; vs[k] = *(const u32x4*)(stb + (size_t)((b * 12 + g * 6) * NCH + n) * 8192 + (c >> 4) * 128 + (c & 15) * 8); }
#pragma unroll 1
    for (int hh = 0; hh < 6; ++hh) { const int h = g * 6 + hh;
#pragma unroll
        for (int k = 0; k < 2; ++k) { const int c = tid + 512 * k; *(LAS u32x4*)(Sp + (c >> 4) * 136 + (c & 15) * 8) = vs[k]; }
        if (hh + 1 < 6) {
#pragma unroll
            for (int k = 0; k < 2; ++k) { const int c = tid + 512 * k; vs[k] = *(const u32x4*)(stb + (size_t)((b * 12 + h + 1) * NCH + n) * 8192 + (c >> 4) * 128 + (c & 15) * 8); } }
        u32x2 zv[2];
#pragma unroll
        for (int q = 0; q < 2; ++q) { const int t = wave * 2 + q, ti = t >> 2, tp = t & 3; zv[q] = *(const u32x2*)(proj + (size_t)(tok0 + ti * 16 + fr) * PINP + PSZ + h * 64 + tp * 16 + 4 * fq); }
        { float o[8]; const float dt = F[384 + hh * 64 + tok];
          ssd_conv8(rawX, 384, tok, hh * 64 + sub * 8, cw, cb, h * 64 + sub * 8, o);
          u32x4 w; w.x = pk2(o[0], o[1]); w.y = pk2(o[2], o[3]); w.z = pk2(o[4], o[5]); w.w = pk2(o[6], o[7]); *(LAS u32x4*)(XsN + tok * 72 + sub * 8) = w;
#pragma unroll
          for (int i = 0; i < 8; ++i) XdT[(sub * 8 + i) * 72 + tok] = (bf16_t)f2bf(o[i] * dt); }
#pragma unroll
        for (int q = 0; q < 2; ++q) { const int t = wave * 2 + q, ti = t >> 2, tj = t & 3, i = ti * 16 + fr, j0 = tj * 16 + 4 * fq; const float ai = F[hh * 64 + i]; float o[4];
#pragma unroll
            for (int jj = 0; jj < 4; ++jj) o[jj] = (i >= j0 + jj) ? cbt[q][jj] * expf(ai - F[hh * 64 + j0 + jj]) : 0.f;
            u32x2 w; w.x = pk2(o[0], o[1]); w.y = pk2(o[2], o[3]); *(LAS u32x2*)(Ms + i * 72 + j0) = w; }
        WG_SYNC();
        { const float Dh = p.in(15)[layer * 12 + h];
#pragma unroll
          for (int q = 0; q < 2; ++q) { const int t = wave * 2 + q, ti = t >> 2, tp = t & 3;
              f32x4 yd = (f32x4){0.f, 0.f, 0.f, 0.f}, yo = yd;
              yd = mm16(Ms + ti * 16 * 72, 72, XdT + tp * 16 * 72, 72, 64, yd, fr, fq);
              yo = mm16(Cs + ti * 16 * 136, 136, Sp + tp * 16 * 136, 136, 128, yo, fr, fq);
              const int i = ti * 16 + fr, p0 = tp * 16 + 4 * fq; const float ea = expf(F[hh * 64 + i]);
              const u32x2 xv = *(const LAS u32x2*)(XsN + i * 72 + p0); const u32x2 z2 = zv[q];
              const float xs0 = bf2f(xv.x & 0xffffu), xs1 = __uint_as_float(xv.x & 0xffff0000u), xs2 = bf2f(xv.y & 0xffffu), xs3 = __uint_as_float(xv.y & 0xffff0000u);
              const float z0 = bf2f(z2.x & 0xffffu), z1 = __uint_as_float(z2.x & 0xffff0000u), z2f = bf2f(z2.y & 0xffffu), z3 = __uint_as_float(z2.y & 0xffff0000u);
              f32x4 y; y.x = (yd[0] + yo[0] * ea + Dh * xs0) * fsilu(z0); y.y = (yd[1] + yo[1] * ea + Dh * xs1) * fsilu(z1);
              y.z = (yd[2] + yo[2] * ea + Dh * xs2) * fsilu(z2f); y.w = (yd[3] + yo[3] * ea + Dh * xs3) * fsilu(z3);
              *(f32x4*)(YS + (size_t)(tok0 + i) * 768 + h * 64 + p0) = y; }
        }
        WG_SYNC();
    }
}

constexpr int S5_WAVE_LDS = 12800;
struct S5Par { float abr, abi; float bbr[16], bbi[16]; };
__device__ __forceinline__ void s5_params(const KPV& p, int layer, int g, int n, S5Par& P) {
    const int gi = (layer * 32 + g) * 64 + n;
    const float are = p.in(17)[gi], aim = p.in(18)[gi], delta = expf(p.in(24)[layer * 32 + g]);
    const float mag = expf(are * delta); float sn, cs; sincosf(aim * delta, &sn, &cs);
    P.abr = mag * cs; P.abi = mag * sn;
    const float den = are * are + aim * aim, pre = P.abr - 1.f, pim = P.abi;
    const float fre = (pre * are + pim * aim) / den, fim = (pim * are - pre * aim) / den;
    const float* br = p.in(19) + (size_t)gi * 16; const float* bi = p.in(20) + (size_t)gi * 16;
#pragma unroll
    for (int i4 = 0; i4 < 4; ++i4) { const f32x4 r = *(const f32x4*)(br + 4 * i4), im = *(const f32x4*)(bi + 4 * i4);
#pragma unroll
        for (int j = 0; j < 4; ++j) { P.bbr[4 * i4 + j] = fre * r[j] - fim * im[j]; P.bbi[4 * i4 + j] = fre * im[j] + fim * r[j]; } }
}
__device__ __forceinline__ void s5_load_u(const bf16_t* proj, int tok0, int g, LAS float* Us, int lane) {
    const bf16_t* src = proj + (size_t)(tok0 + lane) * PINP + PU + g * 16;
    float x[16]; unpack8(*(const u32x4*)src, x); unpack8(*(const u32x4*)(src + 8), x + 8);
#pragma unroll
    for (int i4 = 0; i4 < 4; ++i4) *(LAS f32x4*)(Us + lane * 16 + 4 * i4) = (f32x4){x[4 * i4], x[4 * i4 + 1], x[4 * i4 + 2], x[4 * i4 + 3]};
    asm volatile("s_waitcnt lgkmcnt(0)" ::: "memory"); __builtin_amdgcn_wave_barrier();
}
__device__ __forceinline__ void s5_step(const S5Par& P, const LAS float* Us, int t, float& hr, float& hi) {
    float bur = 0.f, bui = 0.f;
#pragma unroll
    for (int i4 = 0; i4 < 4; ++i4) { const f32x4 u = *(const LAS f32x4*)(Us + t * 16 + 4 * i4);
#pragma unroll
        for (int j = 0; j < 4; ++j) { bur += u[j] * P.bbr[4 * i4 + j]; bui += u[j] * P.bbi[4 * i4 + j]; } }
    const float nr = P.abr * hr - P.abi * hi + bur, ni = P.abr * hi + P.abi * hr + bui; hr = nr; hi = ni;
}
__device__ __forceinline__ void s5_pass1(const KPV& p, int layer, int wu, LAS unsigned char* wl, int lane, const S5Par& P) {
    const int b = wu / (NCH * 32), c = (wu / 32) % NCH, g = wu % 32;
    const bf16_t* proj = (const bf16_t*)(p.ws() + WS_AP); LAS float* Us = (LAS float*)wl;
    s5_load_u(proj, b * SEQ + c * CH, g, Us, lane);
    float hr = 0.f, hi = 0.f;
#pragma unroll 4
    for (int t = 0; t < CH; ++t) s5_step(P, Us, t, hr, hi);
    ((f32x2*)(p.ws() + WS_E5))[(size_t)((b * NCH + c) * 32 + g) * 64 + lane] = (f32x2){hr, hi};
    asm volatile("s_waitcnt lgkmcnt(0)" ::: "memory"); __builtin_amdgcn_wave_barrier();
}
__device__ __forceinline__ void s5_shadow_unit(const KPV& p, int layer, int wu, LAS unsigned char* wl, int lane) { S5Par P; s5_params(p, layer, wu & 31, lane, P); s5_pass1(p, layer, wu, wl, lane, P); }
__device__ __forceinline__ float gelu_tanh(float y) { const float x = 0.7978845608028654f * (y + 0.044715f * y * y * y); const float t = 1.f - 2.f / (__expf(2.f * x) + 1.f); return 0.5f * y * (1.f + t); }
__device__ __forceinline__ void s5_setup_c(const KPV& p, int layer, int g, LAS unsigned char* wl, int lane) {
    LAS bf16_t* Cc = (LAS bf16_t*)(wl + 8448);
    const float* cr = p.in(21) + (size_t)(layer * 32 + g) * 16 * 64; const float* ci = p.in(22) + (size_t)(layer * 32 + g) * 16 * 64;
#pragma unroll
    for (int i = 0; i < 16; ++i) *(LAS unsigned*)(Cc + i * 136 + 2 * lane) = pk2(cr[i * 64 + lane], -ci[i * 64 + lane]);
}
__device__ __forceinline__ void s5_pass2(const KPV& p, int layer, int wu, LAS unsigned char* wl, int lane, const S5Par& P) {
    const int b = wu / (NCH * 32), c = (wu / 32) % NCH, g = wu % 32;
    const bf16_t* proj = (const bf16_t*)(p.ws() + WS_AP); LAS float* Us = (LAS float*)wl; LAS bf16_t* Hs = (LAS bf16_t*)(wl + 4096); LAS bf16_t* Cc = (LAS bf16_t*)(wl + 8448);
    const int tok0 = b * SEQ + c * CH;
    s5_load_u(proj, tok0, g, Us, lane);
    float a64r = P.abr, a64i = P.abi;
#pragma unroll
    for (int s = 0; s < 6; ++s) { const float r = a64r * a64r - a64i * a64i, i2 = 2.f * a64r * a64i; a64r = r; a64i = i2; }
    float hr = 0.f, hi = 0.f;
    { const f32x2* E = (const f32x2*)(p.ws() + WS_E5) + (size_t)(b * NCH * 32 + g) * 64 + lane;
#pragma unroll 1
      for (int cc0 = 0; cc0 < c; cc0 += 8) { f32x2 e[8];
#pragma unroll
          for (int k = 0; k < 8; ++k) e[k] = (cc0 + k < c) ? E[(size_t)(cc0 + k) * 32 * 64] : (f32x2){0.f, 0.f};
#pragma unroll
          for (int k = 0; k < 8; ++k) if (cc0 + k < c) { const float nr = a64r * hr - a64i * hi + e[k].x, ni = a64r * hi + a64i * hr + e[k].y; hr = nr; hi = ni; } } }
    const int fr = lane & 15, fq = lane >> 4;
    const f32x4 dsk = *(const f32x4*)(p.in(23) + layer * 512 + g * 16 + 4 * fq);
    bf16_t* G5 = (bf16_t*)(p.ws() + WS_G5);
    for (int sb = 0; sb < 4; ++sb) {
#pragma unroll 4
        for (int t = 0; t < 16; ++t) { s5_step(P, Us, sb * 16 + t, hr, hi); *(LAS unsigned*)(Hs + t * 136 + 2 * lane) = pk2(hr, hi); }
        asm volatile("s_waitcnt lgkmcnt(0)" ::: "memory"); __builtin_amdgcn_wave_barrier();
        f32x4 acc = (f32x4){0.f, 0.f, 0.f, 0.f};
        acc = mm16(Hs, 136, Cc, 136, 128, acc, fr, fq);
        const f32x4 uu = *(const LAS f32x4*)(Us + (sb * 16 + fr) * 16 + 4 * fq);
        u32x2 w; w.x = pk2(gelu_tanh(acc[0] + dsk.x * uu.x), gelu_tanh(acc[1] + dsk.y * uu.y)); w.y = pk2(gelu_tanh(acc[2] + dsk.z * uu.z), gelu_tanh(acc[3] + dsk.w * uu.w));
        *(u32x2*)(G5 + (size_t)(tok0 + sb * 16 + fr) * 512 + g * 16 + 4 * fq) = w;
        asm volatile("s_waitcnt lgkmcnt(0)" ::: "memory"); __builtin_amdgcn_wave_barrier();
    }
}

__device__ __forceinline__ void gdn_finish(const KPV& p, int layer, int first, int stride, int lane) {
    const bf16_t* GO = (const bf16_t*)(p.ws() + WS_GO); const bf16_t* proj = (const bf16_t*)(p.ws() + WS_AP); bf16_t* MX = (bf16_t*)(p.ws() + WS_MIX);
    const int l = lane & 31; const f32x4 wv = *(const f32x4*)(p.in(10) + layer * 128 + 4 * l);
    constexpr int NIT = M * 6 / 2;
    for (int it0 = first; it0 < NIT; it0 += 4 * stride) { u32x2 ov[4], zv[4];
#pragma unroll
        for (int k = 0; k < 4; ++k) { const int it = it0 + k * stride; if (it < NIT) { const int th = it * 2 + (lane >> 5), tok = th / 6, h = th % 6;
            ov[k] = *(const u32x2*)(GO + (size_t)tok * 768 + h * 128 + 4 * l); zv[k] = *(const u32x2*)(proj + (size_t)tok * PINP + PZ + h * 128 + 4 * l); } }
#pragma unroll
        for (int k = 0; k < 4; ++k) { const int it = it0 + k * stride; if (it < NIT) { const int th = it * 2 + (lane >> 5), tok = th / 6, h = th % 6;
            const float o0 = bf2f(ov[k].x & 0xffffu), o1 = __uint_as_float(ov[k].x & 0xffff0000u), o2 = bf2f(ov[k].y & 0xffffu), o3 = __uint_as_float(ov[k].y & 0xffff0000u);
            const float z0 = bf2f(zv[k].x & 0xffffu), z1 = __uint_as_float(zv[k].x & 0xffff0000u), z2 = bf2f(zv[k].y & 0xffffu), z3 = __uint_as_float(zv[k].y & 0xffff0000u);
            float ss = (o0 * o0 + o1 * o1) + (o2 * o2 + o3 * o3);
            ss += __shfl_xor(ss, 1); ss += __shfl_xor(ss, 2); ss += __shfl_xor(ss, 4); ss += __shfl_xor(ss, 8); ss += __shfl_xor(ss, 16);
            const float r = rsqrtf(ss * (1.f / 128.f) + EPS);
            u32x2 w; w.x = pk2(o0 * r * wv.x * fsilu(z0), o1 * r * wv.y * fsilu(z1)); w.y = pk2(o2 * r * wv.z * fsilu(z2), o3 * r * wv.w * fsilu(z3));
            *(u32x2*)(MX + (size_t)tok * 2048 + h * 128 + 4 * l) = w; } }
    }
}
__device__ __forceinline__ void ssd_finish(const KPV& p, int layer, int first, int stride, int lane) {
    const float* YS = (const float*)(p.ws() + WS_XN); bf16_t* MX = (bf16_t*)(p.ws() + WS_MIX); const float* nw = p.in(16) + layer * 768;
    for (int it0 = first; it0 < M * 2; it0 += 4 * stride) { f32x2 v[4][3];
#pragma unroll
        for (int k = 0; k < 4; ++k) { const int it = it0 + k * stride; if (it < M * 2) { const float* y = YS + (size_t)(it >> 1) * 768 + (it & 1) * 384;
#pragma unroll
            for (int q = 0; q < 3; ++q) v[k][q] = *(const f32x2*)(y + 2 * lane + 128 * q); } }
#pragma unroll
        for (int k = 0; k < 4; ++k) { const int it = it0 + k * stride; if (it < M * 2) { const int tok = it >> 1, g = it & 1; float ss = 0.f;
#pragma unroll
            for (int q = 0; q < 3; ++q) ss += v[k][q].x * v[k][q].x + v[k][q].y * v[k][q].y;
            const float r = rsqrtf(wave_sum(ss) * (1.f / 384.f) + EPS);
#pragma unroll
            for (int q = 0; q < 3; ++q) { const f32x2 w = *(const f32x2*)(nw + g * 384 + 2 * lane + 128 * q);
                *(unsigned*)(MX + (size_t)tok * 2048 + 768 + g * 384 + 2 * lane + 128 * q) = pk2(v[k][q].x * r * w.x, v[k][q].y * r * w.y); } } }
    }
}

#define XB_TMO      128
#define XB_XCNT(j)  (256  + 64 * (j))
#define XB_XSUB(j)  (1280 + 64 * (j))
#define XB_XGEN(j)  (2304 + 64 * (j))
#define XB_TOP      3328
#define XB_TOPGEN   3392
#define XCD_BAR_WORDS 3456
#define XB_SPIN_CAP (1u << 18)

__device__ __forceinline__ unsigned xb_ld(unsigned* p)              { return __hip_atomic_load(p, __ATOMIC_RELAXED, __HIP_MEMORY_SCOPE_AGENT); }
__device__ __forceinline__ unsigned xb_add(unsigned* p, unsigned v) { return __hip_atomic_fetch_add(p, v, __ATOMIC_RELAXED, __HIP_MEMORY_SCOPE_AGENT); }
__device__ __forceinline__ unsigned xb_xcc_id() { return (unsigned)__builtin_amdgcn_s_getreg((3 << 11) | 20) & 0xFu; }
#define XB_SPIN(cond, bar) do { unsigned _sp = 0; while (cond) { __builtin_amdgcn_s_sleep(1); \
    if ((++_sp & 255u) == 0u) { if (xb_ld(&(bar)[XB_TMO])) break; if (_sp > XB_SPIN_CAP) { atomicAdd(&(bar)[XB_TMO], 1u); break; } } } } while (0)

struct XcdBarrier {
    unsigned* bar; unsigned x;
    volatile LAS unsigned* st;
};

__device__ __forceinline__ XcdBarrier xcd_barrier_post(unsigned* bar, volatile LAS unsigned* st) {
    XcdBarrier b; b.bar = bar; b.x = xb_xcc_id(); b.st = st;
    if (threadIdx.x == 0) (void)xb_add(&bar[XB_XCNT(b.x)], 1u);
    return b;
}
__device__ __forceinline__ void xcd_barrier_complete(unsigned* bar, unsigned x, unsigned& nloc, unsigned& nx) {
    const unsigned G = gridDim.x * gridDim.y * gridDim.z;
    unsigned sum, cnt, mine, sp = 0u;
    for (;;) {
        sum = 0u; cnt = 0u; mine = 0u;
#pragma unroll
        for (unsigned j = 0; j < 16; ++j) { const unsigned c = xb_ld(&bar[XB_XCNT(j)]); sum += c; cnt += (c > 0u) ? 1u : 0u; mine = (j == x) ? c : mine; }
        if (sum == G) break;
        __builtin_amdgcn_s_sleep(1);
        if ((++sp & 255u) == 0u) { if (xb_ld(&bar[XB_TMO])) break; if (sp > XB_SPIN_CAP) { atomicAdd(&bar[XB_TMO], 1u); break; } }
    }
    nloc = mine > 0u ? mine : 1u; nx = cnt > 0u ? cnt : 1u;
}

__device__ __forceinline__ void xcd_barrier(const XcdBarrier& b) {
    asm volatile("s_waitcnt vmcnt(0)" ::: "memory");
    __syncthreads();
    if (threadIdx.x == 0) {
        unsigned* bar = b.bar;
        __builtin_amdgcn_s_waitcnt(0);
        unsigned nloc = b.st[0], nx = b.st[1];
        if (nloc == 0u) { xcd_barrier_complete(bar, b.x, nloc, nx); b.st[0] = nloc; b.st[1] = nx; }
        const unsigned old = xb_add(&bar[XB_XSUB(b.x)], 1u);
        const unsigned gen = old / nloc;
        if (old + 1u == (gen + 1u) * nloc) {
            __builtin_amdgcn_fence(__ATOMIC_RELEASE, "agent");
            asm volatile("s_waitcnt vmcnt(0)" ::: "memory");
            const unsigned og = xb_add(&bar[XB_TOP], 1u);
            const unsigned tg = og / nx;
            if (og + 1u == (tg + 1u) * nx) xb_add(&bar[XB_TOPGEN], 1u);
            else XB_SPIN(xb_ld(&bar[XB_TOPGEN]) == tg, bar);
            __builtin_amdgcn_fence(__ATOMIC_ACQUIRE, "agent");
            xb_add(&bar[XB_XGEN(b.x)], 1u);
            asm volatile("s_waitcnt vmcnt(0)" ::: "memory");
        } else {
            XB_SPIN(xb_ld(&bar[XB_XGEN(b.x)]) == gen, bar);
            __builtin_amdgcn_fence(__ATOMIC_ACQUIRE, "agent");
            asm volatile("s_waitcnt vmcnt(0)" ::: "memory");
        }
    }
    __syncthreads();
}

constexpr int NPH_LAYER = 13, NPHASES = 2 * NPH_LAYER + 1;
template <int PH, int SEL = 7>
__device__ __forceinline__ void run_phase(LAS unsigned char* lds) {
    const AS4 KP* kp_ = (const AS4 KP*)__builtin_amdgcn_kernarg_segment_ptr();
    asm volatile("" : "+s"(kp_));
    const KPV p{kp_};
    int tid = threadIdx.x; asm volatile("" : "+v"(tid));
    int G = gridDim.x, bid = blockIdx.x; asm volatile("" : "+s"(G), "+s"(bid)); const int NGW = G * 8;
    const int lane = tid & 63, wave = __builtin_amdgcn_readfirstlane(tid >> 6), gw = bid * 8 + wave;
    unsigned char* ws = p.ws(); float* hbuf = p.out();
    bf16_t* HB = (bf16_t*)(ws + WS_H); bf16_t* AP = (bf16_t*)(ws + WS_AP); bf16_t* MX = (bf16_t*)(ws + WS_MIX);
    if constexpr (PH == NPHASES - 1) { norm_phase<true>(hbuf, p.in(32), nullptr, p.out(), gw, NGW, lane); return; }
    constexpr int layer = PH / NPH_LAYER, s = PH % NPH_LAYER;
    if constexpr (s == 0) {
        convert_phase(p, layer, lds, gw, NGW, wave, lane);
        if constexpr (layer == 0) { float* SSQ = (float*)(ws + WS_SSQ);
            norm_raw_phase(p.in(0), nullptr, HB, SSQ, gw, NGW, lane); }
    } else if constexpr (s == 1 || s == 11) {
        pg8::Gemm g{HB, (const bf16_t*)(ws + (s == 1 ? WS_WGU1 : WS_WGU2)), M, 2 * FF, D}; pg8::FixedOrder<64, 44> S{G, bid};
        pg8::rstd_table(S, (const float*)(ws + WS_SSQ) + (size_t)(layer * 3 + (s == 1 ? 0 : 2)) * M * 32, (LAS float*)(lds + 131072));
        pg8::EpiSwiGLU E{AP, FF, (const LAS float*)(lds + 131072)};
        pg8::gemm_phase<pg8::EpiSwiGLU, decltype(S), true, true>(lds, g, S, E);
    } else if constexpr (s == 2 || s == 12) {
        pg8::Gemm g{AP, (const bf16_t*)(ws + (s == 2 ? WS_WD1 : WS_WD2)), M, D, FF}; pg8::FixedOrder<64, 8> S{G, bid};
        if constexpr (layer == 1 && s == 12) { pg8::EpiResidOut E{HB, hbuf, D, 0.5f}; pg8::gemm_phase<pg8::EpiResidOut, decltype(S), true, true>(lds, g, S, E); }
        else { pg8::EpiResidH E{(layer == 0 && s == 2 && SEL != 0) ? p.in(0) : nullptr, HB, D, SEL == 0 ? 0.f : 0.5f,
                                (float*)(ws + WS_SSQ) + (size_t)(s == 2 ? layer * 3 + 1 : (layer + 1) * 3) * M * 32};
            pg8::gemm_phase<pg8::EpiResidH, decltype(S), true, true>(lds, g, S, E); }
    } else if constexpr (s == 4) {
        pg8::Gemm g{HB, (const bf16_t*)(ws + WS_WIN), M, PINP, D}; pg8::FixedOrder<64, 23> S{G, bid};
        pg8::rstd_table(S, (const float*)(ws + WS_SSQ) + (size_t)(layer * 3 + 1) * M * 32, (LAS float*)(lds + 131072));
        pg8::EpiBf16 E{AP, PINP, (const LAS float*)(lds + 131072)};
        pg8::gemm_phase<pg8::EpiBf16, decltype(S), true, true>(lds, g, S, E);
    } else if constexpr (s == 5) {
        int s5_done = 0;
        if (SEL & 1) for (int u = bid, it = 0; u < NBATCH * 6 * NCH; u += G, ++it) { int wu = -1;
            if ((SEL & 4) && wave > 0) { const int slot = it * 7 + (wave - 1); const int cand = bid * 8 + (slot & 7) + (slot >> 3) * NGW; if (cand < NBATCH * NCH * 32) wu = cand; }
            gdn_pre_unit(p, layer, u, lds, tid, wave, lane, wu); if (SEL & 4) s5_done = (it + 1) * 7; }
        if (SEL & 2) for (int u = bid; u < NBATCH * NCH * 2; u += G) ssd_pre_g(p, layer, u, lds, tid, wave, lane);
        if (SEL & 4) for (int slot = s5_done + wave; ; slot += 8) { const int wu = bid * 8 + (slot & 7) + (slot >> 3) * NGW; if (wu >= NBATCH * NCH * 32) break;
            s5_shadow_unit(p, layer, wu, lds + wave * S5_WAVE_LDS, lane); }
    } else if constexpr (s == 6) {
        const int NSC = NBATCH * 6 * 4;
        if (SEL & 1) for (int u = bid; u < NSC; u += G) gdn_scan_unit(p, u, lds, tid, wave, lane);
        if (SEL & 2) { if (G > NSC) { if (bid >= NSC) ssd_scan_items(p, (bid - NSC) * 512 + tid, (G - NSC) * 512); }
        else ssd_scan_items(p, bid * 512 + tid, G * 512); }
    } else if constexpr (s == 7) {
        if (SEL & 2) for (int u = bid; u < NBATCH * NCH * 2; u += G) ssd_out_g(p, layer, u, lds, tid, wave, lane);
        if (SEL & 4) { if ((NGW & 31) == 0) { S5Par P; s5_params(p, layer, gw & 31, lane, P); s5_setup_c(p, layer, gw & 31, lds + wave * S5_WAVE_LDS, lane);
                for (int u = gw; u < NBATCH * NCH * 32; u += NGW) s5_pass2(p, layer, u, lds + wave * S5_WAVE_LDS, lane, P); }
            else for (int u = gw; u < NBATCH * NCH * 32; u += NGW) { S5Par P; s5_params(p, layer, u & 31, lane, P); s5_setup_c(p, layer, u & 31, lds + wave * S5_WAVE_LDS, lane); s5_pass2(p, layer, u, lds + wave * S5_WAVE_LDS, lane, P); } }
    } else if constexpr (s == 8) {
        pg8::Gemm g{(const bf16_t*)(ws + WS_G5), (const bf16_t*)(ws + WS_WGLU), M, 512, 512}; pg8::FixedOrder<64, 2> S{G, bid};
        pg8::EpiGlu E{(const bf16_t*)(ws + WS_G5), 512, MX, 2048, 1536, p.in(26) + layer * 512};
        pg8::gemm_phase<pg8::EpiGlu, decltype(S), true, true>(lds, g, S, E);
        gdn_finish(p, layer, gw, NGW, lane); ssd_finish(p, layer, gw, NGW, lane);
    } else if constexpr (s == 9) {
        pg8::Gemm g{MX, (const bf16_t*)(ws + WS_WOUT), M, D, D}; pg8::FixedOrder<64, 8> S{G, bid};
        pg8::EpiResidH E{nullptr, HB, D, SEL == 0 ? 0.f : 1.0f, (float*)(ws + WS_SSQ) + (size_t)(layer * 3 + 2) * M * 32};
        pg8::gemm_phase<pg8::EpiResidH, decltype(S), true, true>(lds, g, S, E);
    }
}
__global__ void __launch_bounds__(512) mk_fwd(KP pk) {
    extern __shared__ __attribute__((aligned(16))) unsigned char lds_raw[];
    LAS unsigned char* lds = (LAS unsigned char*)lds_raw;
    const int lo = pk.ph_lo, hi = pk.ph_hi;
    volatile LAS unsigned* xst = (volatile LAS unsigned*)(lds + LDS_BYTES - 64);
    if (threadIdx.x < 2) xst[threadIdx.x] = 0u;
    __syncthreads();
    XcdBarrier xbar = xcd_barrier_post((unsigned*)pk.ws, xst);
    bool first_sync = true;
#ifndef DUP_MASK
#define DUP_MASK 0
#endif
#ifndef DUPSEL5
#define DUPSEL5 DUPSEL
#endif
#ifndef DUPSEL
#define DUPSEL 7
#endif
#ifndef DUP_MIXTO
#define DUP_MIXTO 0
#endif
#ifndef EXTRA_SYNCS
#define EXTRA_SYNCS 0
#endif
#define RUN(k) if (lo <= (k) && (k) < hi && (k) % NPH_LAYER != 3 && (k) % NPH_LAYER != 10) { if ((k) > lo) { if (first_sync) { cg::this_grid().sync(); first_sync = false; } else xcd_barrier(xbar); } for (int xs_ = 0; xs_ < EXTRA_SYNCS; ++xs_) xcd_barrier(xbar); run_phase<(k)>(lds); \
        if (((DUP_MASK >> ((k) % NPH_LAYER)) & 1) && (k) < NPHASES - 1) { xcd_barrier(xbar); run_phase<(k), (((k) % NPH_LAYER == 2 || (k) % NPH_LAYER == 9 || (k) % NPH_LAYER == 12) ? 0 : 7)>(lds); } \
        if ((k) % NPH_LAYER == 8 && (k) < NPHASES - 1) { \
            if (DUP_MIXTO >= 5) { cg::this_grid().sync(); run_phase<(k) - 3, DUPSEL5>(lds); } if (DUP_MIXTO >= 6) { cg::this_grid().sync(); run_phase<(k) - 2, DUPSEL>(lds); } \
            if (DUP_MIXTO >= 7) { cg::this_grid().sync(); run_phase<(k) - 1, DUPSEL>(lds); } if (DUP_MIXTO >= 8) { cg::this_grid().sync(); run_phase<(k)>(lds); } } }
    RUN(0) RUN(1) RUN(2) RUN(3) RUN(4) RUN(5) RUN(6) RUN(7) RUN(8) RUN(9) RUN(10) RUN(11) RUN(12)
    RUN(13) RUN(14) RUN(15) RUN(16) RUN(17) RUN(18) RUN(19) RUN(20) RUN(21) RUN(22) RUN(23) RUN(24) RUN(25) RUN(26)
#undef RUN
}

extern "C" void kernel_launch(void* const* d_in, const int* in_sizes, int n_in, void* d_out, int out_size, void* d_ws, size_t ws_size, hipStream_t stream) {
    static int grid = 0;
    if (grid == 0) {
        if (n_in != 33 || in_sizes[0] != M * D || out_size != M * D || ws_size < WS_END) { fprintf(stderr, "kernel_launch: unexpected shapes / workspace (n_in %d, ws %zu < %zu)\n", n_in, ws_size, (size_t)WS_END); grid = -1; return; }
        int dev = 0, cus = 0, per_cu = 0;
        hipGetDevice(&dev); hipDeviceGetAttribute(&cus, hipDeviceAttributeMultiprocessorCount, dev);
        if (hipFuncSetAttribute((const void*)mk_fwd, hipFuncAttributeMaxDynamicSharedMemorySize, LDS_BYTES) != hipSuccess) { fprintf(stderr, "kernel_launch: hipFuncSetAttribute failed\n"); grid = -1; return; }
        if (hipOccupancyMaxActiveBlocksPerMultiprocessor(&per_cu, (const void*)mk_fwd, 512, LDS_BYTES) != hipSuccess || per_cu < 1) { fprintf(stderr, "kernel_launch: occupancy query says %d\n", per_cu); per_cu = 1; }
        (void)hipGetLastError();
        grid = cus;
    }
    if (grid < 0) return;
    if (hipMemsetAsync(d_ws, 0, 16384, stream) != hipSuccess) { fprintf(stderr, "kernel_launch: memset of the barrier words failed\n"); return; }
    KP a{};
    for (int i = 0; i < 33; ++i) a.in[i] = (const float*)d_in[i];
    a.out = (float*)d_out; a.ws = (unsigned char*)d_ws;
#if MK_MULTI
    for (int ph = 0; ph < NPHASES; ++ph) { if (ph % NPH_LAYER == 3 || ph % NPH_LAYER == 10) continue; a.ph_lo = ph; a.ph_hi = ph + 1; hipLaunchKernelGGL(mk_fwd, dim3(grid), dim3(512), LDS_BYTES, stream, a); }
#else
    a.ph_lo = 0; a.ph_hi = NPHASES;
    void* args[] = {&a};
    hipError_t e = hipLaunchCooperativeKernel((const void*)mk_fwd, dim3(grid), dim3(512), args, LDS_BYTES, stream);
    if (e != hipSuccess) fprintf(stderr, "cooperative launch failed: %s (grid %d)\n", hipGetErrorString(e), grid);
#endif
}
```

```cpp
#include <hip/hip_runtime.h>
#include <hip/hip_cooperative_groups.h>
#include <cstdio>
#include <cstdint>
namespace cg = cooperative_groups;
#ifndef MK_MULTI
#define MK_MULTI 0
#endif
#ifndef MIXSEL
#define MIXSEL 7
#endif
namespace pg8 {
#define PG8_LAS __attribute__((address_space(3)))
typedef unsigned short bf16_t;
typedef short bf16x8 __attribute__((ext_vector_type(8)));
typedef float f32x4 __attribute__((ext_vector_type(4)));
typedef unsigned u32x4 __attribute__((ext_vector_type(4)));
constexpr int BM = 256, BK = 64, HALF = 128, HTB = HALF * BK * 2  , STAGE_BYTES = 8 * HTB, NXCD = 8, WGM = 8;

__host__ __device__ __forceinline__ int lds_byte(int r, int c) { const int st = (r >> 4) * 2 + (c >> 5), rr = r & 15, cc = c & 31, ob = rr * 64 + cc * 2; return st * 1024 + (ob ^ (((ob >> 9) & 1) << 5)); }
__host__ __device__ __forceinline__ void stage_rc(int b, int& R, int& C) { const int st = b / 1024, sb = b % 1024, swz = sb ^ (((sb >> 9) & 1) << 5); R = (st >> 1) * 16 + swz / 64; C = (st & 1) * 32 + (swz % 64) / 2; }
__host__ __device__ __forceinline__ int perm32(int rho) { const int n = rho >> 4, i = rho & 15; return 8 * (i >> 2) + 4 * n + (i & 3); }

struct Unit { int pm, pn; };
struct Gemm { const bf16_t* A; const bf16_t* Bt; int M, N, K; };

struct StaticOrder {
    int nM, nN, nwg, G, c;
    __host__ __device__ void init(int M, int N, int G_, int c_) { nM = M / BM; nN = N / BM; nwg = nM * nN; G = G_; c = c_; }
    __host__ __device__ bool next(int i, Unit& u) const {
        const long L = (long)i * G + c; if (L >= nwg) return false;
        int wgid = (int)L; { const int q = nwg / NXCD, r = nwg % NXCD, xcd = wgid % NXCD, off = wgid / NXCD; wgid = (xcd < r ? xcd * (q + 1) : r * (q + 1) + (xcd - r) * q) + off; }
        const int nig = WGM * nN, gid = wgid / nig, fm = gid * WGM, gsz = (nM - fm) < WGM ? (nM - fm) : WGM;
        u.pm = fm + ((wgid % nig) % gsz); u.pn = (wgid % nig) / gsz; return true;
    }
    __device__ __forceinline__ void a_ready(const Unit&) const {}
    __device__ __forceinline__ void done(const Unit&) const {}
};

typedef __bf16 bf16v2_t __attribute__((ext_vector_type(2)));
typedef float f32x2c_t __attribute__((ext_vector_type(2)));
__device__ __forceinline__ unsigned cvt_pk_bf16(float lo, float hi) { const bf16v2_t v = __builtin_convertvector((f32x2c_t){lo, hi}, bf16v2_t); return __builtin_bit_cast(unsigned, v); }
typedef float f32x2 __attribute__((ext_vector_type(2)));
typedef unsigned u32x2 __attribute__((ext_vector_type(2)));
__device__ __forceinline__ float fsilu(float x) { return x / (1.f + __expf(-x)); }
__device__ __forceinline__ float fsigmoid(float x) { return 1.f / (1.f + __expf(-x)); }
template <class Sched>
__device__ __forceinline__ void rstd_table(const Sched& S, const float* ssq, PG8_LAS float* rtab) {
    const int t = threadIdx.x, row = t >> 1, half = t & 1; unsigned done = 0u; Unit u;
    for (int i = 0; S.next(i, u); ++i) { const unsigned bit = 1u << (u.pm & 15); if (done & bit) continue; done |= bit;
        const f32x4* q = (const f32x4*)(ssq + (size_t)(u.pm * BM + row) * 32 + half * 16);
        f32x4 a = (q[0] + q[1]) + (q[2] + q[3]); float s = (a[0] + a[1]) + (a[2] + a[3]); s += __shfl_xor(s, 1);
        if (half == 0) rtab[(u.pm & 15) * 256 + row] = rsqrtf(s * (1.f / 2048.f) + 1e-6f); }
    __syncthreads();
}
struct EpiBf16 {
    static constexpr bool PERM = true, AFTER_DRAIN = false;
    bf16_t* O; int ldc; const PG8_LAS float* rtab;
    __device__ __forceinline__ void operator()(const f32x4 (&acc)[2][2][4][2], const Unit& u, int wr, int wc, int fr, int fq) const {
        const int row0 = u.pm * BM + wr * 64 + fr, col0 = u.pn * BM + wc * 32 + 8 * fq;
#pragma unroll
        for (int ai = 0; ai < 2; ++ai)
#pragma unroll
            for (int m = 0; m < 4; ++m) { bf16_t* rowp = O + (size_t)(row0 + ai * HALF + m * 16) * ldc + col0;
                const float rs = rtab[(u.pm & 15) * 256 + wr * 64 + fr + ai * HALF + m * 16];
#pragma unroll
                for (int bj = 0; bj < 2; ++bj) { const f32x4 v0 = acc[ai][bj][m][0] * rs, v1 = acc[ai][bj][m][1] * rs;
                    u32x4 w; w.x = cvt_pk_bf16(v0[0], v0[1]); w.y = cvt_pk_bf16(v0[2], v0[3]); w.z = cvt_pk_bf16(v1[0], v1[1]); w.w = cvt_pk_bf16(v1[2], v1[3]);
                    *(u32x4*)(rowp + bj * HALF) = w; } }
    }
};
struct EpiSwiGLU {
    static constexpr bool PERM = true, AFTER_DRAIN = false;
    bf16_t* O; int ldc; const PG8_LAS float* rtab;
    __device__ __forceinline__ void operator()(const f32x4 (&acc)[2][2][4][2], const Unit& u, int wr, int wc, int fr, int fq) const {
        const int row0 = u.pm * BM + wr * 64 + fr, col0 = u.pn * HALF + wc * 32 + 8 * fq;
#pragma unroll
        for (int ai = 0; ai < 2; ++ai)
#pragma unroll
            for (int m = 0; m < 4; ++m) { bf16_t* rowp = O + (size_t)(row0 + ai * HALF + m * 16) * ldc + col0;
                const float rs = rtab[(u.pm & 15) * 256 + wr * 64 + fr + ai * HALF + m * 16];
                const f32x4 g0 = acc[ai][0][m][0] * rs, g1 = acc[ai][0][m][1] * rs, u0 = acc[ai][1][m][0] * rs, u1 = acc[ai][1][m][1] * rs;
                u32x4 w; w.x = cvt_pk_bf16(fsilu(g0[0]) * u0[0], fsilu(g0[1]) * u0[1]); w.y = cvt_pk_bf16(fsilu(g0[2]) * u0[2], fsilu(g0[3]) * u0[3]);
                w.z = cvt_pk_bf16(fsilu(g1[0]) * u1[0], fsilu(g1[1]) * u1[1]); w.w = cvt_pk_bf16(fsilu(g1[2]) * u1[2], fsilu(g1[3]) * u1[3]);
                *(u32x4*)rowp = w; }
    }
};
struct EpiResid {
    static constexpr bool PERM = false, AFTER_DRAIN = false;
    const float* base; float* out; int ldc; float s;
    __device__ __forceinline__ void operator()(const f32x4 (&acc)[2][2][4][2], const Unit& u, int wr, int wc, int fr, int fq) const {
        const int row0 = u.pm * BM + wr * 64 + fr, col0 = u.pn * BM + wc * 32 + 4 * fq;
#pragma unroll
        for (int ai = 0; ai < 2; ++ai)
#pragma unroll
            for (int m = 0; m < 4; ++m) { const size_t off = (size_t)(row0 + ai * HALF + m * 16) * ldc + col0;
#pragma unroll
                for (int bj = 0; bj < 2; ++bj)
#pragma unroll
                    for (int n = 0; n < 2; ++n) { const f32x4 b = *(const f32x4*)(base + off + bj * HALF + n * 16);
                        *(f32x4*)(out + off + bj * HALF + n * 16) = b + acc[ai][bj][m][n] * s; } }
    }
};
struct EpiResidH {
    static constexpr bool PERM = false, AFTER_DRAIN = false;
    const float* basef; bf16_t* H; int ldc; float s; float* ssq;
    __device__ __forceinline__ void operator()(const f32x4 (&acc)[2][2][4][2], const Unit& u, int wr, int wc, int fr, int fq) const {
        const int row0 = u.pm * BM + wr * 64 + fr, col0 = u.pn * BM + wc * 32 + 4 * fq;
#pragma unroll
        for (int ai = 0; ai < 2; ++ai)
#pragma unroll
            for (int m = 0; m < 4; ++m) { const int row = row0 + ai * HALF + m * 16; const size_t off = (size_t)row * ldc + col0; float ss = 0.f;
#pragma unroll
                for (int bj = 0; bj < 2; ++bj)
#pragma unroll
                    for (int n = 0; n < 2; ++n) { const int co = bj * HALF + n * 16; f32x4 b;
                        if (basef) b = *(const f32x4*)(basef + off + co);
                        else { const u32x2 hb = *(const u32x2*)(H + off + co); b[0] = __uint_as_float(hb.x << 16); b[1] = __uint_as_float(hb.x & 0xffff0000u); b[2] = __uint_as_float(hb.y << 16); b[3] = __uint_as_float(hb.y & 0xffff0000u); }
                        const f32x4 o = b + acc[ai][bj][m][n] * s;
                        ss += (o[0] * o[0] + o[1] * o[1]) + (o[2] * o[2] + o[3] * o[3]);
                        u32x2 q; q.x = cvt_pk_bf16(o[0], o[1]); q.y = cvt_pk_bf16(o[2], o[3]);
                        *(u32x2*)(H + off + co) = q; }
                ss += __shfl_xor(ss, 16); ss += __shfl_xor(ss, 32);
                if (fq == 0) ssq[(size_t)row * 32 + u.pn * 4 + wc] = ss; }
    }
};
struct EpiResidOut {
    static constexpr bool PERM = false, AFTER_DRAIN = false;
    const bf16_t* H; float* out; int ldc; float s;
    __device__ __forceinline__ void operator()(const f32x4 (&acc)[2][2][4][2], const Unit& u, int wr, int wc, int fr, int fq) const {
        const int row0 = u.pm * BM + wr * 64 + fr, col0 = u.pn * BM + wc * 32 + 4 * fq;
#pragma unroll
        for (int ai = 0; ai < 2; ++ai)
#pragma unroll
            for (int m = 0; m < 4; ++m) { const size_t off = (size_t)(row0 + ai * HALF + m * 16) * ldc + col0;
#pragma unroll
                for (int bj = 0; bj < 2; ++bj)
#pragma unroll
                    for (int n = 0; n < 2; ++n) { const int co = bj * HALF + n * 16; const u32x2 hb = *(const u32x2*)(H + off + co);
                        f32x4 b; b[0] = __uint_as_float(hb.x << 16); b[1] = __uint_as_float(hb.x & 0xffff0000u); b[2] = __uint_as_float(hb.y << 16); b[3] = __uint_as_float(hb.y & 0xffff0000u);
                        *(f32x4*)(out + off + co) = b + acc[ai][bj][m][n] * s; } }
    }
};
struct EpiGlu {
    static constexpr bool PERM = true, AFTER_DRAIN = false;
    const bf16_t* G; int ldg; bf16_t* O; int ldo, ocol; const float* bias;
    __device__ __forceinline__ void operator()(const f32x4 (&acc)[2][2][4][2], const Unit& u, int wr, int wc, int fr, int fq) const {
        const int row0 = u.pm * BM + wr * 64 + fr, col0 = u.pn * BM + wc * 32 + 8 * fq;
#pragma unroll
        for (int ai = 0; ai < 2; ++ai)
#pragma unroll
            for (int m = 0; m < 4; ++m) { const int row = row0 + ai * HALF + m * 16;
#pragma unroll
                for (int bj = 0; bj < 2; ++bj) { const int c = col0 + bj * HALF;
                    const f32x4 b0 = *(const f32x4*)(bias + c), b1 = *(const f32x4*)(bias + c + 4);
                    const u32x4 gv = *(const u32x4*)(G + (size_t)row * ldg + c);
                    const f32x4 v0 = acc[ai][bj][m][0] + b0, v1 = acc[ai][bj][m][1] + b1;
                    float g[8]; g[0] = __uint_as_float(gv.x << 16); g[1] = __uint_as_float(gv.x & 0xffff0000u); g[2] = __uint_as_float(gv.y << 16); g[3] = __uint_as_float(gv.y & 0xffff0000u);
                    g[4] = __uint_as_float(gv.z << 16); g[5] = __uint_as_float(gv.z & 0xffff0000u); g[6] = __uint_as_float(gv.w << 16); g[7] = __uint_as_float(gv.w & 0xffff0000u);
                    u32x4 w; w.x = cvt_pk_bf16(g[0] * fsigmoid(v0[0]), g[1] * fsigmoid(v0[1])); w.y = cvt_pk_bf16(g[2] * fsigmoid(v0[2]), g[3] * fsigmoid(v0[3]));
                    w.z = cvt_pk_bf16(g[4] * fsigmoid(v1[0]), g[5] * fsigmoid(v1[1])); w.w = cvt_pk_bf16(g[6] * fsigmoid(v1[2]), g[7] * fsigmoid(v1[3]));
                    *(u32x4*)(O + (size_t)row * ldo + ocol + c) = w; } }
    }
};

template <int NM, int NN> struct FixedOrder {
    int G, c;
    __device__ __forceinline__ bool next(int i, Unit& u) const {
        constexpr int nwg = NM * NN, q = nwg / 8, r = nwg % 8, nig = 8 * NN;
        const int L = i * G + c; if (L >= nwg) return false;
        const int xcd = L & 7, off = L >> 3;
        const int wgid = (xcd < r ? xcd * (q + 1) : r * (q + 1) + (xcd - r) * q) + off;
        const int gid = wgid / nig, rem = wgid % nig;
        u.pm = gid * 8 + (rem & 7); u.pn = rem >> 3; return true;
    }
    __device__ __forceinline__ void a_ready(const Unit&) const {}
    __device__ __forceinline__ void done(const Unit&) const {}
};

template <class Epi, class Sched, bool ALIGN_EPI = false, bool SP2 = false>
__device__ __forceinline__ void gemm_phase(PG8_LAS unsigned char* lds, const Gemm g, const Sched& S, const Epi& E) {
    int tid_ = threadIdx.x; asm volatile("" : "+v"(tid_));
    const int tid = tid_, wid = __builtin_amdgcn_readfirstlane(tid >> 6), lane = tid & 63, wr = wid >> 2, wc = wid & 3, fr = lane & 15, fq = lane >> 4;
    const int K = g.K, nt = K / BK;
    unsigned voffA[2], voffB[2];
#pragma unroll
    for (int i = 0; i < 2; ++i) { int R, C; stage_rc(tid * 16 + i * 8192, R, C); const int Rb = Epi::PERM ? ((R & ~31) + perm32(R & 31)) : R;
        voffA[i] = (unsigned)(R * K + C) * 2u; voffB[i] = (unsigned)(Rb * K + C) * 2u; }
    const size_t kstep = (size_t)(BK * 2);
    const size_t hstep = (size_t)HALF * K * 2;
    const size_t tstep = 2 * hstep;
    const unsigned ldsw = (unsigned)wid * 1024u;
    const int aoff = lds_byte(wr * 64 + fr, fq * 8), boff = lds_byte(wc * 32 + fr, fq * 8);
#define PG8_SA(b, h) (((b) * 2 + (h)) * HTB)
#define PG8_SB(b, h) ((4 + (b) * 2 + (h)) * HTB)
#define PG8_STAGE(bufoff, gbase, voff) do { _Pragma("unroll") for (int _i = 0; _i < 2; ++_i) \
        __builtin_amdgcn_global_load_lds((const unsigned*)((const char*)(gbase) + (voff)[_i]), (PG8_LAS unsigned*)(lds + (bufoff) + ldsw + _i * 8192), 16, 0, 0); } while (0)
#define PG8_LDA(dst, b, h) do { _Pragma("unroll") for (int m = 0; m < 4; ++m) _Pragma("unroll") for (int k = 0; k < 2; ++k) dst[m][k] = *(const PG8_LAS bf16x8*)(lds + PG8_SA(b, h) + aoff + m * 2048 + k * 1024); } while (0)
#define PG8_LDB(dst, b, h) do { _Pragma("unroll") for (int n = 0; n < 2; ++n) _Pragma("unroll") for (int k = 0; k < 2; ++k) dst[n][k] = *(const PG8_LAS bf16x8*)(lds + PG8_SB(b, h) + boff + n * 2048 + k * 1024); } while (0)
#define PG8_MMA(ai, bj, At, Bt) do { __builtin_amdgcn_s_setprio(1); _Pragma("unroll") for (int m = 0; m < 4; ++m) _Pragma("unroll") for (int n = 0; n < 2; ++n) _Pragma("unroll") for (int k = 0; k < 2; ++k) \
        acc[ai][bj][m][n] = __builtin_amdgcn_mfma_f32_16x16x32_bf16(Bt[n][k], At[m][k], acc[ai][bj][m][n], 0, 0, 0); __builtin_amdgcn_s_setprio(0); } while (0)
#define PG8_WAIT_V(n) asm volatile("s_waitcnt vmcnt(" #n ")" ::: "memory")
#define PG8_WAIT_L(n) asm volatile("s_waitcnt lgkmcnt(" #n ")" ::: "memory")
#define PG8_BAR __builtin_amdgcn_s_barrier()
#define PG8_SCHED __builtin_amdgcn_sched_barrier(0)
    Unit cur, nxt; int ui = 0;
    if (!S.next(0, cur)) return;
    f32x4 acc[2][2][4][2];
#pragma unroll
    for (int a = 0; a < 2; ++a)
#pragma unroll
        for (int b = 0; b < 2; ++b)
#pragma unroll
            for (int m = 0; m < 4; ++m)
#pragma unroll
                for (int n = 0; n < 2; ++n) acc[a][b][m][n] = (f32x4){0.f, 0.f, 0.f, 0.f};
    bf16x8 At[4][2], B0[2][2], B1[2][2];
    const char* cA = (const char*)g.A + (size_t)cur.pm * tstep; const char* cB = (const char*)g.Bt + (size_t)cur.pn * tstep;
    S.a_ready(cur);
    if constexpr (SP2) {
        PG8_STAGE(PG8_SB(0, 0), cB, voffB); PG8_STAGE(PG8_SB(0, 1), cB + hstep, voffB); PG8_STAGE(PG8_SA(0, 0), cA, voffA); PG8_STAGE(PG8_SA(0, 1), cA + hstep, voffA);
        if (wr == 1) PG8_BAR;
        PG8_WAIT_V(2); PG8_BAR;
        PG8_STAGE(PG8_SB(1, 0), cB + kstep, voffB); PG8_STAGE(PG8_SA(1, 0), cA + kstep, voffA); PG8_STAGE(PG8_SB(1, 1), cB + hstep + kstep, voffB);
        PG8_WAIT_V(6); PG8_BAR;
    } else {
        PG8_STAGE(PG8_SB(0, 0), cB, voffB); PG8_STAGE(PG8_SA(0, 0), cA, voffA); PG8_STAGE(PG8_SB(0, 1), cB + hstep, voffB); PG8_STAGE(PG8_SA(0, 1), cA + hstep, voffA);
        if (wr == 1) PG8_BAR;
        PG8_WAIT_V(4); PG8_BAR;
        PG8_STAGE(PG8_SB(1, 0), cB + kstep, voffB); PG8_STAGE(PG8_SA(1, 0), cA + kstep, voffA); PG8_STAGE(PG8_SB(1, 1), cB + hstep + kstep, voffB);
        PG8_WAIT_V(6); PG8_BAR;
    }
    for (;;) {
        const bool has_next = S.next(ui + 1, nxt);
        const char* nA = has_next ? (const char*)g.A + (size_t)nxt.pm * tstep : cA; const char* nB = has_next ? (const char*)g.Bt + (size_t)nxt.pn * tstep : cB;
        for (int t = 0; t < nt; t += 2) {
            const bool last = (t == nt - 2);
            const char* a1 = cA + (size_t)(t + 1) * kstep;
            const char* a2 = last ? nA : cA + (size_t)(t + 2) * kstep; const char* b2 = last ? nB : cB + (size_t)(t + 2) * kstep;
            const char* a3 = a2 + kstep; const char* b3 = b2 + kstep;
            if (last && has_next) S.a_ready(nxt);
            if constexpr (SP2) {
            PG8_LDB(B0, 0, 0); PG8_LDB(B1, 0, 1); PG8_SCHED; PG8_LDA(At, 0, 0); PG8_STAGE(PG8_SA(1, 1), a1 + hstep, voffA);
            PG8_WAIT_V(8); PG8_WAIT_L(0); PG8_BAR; PG8_MMA(0, 0, At, B0); PG8_MMA(0, 1, At, B1); PG8_BAR; PG8_SCHED;
            PG8_LDA(At, 0, 1); PG8_STAGE(PG8_SB(0, 0), b2, voffB); PG8_STAGE(PG8_SB(0, 1), b2 + hstep, voffB); PG8_STAGE(PG8_SA(0, 0), a2, voffA);
            PG8_WAIT_V(8); PG8_WAIT_L(0); PG8_BAR; PG8_MMA(1, 0, At, B0); PG8_MMA(1, 1, At, B1); PG8_BAR; PG8_SCHED;
            PG8_LDB(B0, 1, 0); PG8_LDB(B1, 1, 1); PG8_SCHED; PG8_LDA(At, 1, 0); PG8_STAGE(PG8_SA(0, 1), a2 + hstep, voffA);
            PG8_WAIT_V(8); PG8_WAIT_L(0); PG8_BAR; PG8_MMA(0, 0, At, B0); PG8_MMA(0, 1, At, B1); PG8_BAR; PG8_SCHED;
            PG8_LDA(At, 1, 1); PG8_STAGE(PG8_SB(1, 0), b3, voffB); PG8_STAGE(PG8_SB(1, 1), b3 + hstep, voffB); PG8_STAGE(PG8_SA(1, 0), a3, voffA);
            PG8_WAIT_V(8); PG8_WAIT_L(0); PG8_BAR; PG8_MMA(1, 0, At, B0); PG8_MMA(1, 1, At, B1); PG8_BAR; PG8_SCHED;
            } else {
            PG8_LDB(B0, 0, 0); PG8_SCHED; PG8_LDA(At, 0, 0); PG8_STAGE(PG8_SA(1, 1), a1 + hstep, voffA);
            PG8_WAIT_L(8); PG8_BAR; PG8_WAIT_L(0); PG8_MMA(0, 0, At, B0); PG8_BAR; PG8_SCHED;
            PG8_LDB(B1, 0, 1); PG8_STAGE(PG8_SB(0, 0), b2, voffB);
            PG8_BAR; PG8_WAIT_L(0); PG8_MMA(0, 1, At, B1); PG8_BAR;
            PG8_LDA(At, 0, 1); PG8_STAGE(PG8_SA(0, 0), a2, voffA);
            PG8_BAR; PG8_WAIT_L(0); PG8_MMA(1, 0, At, B0); PG8_BAR; PG8_SCHED;
            PG8_STAGE(PG8_SB(0, 1), b2 + hstep, voffB);
            PG8_WAIT_V(6); PG8_BAR; PG8_MMA(1, 1, At, B1); PG8_BAR;
            PG8_LDB(B0, 1, 0); PG8_SCHED; PG8_LDA(At, 1, 0); PG8_STAGE(PG8_SA(0, 1), a2 + hstep, voffA);
            PG8_WAIT_L(8); PG8_BAR; PG8_WAIT_L(0); PG8_MMA(0, 0, At, B0); PG8_BAR; PG8_SCHED;
            PG8_LDB(B1, 1, 1); PG8_STAGE(PG8_SB(1, 0), b3, voffB);
            PG8_BAR; PG8_WAIT_L(0); PG8_MMA(0, 1, At, B1); PG8_BAR;
            PG8_LDA(At, 1, 1); PG8_STAGE(PG8_SA(1, 0), a3, voffA);
            PG8_BAR; PG8_WAIT_L(0); PG8_MMA(1, 0, At, B0); PG8_BAR; PG8_SCHED;
            PG8_STAGE(PG8_SB(1, 1), b3 + hstep, voffB);
            PG8_WAIT_V(6); PG8_BAR; PG8_MMA(1, 1, At, B1); PG8_BAR;
            }
        }
        if constexpr (ALIGN_EPI) { if (wr == 0) PG8_BAR; }
        if constexpr (!Epi::AFTER_DRAIN) { E(acc, cur, wr, wc, fr, fq); S.done(cur); }
        if (!has_next) break;
#pragma unroll
        for (int a = 0; a < 2; ++a)
#pragma unroll
            for (int b = 0; b < 2; ++b)
#pragma unroll
                for (int m = 0; m < 4; ++m)
#pragma unroll
                    for (int n = 0; n < 2; ++n) acc[a][b][m][n] = (f32x4){0.f, 0.f, 0.f, 0.f};
        cur = nxt; cA = nA; cB = nB; ++ui;
        if constexpr (ALIGN_EPI) { if (wr == 1) PG8_BAR; }
    }
    PG8_WAIT_V(0);
    if constexpr (!ALIGN_EPI) { if (wr == 0) PG8_BAR; }
    PG8_BAR;
    if constexpr (Epi::AFTER_DRAIN) { E.fused(acc, cur, wr, wc, fr, fq, lds, wid, lane); S.done(cur); }
#undef PG8_SA
#undef PG8_SB
#undef PG8_STAGE
#undef PG8_LDA
#undef PG8_LDB
#undef PG8_MMA
#undef PG8_WAIT_V
#undef PG8_WAIT_L
#undef PG8_BAR
#undef PG8_SCHED
}
}

#define LAS __attribute__((address_space(3)))
typedef unsigned short bf16_t;
typedef short bf16x8 __attribute__((ext_vector_type(8)));
typedef float f32x4 __attribute__((ext_vector_type(4)));
typedef float f32x2 __attribute__((ext_vector_type(2)));
typedef unsigned u32x4 __attribute__((ext_vector_type(4)));
typedef unsigned u32x2 __attribute__((ext_vector_type(2)));

constexpr int M = 16384, D = 2048, FF = 5632, SEQ = 2048, NBATCH = 8, NCH = 32, CH = 64;
constexpr int PIN = 5656, PINP = 5888;
constexpr int PQ = 0, PK = 768, PV = 1536, PZ = 2304;
constexpr int PSZ = 3072, PSX = 3840, PSB = 4608, PSC = 4864;
constexpr int PU = 5120;
constexpr int PGB = 5632, PGA = 5638, PSDT = 5648;
constexpr float EPS = 1e-6f;
constexpr size_t MiB = 1u << 20;
constexpr size_t WS_CTL = 0, WS_GL = 64 * 1024, WS_CD = 128 * 1024;
constexpr size_t WS_WGU1 = 1 * MiB, WS_WD1 = 45 * MiB, WS_WIN = 67 * MiB, WS_WGLU = 90 * MiB, WS_WOUT = 91 * MiB, WS_WGU2 = 99 * MiB, WS_WD2 = 143 * MiB;
constexpr size_t WS_XN = 166 * MiB;
constexpr size_t WS_AP = 230 * MiB;
constexpr size_t WS_MIX = 414 * MiB;
constexpr size_t WS_GT = 478 * MiB;
constexpr size_t WS_GO = 586 * MiB;
constexpr size_t WS_ST = 610 * MiB;
constexpr size_t WS_G5 = 658 * MiB;
constexpr size_t WS_E5 = 674 * MiB;
constexpr size_t WS_SSQ = 678 * MiB;
constexpr size_t WS_H = 690 * MiB;
constexpr size_t WS_END = 754 * MiB;
constexpr int GT_UNIT = 73728, GT_U = 0, GT_W = 16384, GT_QD = 32768, GT_KDT = 49152, GT_ATT = 65536;
constexpr int LDS_BYTES = 155648;

__device__ __forceinline__ float bf2f(unsigned v) { return __uint_as_float(v << 16); }
__device__ __forceinline__ unsigned f2bf(float f) { unsigned u = __float_as_uint(f); return (u + 0x7fffu + ((u >> 16) & 1u)) >> 16; }
__device__ __forceinline__ unsigned pk2(float lo, float hi) { return pg8::cvt_pk_bf16(lo, hi); }
__device__ __forceinline__ float fsilu(float x) { return x / (1.f + __expf(-x)); }
__device__ __forceinline__ float fsigmoid(float x) { return 1.f / (1.f + __expf(-x)); }
__device__ __forceinline__ float fsoftplus(float x) { return x > 20.f ? x : log1pf(expf(x)); }
__device__ __forceinline__ void unpack8(const u32x4 v, float* f) {
    f[0] = __uint_as_float(v.x << 16); f[1] = __uint_as_float(v.x & 0xffff0000u); f[2] = __uint_as_float(v.y << 16); f[3] = __uint_as_float(v.y & 0xffff0000u);
    f[4] = __uint_as_float(v.z << 16); f[5] = __uint_as_float(v.z & 0xffff0000u); f[6] = __uint_as_float(v.w << 16); f[7] = __uint_as_float(v.w & 0xffff0000u); }
__device__ __forceinline__ float wave_sum(float v) {
#pragma unroll
    for (int o = 1; o < 64; o <<= 1) v += __shfl_xor(v, o);
    return v;
}
__device__ __forceinline__ float wave_incl_scan(float v, int lane) {
#pragma unroll
    for (int o = 1; o < 64; o <<= 1) { const float t = __shfl_up(v, o); if (lane >= o) v += t; }
    return v;
}
__device__ __forceinline__ f32x4 mm16(const LAS bf16_t* X, int ldx, const LAS bf16_t* Y, int ldy, int K, f32x4 acc, int fr, int fq) {
    const LAS bf16_t* xp = X + fr * ldx + fq * 8; const LAS bf16_t* yp = Y + fr * ldy + fq * 8;
#if defined(MM16_NAIVE)
    for (int k = 0; k < K; ++k) { const float xv = bf2f(X[fr * ldx + k]);
#pragma unroll
        for (int j = 0; j < 4; ++j) acc[j] += xv * bf2f(Y[(4 * fq + j) * ldy + k]); }
    (void)xp; (void)yp;
#else
    for (int k = 0; k < K; k += 32) { const bf16x8 x = *(const LAS bf16x8*)(xp + k); const bf16x8 y = *(const LAS bf16x8*)(yp + k);
        acc = __builtin_amdgcn_mfma_f32_16x16x32_bf16(y, x, acc, 0, 0, 0);
        asm volatile("" :: "v"(x), "v"(y)); }
#endif
    return acc;
}
#define WG_SYNC() do { asm volatile("s_waitcnt lgkmcnt(0)" ::: "memory"); __builtin_amdgcn_s_barrier(); asm volatile("" ::: "memory"); } while (0)

struct KP { const float* in[33]; float* out; unsigned char* ws; int ph_lo, ph_hi; };
#define AS4 __attribute__((address_space(4)))
struct KPV {
    const AS4 KP* k;
    __device__ __forceinline__ const float* in(int i) const { return k->in[i]; }
    __device__ __forceinline__ unsigned char* ws() const { return k->ws; }
    __device__ __forceinline__ float* out() const { return k->out; }
};

__device__ __forceinline__ int map_row(int mode, int n) {
    if (mode == 0) return n;
    if (mode == 1) return ((n >> 7) << 8) + (n & 127);
    if (mode == 2) return ((n >> 7) << 8) + 128 + (n & 127);
    if (n < 3072) return n;
    if (n < 3084) return PGB + (n - 3072);
    if (n < 5132) return 3072 + (n - 3084);
    if (n < 5144) return PSDT + (n - 5132);
    return PU + (n - 5144);
}
__device__ __forceinline__ void transpose_item(const float* W, int K, int N, bf16_t* WT, int mode, LAS float* scr, int item, int lane, const float* nw = nullptr) {
    const int nblk = (N + 31) / 32, kb = item / nblk, nb = item % nblk, k0 = 64 * kb, n0 = 32 * nb;
    const int nn = n0 + (lane & 31); const bool ok = nn < N;
    float wv[32];
#pragma unroll
    for (int i = 0; i < 32; ++i) { const int kk = 2 * i + (lane >> 5); wv[i] = ok ? __builtin_nontemporal_load(W + (size_t)(k0 + kk) * N + nn) : 0.f; }
#pragma unroll
    for (int i = 0; i < 32; ++i) { const int kk = 2 * i + (lane >> 5); scr[kk * 33 + (lane & 31)] = nw ? wv[i] * nw[k0 + kk] : wv[i]; }
    asm volatile("s_waitcnt lgkmcnt(0)" ::: "memory"); __builtin_amdgcn_wave_barrier();
    const int c = lane & 7;
#pragma unroll
    for (int j = 0; j < 4; ++j) { const int n = (lane >> 3) + 8 * j; const LAS float* s = scr + (8 * c) * 33 + n;
        u32x4 o; o.x = pk2(s[0 * 33], s[1 * 33]); o.y = pk2(s[2 * 33], s[3 * 33]); o.z = pk2(s[4 * 33], s[5 * 33]); o.w = pk2(s[6 * 33], s[7 * 33]);
        if (n0 + n < N) *(u32x4*)(WT + (size_t)map_row(mode, n0 + n) * K + k0 + 8 * c) = o; }
    asm volatile("s_waitcnt lgkmcnt(0)" ::: "memory"); __builtin_amdgcn_wave_barrier();
}
__device__ __forceinline__ void convert_phase(const KPV& p, int layer, LAS unsigned char* lds, int gw, int NGW, int wave, int lane) {
    LAS float* scr = (LAS float*)(lds + wave * 16384);
    unsigned char* ws = p.ws();
    constexpr int I_GU = (D / 64) * (FF / 32), I_DN = (FF / 64) * (D / 32), I_IN = (D / 64) * ((PIN + 31) / 32), I_GLU = (512 / 64) * (512 / 32), I_OUT = (D / 64) * (D / 32);
    constexpr int NITEMS = 4 * I_GU + 2 * I_DN + I_IN + I_GLU + I_OUT;
    for (int it = gw; it < NITEMS; it += NGW) {
        int r = it;
        if (r < I_GU) { transpose_item(p.in(2) + (size_t)layer * D * FF, D, FF, (bf16_t*)(ws + WS_WGU1), 1, scr, r, lane, p.in(1) + layer * D); continue; } r -= I_GU;
        if (r < I_GU) { transpose_item(p.in(3) + (size_t)layer * D * FF, D, FF, (bf16_t*)(ws + WS_WGU1), 2, scr, r, lane, p.in(1) + layer * D); continue; } r -= I_GU;
        if (r < I_DN) { transpose_item(p.in(4) + (size_t)layer * D * FF, FF, D, (bf16_t*)(ws + WS_WD1), 0, scr, r, lane); continue; } r -= I_DN;
        if (r < I_IN) { transpose_item(p.in(6) + (size_t)layer * D * PIN, D, PIN, (bf16_t*)(ws + WS_WIN), 3, scr, r, lane, p.in(5) + layer * D); continue; } r -= I_IN;
        if (r < I_GLU) { transpose_item(p.in(25) + (size_t)layer * 512 * 512, 512, 512, (bf16_t*)(ws + WS_WGLU), 0, scr, r, lane); continue; } r -= I_GLU;
        if (r < I_OUT) { transpose_item(p.in(27) + (size_t)layer * D * D, D, D, (bf16_t*)(ws + WS_WOUT), 0, scr, r, lane); continue; } r -= I_OUT;
        if (r < I_GU) { transpose_item(p.in(29) + (size_t)layer * D * FF, D, FF, (bf16_t*)(ws + WS_WGU2), 1, scr, r, lane, p.in(28) + layer * D); continue; } r -= I_GU;
        if (r < I_GU) { transpose_item(p.in(30) + (size_t)layer * D * FF, D, FF, (bf16_t*)(ws + WS_WGU2), 2, scr, r, lane, p.in(28) + layer * D); continue; } r -= I_GU;
        transpose_item(p.in(31) + (size_t)layer * D * FF, FF, D, (bf16_t*)(ws + WS_WD2), 0, scr, r, lane);
    }
}
__device__ __forceinline__ void norm_raw_phase(const float* h, const float* w, bf16_t* xn, float* ssq, int gw, int NGW, int lane) {
    for (int row = gw; row < M; row += NGW) {
        const f32x4* xr = (const f32x4*)(h + (size_t)row * D) + lane; float s = 0.f;
#pragma unroll
        for (int j = 0; j < 8; ++j) { const f32x4 v = xr[64 * j]; s += (v.x * v.x + v.y * v.y) + (v.z * v.z + v.w * v.w);
            u32x2 q; q.x = pk2(v.x, v.y); q.y = pk2(v.z, v.w);
            *((u32x2*)(xn + (size_t)row * D) + lane + 64 * j) = q; }
        s = wave_sum(s); if (lane < 32) ssq[(size_t)row * 32 + lane] = (lane == 0) ? s : 0.f;
    }
}
template <bool FINAL>
__device__ __forceinline__ void norm_phase(const float* h, const float* w, bf16_t* xn, float* fout, int gw, int NGW, int lane) {
    for (int row = gw; row < M; row += NGW) {
        const f32x4* xr = (const f32x4*)(h + (size_t)row * D) + lane;
        f32x4 v[8]; float s = 0.f;
#pragma unroll
        for (int j = 0; j < 8; ++j) { v[j] = xr[64 * j]; s += (v[j].x * v[j].x + v[j].y * v[j].y) + (v[j].z * v[j].z + v[j].w * v[j].w); }
        const float rstd = rsqrtf(wave_sum(s) * (1.f / D) + EPS);
#pragma unroll
        for (int j = 0; j < 8; ++j) { const f32x4 wv = *((const f32x4*)w + lane + 64 * j); const f32x4 o = v[j] * rstd * wv;
            if (FINAL) *((f32x4*)(fout + (size_t)row * D) + lane + 64 * j) = o;
            else { u32x2 q; q.x = pk2(o.x, o.y); q.y = pk2(o.z, o.w); *((u32x2*)(xn + (size_t)row * D) + lane + 64 * j) = q; } }
    }
}

constexpr int G_RAW = 0;
constexpr int G_LF = 0, G_TS = 17408, G_TF = 26624;
constexpr int G_QS = 51456, G_KS = 68864, G_KDT = 86272, G_VBT = 104704, G_KGT = 123136, G_GATE = 141568;
struct S5Par;
__device__ __forceinline__ void s5_shadow_unit(const KPV& p, int layer, int wu, LAS unsigned char* wl, int lane);
__device__ __forceinline__ void gdn_pre_unit(const KPV& p, int layer, int unit, LAS unsigned char* lds, int tid, int wave, int lane, int s5_wu = -1) {
    asm volatile("" : "+v"(tid)); lane = tid & 63;
    const int b = unit / (6 * NCH), h = (unit / NCH) % 6, n = unit % NCH;
    const int tok0 = b * SEQ + n * CH;
    const bf16_t* proj = (const bf16_t*)(p.ws() + WS_AP);
    unsigned char* gt = p.ws() + WS_GT + (size_t)unit * GT_UNIT;
    LAS bf16_t* raw = (LAS bf16_t*)(lds + G_RAW);
    LAS float* Gs = (LAS float*)(lds + G_GATE); LAS float* Bt = Gs + 64;
    { u32x4 rv[7];
#pragma unroll
      for (int k = 0; k < 7; ++k) { const int c = tid + 512 * k, part = c / (67 * 16), rc = c % (67 * 16), r = rc >> 4, ch = rc & 15;
          rv[k] = (u32x4){0u, 0u, 0u, 0u};
          if (c < 3 * 67 * 16 && (n > 0 || r >= 3)) rv[k] = *(const u32x4*)(proj + (size_t)(tok0 + r - 3) * PINP + part * 768 + h * 128 + ch * 8); }
#pragma unroll
      for (int k = 0; k < 7; ++k) { const int c = tid + 512 * k, part = c / (67 * 16), rc = c % (67 * 16), r = rc >> 4, ch = rc & 15;
          if (c < 3 * 67 * 16) *(LAS u32x4*)(raw + (part * 67 + r) * 128 + ch * 8) = rv[k]; } }
    if (wave == 0) { const size_t ro = (size_t)(tok0 + lane) * PINP;
        const float braw = bf2f(proj[ro + PGB + h]), araw = bf2f(proj[ro + PGA + h]);
        const float g = -expf(p.in(8)[layer * 6 + h]) * fsoftplus(araw + p.in(9)[layer * 6 + h]);
        Gs[lane] = wave_incl_scan(g, lane); Bt[lane] = 1.f / (1.f + expf(-braw)); }
    WG_SYNC();
    { const int tok = tid >> 3, sub = tid & 7, c0 = sub * 16;
      const float* cw = p.in(7) + (size_t)layer * 4 * 2304 + h * 128 + c0;
      const float G = Gs[tok], beta = Bt[tok], Glast = Gs[63];
      const float eG = expf(G), eGl = expf(Glast - G);
      LAS bf16_t* Qs = (LAS bf16_t*)(lds + G_QS); LAS bf16_t* Ks = (LAS bf16_t*)(lds + G_KS);
      LAS bf16_t* KdT = (LAS bf16_t*)(lds + G_KDT); LAS bf16_t* VbT = (LAS bf16_t*)(lds + G_VBT); LAS bf16_t* KgT = (LAS bf16_t*)(lds + G_KGT);
#pragma unroll 1
      for (int part = 0; part < 3; ++part) {
          float acc[16];
#pragma unroll
          for (int i = 0; i < 16; ++i) acc[i] = 0.f;
#pragma unroll
          for (int tap = 0; tap < 4; ++tap) {
              const LAS bf16_t* rp = raw + (part * 67 + tok + tap) * 128 + c0;
              float x[16]; unpack8(*(const LAS u32x4*)rp, x); unpack8(*(const LAS u32x4*)(rp + 8), x + 8);
              const float* wp = cw + tap * 2304 + part * 768;
#pragma unroll
              for (int i4 = 0; i4 < 4; ++i4) { const f32x4 wv = *(const f32x4*)(wp + 4 * i4);
                  acc[4 * i4 + 0] += wv.x * x[4 * i4 + 0]; acc[4 * i4 + 1] += wv.y * x[4 * i4 + 1]; acc[4 * i4 + 2] += wv.z * x[4 * i4 + 2]; acc[4 * i4 + 3] += wv.w * x[4 * i4 + 3]; }
          }
          float ss = 0.f;
#pragma unroll
          for (int i = 0; i < 16; ++i) { acc[i] = fsilu(acc[i]); ss += acc[i] * acc[i]; }
          ss += __shfl_xor(ss, 1); ss += __shfl_xor(ss, 2); ss += __shfl_xor(ss, 4);
          const float r = (part == 2) ? 1.f : rsqrtf(ss + EPS) * (part == 0 ? 0.08838834764831845f : 1.f);
#pragma unroll
          for (int i = 0; i < 16; ++i) acc[i] *= r;
          u32x4 a, c;
          a.x = pk2(acc[0], acc[1]); a.y = pk2(acc[2], acc[3]); a.z = pk2(acc[4], acc[5]); a.w = pk2(acc[6], acc[7]);
          c.x = pk2(acc[8], acc[9]); c.y = pk2(acc[10], acc[11]); c.z = pk2(acc[12], acc[13]); c.w = pk2(acc[14], acc[15]);
          if (part == 0) {
              *(LAS u32x4*)(Qs + tok * 136 + c0) = a; *(LAS u32x4*)(Qs + tok * 136 + c0 + 8) = c;
              a.x = pk2(acc[0] * eG, acc[1] * eG); a.y = pk2(acc[2] * eG, acc[3] * eG); a.z = pk2(acc[4] * eG, acc[5] * eG); a.w = pk2(acc[6] * eG, acc[7] * eG);
              c.x = pk2(acc[8] * eG, acc[9] * eG); c.y = pk2(acc[10] * eG, acc[11] * eG); c.z = pk2(acc[12] * eG, acc[13] * eG); c.w = pk2(acc[14] * eG, acc[15] * eG);
              bf16_t* qd = (bf16_t*)(gt + GT_QD) + tok * 128 + c0; *(u32x4*)qd = a; *(u32x4*)(qd + 8) = c;
          } else if (part == 1) {
              *(LAS u32x4*)(Ks + tok * 136 + c0) = a; *(LAS u32x4*)(Ks + tok * 136 + c0 + 8) = c;
              const float kbg = beta * eG;
#pragma unroll
              for (int i = 0; i < 16; ++i) { KdT[(c0 + i) * 72 + tok] = (bf16_t)f2bf(acc[i] * eGl); KgT[(c0 + i) * 72 + tok] = (bf16_t)f2bf(acc[i] * kbg); }
          } else {
#pragma unroll
              for (int i = 0; i < 16; ++i) VbT[(c0 + i) * 72 + tok] = (bf16_t)f2bf(acc[i] * beta);
          }
      }
    }
    WG_SYNC();
    { LAS float* Lf = (LAS float*)(lds + G_LF);
      const LAS bf16_t* Qs = (const LAS bf16_t*)(lds + G_QS); const LAS bf16_t* Ks = (const LAS bf16_t*)(lds + G_KS);
      const int fr = lane & 15, fq = lane >> 4;
      for (int job = wave * 4; job < wave * 4 + 4; ++job) { const int mat = job >> 4, ti = (job >> 2) & 3, tj = job & 3;
          f32x4 acc = (f32x4){0.f, 0.f, 0.f, 0.f};
          acc = mm16((mat == 0 ? Ks : Qs) + ti * 16 * 136, 136, Ks + tj * 16 * 136, 136, 128, acc, fr, fq);
          const int i = ti * 16 + fr, j0 = tj * 16 + 4 * fq; const float Gi = Gs[i], bi = Bt[i];
          float o[4];
#pragma unroll
          for (int jj = 0; jj < 4; ++jj) { const int j = j0 + jj; const float dec = (i >= j) ? expf(Gi - Gs[j]) : 0.f;
              o[jj] = (mat == 0) ? ((i > j) ? acc[jj] * bi * dec : 0.f) : acc[jj] * dec; }
          if (mat == 0) { Lf[(j0 + 0) * 68 + i] = o[0]; Lf[(j0 + 1) * 68 + i] = o[1]; Lf[(j0 + 2) * 68 + i] = o[2]; Lf[(j0 + 3) * 68 + i] = o[3]; }
          else { u32x2 w; w.x = pk2(o[0], o[1]); w.y = pk2(o[2], o[3]); *(u32x2*)((bf16_t*)(gt + GT_ATT) + i * 64 + j0) = w; } }
    }
    WG_SYNC();
    if (wave == 0) { const LAS float* LfT = (const LAS float*)(lds + G_LF); LAS bf16_t* Ts = (LAS bf16_t*)(lds + G_TS); LAS float* Tf = (LAS float*)(lds + G_TF);
#pragma unroll 1
        for (int I = 0; I < 4; ++I) { float s[16];
#pragma unroll
            for (int ii = 0; ii < 16; ++ii) s[ii] = (16 * I + ii == lane) ? 1.f : 0.f;
#pragma unroll 2
            for (int j = 0; j < 16 * I; ++j) { const float tj = Tf[j * 64 + lane]; const LAS f32x4* lc = (const LAS f32x4*)(LfT + j * 68 + 16 * I);
#pragma unroll
                for (int q = 0; q < 4; ++q) { const f32x4 l = lc[q]; s[4 * q + 0] -= l.x * tj; s[4 * q + 1] -= l.y * tj; s[4 * q + 2] -= l.z * tj; s[4 * q + 3] -= l.w * tj; } }
#pragma unroll
            for (int jj = 0; jj < 16; ++jj) { const float t = s[jj]; Tf[(16 * I + jj) * 64 + lane] = t; Ts[(16 * I + jj) * 72 + lane] = (bf16_t)f2bf(t);
                const LAS f32x4* lc = (const LAS f32x4*)(LfT + (16 * I + jj) * 68 + 16 * I);
#pragma unroll
                for (int q = 0; q < 4; ++q) { if (4 * q + 3 > jj) { const f32x4 l = lc[q];
                    if (4 * q + 0 > jj) s[4 * q + 0] -= l.x * t; if (4 * q + 1 > jj) s[4 * q + 1] -= l.y * t; if (4 * q + 2 > jj) s[4 * q + 2] -= l.z * t; if (4 * q + 3 > jj) s[4 * q + 3] -= l.w * t; } } }
        }
        if (lane == 0) ((float*)(p.ws() + WS_GL))[unit] = expf(Gs[63]);
    } else { const LAS bf16_t* KdT = (const LAS bf16_t*)(lds + G_KDT);
        for (int c = tid - 64; c < 128 * 8; c += 448) { const int r = c >> 3, ch = c & 7; *(u32x4*)((bf16_t*)(gt + GT_KDT) + r * 64 + ch * 8) = *(const LAS u32x4*)(KdT + r * 72 + ch * 8); }
        if (s5_wu >= 0) s5_shadow_unit(p, layer, s5_wu, lds + G_QS + (wave - 1) * 4096, lane); }
    WG_SYNC();
    asm volatile("" : "+v"(tid)); lane = tid & 63;
    { const LAS bf16_t* Ts = (const LAS bf16_t*)(lds + G_TS); const LAS bf16_t* VbT = (const LAS bf16_t*)(lds + G_VBT); const LAS bf16_t* KgT = (const LAS bf16_t*)(lds + G_KGT);
      const int fr = lane & 15, fq = lane >> 4;
      for (int job = wave * 8; job < wave * 8 + 8; ++job) { const int mat = job >> 5, ti = (job >> 3) & 3, te = job & 7;
          f32x4 acc = (f32x4){0.f, 0.f, 0.f, 0.f};
          acc = mm16(Ts + ti * 16 * 72, 72, (mat == 0 ? VbT : KgT) + te * 16 * 72, 72, 64, acc, fr, fq);
          u32x2 w; w.x = pk2(acc[0], acc[1]); w.y = pk2(acc[2], acc[3]);
          *(u32x2*)((bf16_t*)(gt + (mat == 0 ? GT_U : GT_W)) + (ti * 16 + fr) * 128 + te * 16 + 4 * fq) = w; }
    }
    WG_SYNC();
}

constexpr int GS_BUF = 66560;
constexpr int GS_WB = 0, GS_QB = 17408, GS_KT = 34816, GS_AT = 53248, GS_UB = 62464;
constexpr int GS_ST = 2 * GS_BUF, GS_VNT = GS_ST + 8704;
__device__ __forceinline__ void gs_load(const unsigned char* gt, int es, int tid, u32x4 (&v)[8]) {
#pragma unroll
    for (int k = 0; k < 8; ++k) { const int c = tid + 512 * k; const bf16_t* src;
        if (k < 2) src = (const bf16_t*)(gt + GT_W) + (c >> 4) * 128 + (c & 15) * 8;
        else if (k < 4) { const int c2 = c - 1024; src = (const bf16_t*)(gt + GT_QD) + (c2 >> 4) * 128 + (c2 & 15) * 8; }
        else if (k < 6) { const int c2 = c - 2048; src = (const bf16_t*)(gt + GT_KDT) + (c2 >> 3) * 64 + (c2 & 7) * 8; }
        else if (k < 7) { const int c2 = c - 3072; src = (const bf16_t*)(gt + GT_ATT) + (c2 >> 3) * 64 + (c2 & 7) * 8; }
        else { const int c2 = (c - 3584) & 255; src = (const bf16_t*)(gt + GT_U) + (c2 >> 2) * 128 + es * 32 + (c2 & 3) * 8; }
        v[k] = *(const u32x4*)src; }
}
__device__ __forceinline__ void gs_store(LAS unsigned char* buf, int tid, const u32x4 (&v)[8]) {
#pragma unroll
    for (int k = 0; k < 8; ++k) { const int c = tid + 512 * k; LAS bf16_t* dst;
        if (k < 2) dst = (LAS bf16_t*)(buf + GS_WB) + (c >> 4) * 136 + (c & 15) * 8;
        else if (k < 4) { const int c2 = c - 1024; dst = (LAS bf16_t*)(buf + GS_QB) + (c2 >> 4) * 136 + (c2 & 15) * 8; }
        else if (k < 6) { const int c2 = c - 2048; dst = (LAS bf16_t*)(buf + GS_KT) + (c2 >> 3) * 72 + (c2 & 7) * 8; }
        else if (k < 7) { const int c2 = c - 3072; dst = (LAS bf16_t*)(buf + GS_AT) + (c2 >> 3) * 72 + (c2 & 7) * 8; }
        else { const int c2 = (c - 3584) & 255; dst = (LAS bf16_t*)(buf + GS_UB) + (c2 >> 2) * 32 + (c2 & 3) * 8; }
        if (k < 7 || tid < 256) *(LAS u32x4*)dst = v[k]; }
}
__device__ __forceinline__ void gdn_scan_step(LAS unsigned char* buf, LAS bf16_t* ST, LAS bf16_t* VnT, f32x4 (&sacc)[2], float gl, bf16_t* gop, int wave, int fr, int fq) {
    const int d0 = wave * 16, ti = wave >> 1, te = wave & 1, i0 = ti * 16, e0 = te * 16;
#pragma unroll
    for (int et = 0; et < 2; ++et)
#pragma unroll
        for (int jj = 0; jj < 4; ++jj) ST[(16 * et + 4 * fq + jj) * 136 + d0 + fr] = (bf16_t)f2bf(sacc[et][jj]);
    WG_SYNC();
    f32x4 accv = (f32x4){0.f, 0.f, 0.f, 0.f}, acco = accv;
    accv = mm16((const LAS bf16_t*)(buf + GS_WB) + i0 * 136, 136, ST + e0 * 136, 136, 128, accv, fr, fq);
    acco = mm16((const LAS bf16_t*)(buf + GS_QB) + i0 * 136, 136, ST + e0 * 136, 136, 128, acco, fr, fq);
    { const u32x2 uu = *(const LAS u32x2*)((const LAS bf16_t*)(buf + GS_UB) + (i0 + fr) * 32 + e0 + 4 * fq);
      const float u0 = bf2f(uu.x & 0xffffu), u1 = __uint_as_float(uu.x & 0xffff0000u), u2 = bf2f(uu.y & 0xffffu), u3 = __uint_as_float(uu.y & 0xffff0000u);
      accv[0] = u0 - accv[0]; accv[1] = u1 - accv[1]; accv[2] = u2 - accv[2]; accv[3] = u3 - accv[3]; }
#pragma unroll
    for (int jj = 0; jj < 4; ++jj) VnT[(e0 + 4 * fq + jj) * 72 + i0 + fr] = (bf16_t)f2bf(accv[jj]);
    WG_SYNC();
    acco = mm16((const LAS bf16_t*)(buf + GS_AT) + i0 * 72, 72, VnT + e0 * 72, 72, 64, acco, fr, fq);
    { u32x2 w; w.x = pk2(acco[0], acco[1]); w.y = pk2(acco[2], acco[3]); *(u32x2*)(gop + (size_t)(i0 + fr) * 768 + e0 + 4 * fq) = w; }
#pragma unroll
    for (int et = 0; et < 2; ++et) { sacc[et] = sacc[et] * gl;
        sacc[et] = mm16((const LAS bf16_t*)(buf + GS_KT) + d0 * 72, 72, VnT + 16 * et * 72, 72, 64, sacc[et], fr, fq); }
}
__device__ __forceinline__ void gdn_scan_unit(const KPV& p, int unit, LAS unsigned char* lds, int tid, int wave, int lane) {
    const int bh = unit >> 2, es = unit & 3, b = bh / 6, h = bh % 6;
    const unsigned char* gt0 = p.ws() + WS_GT + (size_t)bh * NCH * GT_UNIT;
    const float* GL = (const float*)(p.ws() + WS_GL) + bh * NCH;
    bf16_t* GO = (bf16_t*)(p.ws() + WS_GO) + (size_t)(b * SEQ) * 768 + h * 128 + es * 32;
    const int fr = lane & 15, fq = lane >> 4;
    LAS bf16_t* ST = (LAS bf16_t*)(lds + GS_ST); LAS bf16_t* VnT = (LAS bf16_t*)(lds + GS_VNT);
    u32x4 pa[8], pb[8];
    gs_load(gt0, es, tid, pa); gs_store(lds, tid, pa);
    gs_load(gt0 + (size_t)GT_UNIT, es, tid, pa);
    LAS float* GLs = (LAS float*)(lds + GS_VNT + 4608);
    if (tid < 32) GLs[tid] = GL[tid];
    f32x4 sacc[2]; sacc[0] = (f32x4){0.f, 0.f, 0.f, 0.f}; sacc[1] = sacc[0];
#pragma unroll 1
    for (int n = 0; n < NCH; n += 2) {
        if (n + 2 < NCH) gs_load(gt0 + (size_t)(n + 2) * GT_UNIT, es, tid, pb);
        gdn_scan_step(lds, ST, VnT, sacc, GLs[n], GO + (size_t)(n * CH) * 768, wave, fr, fq);
        gs_store(lds + GS_BUF, tid, pa);
        if (n + 3 < NCH) gs_load(gt0 + (size_t)(n + 3) * GT_UNIT, es, tid, pa);
        gdn_scan_step(lds + GS_BUF, ST, VnT, sacc, GLs[n + 1], GO + (size_t)((n + 1) * CH) * 768, wave, fr, fq);
        if (n + 2 < NCH) gs_store(lds, tid, pb);
    }
    WG_SYNC();
}

constexpr int S_RAWC = 0, S_RAWB = 17152, S_RAWX = 34304;
constexpr int S_CS = 42880, S_BS = 60288, S_SP = 77696;
constexpr int S_XDT = 95104, S_XSN = 104320, S_MS = 113536;
constexpr int S_F = 122752;
template <int W16, int NI>
__device__ __forceinline__ void ssd_raw_ld(const bf16_t* proj, int tok0, int n, int col, int tid, u32x4 (&v)[NI]) {
#pragma unroll
    for (int k = 0; k < NI; ++k) { const int c = tid + 512 * k, r = c / W16, ch = c % W16; v[k] = (u32x4){0u, 0u, 0u, 0u};
        if (c < 67 * W16 && (n > 0 || r >= 3)) v[k] = *(const u32x4*)(proj + (size_t)(tok0 + r - 3) * PINP + col + ch * 8); }
}
template <int W16, int NI>
__device__ __forceinline__ void ssd_raw_st(LAS bf16_t* dst, int tid, const u32x4 (&v)[NI]) {
#pragma unroll
    for (int k = 0; k < NI; ++k) { const int c = tid + 512 * k, r = c / W16, ch = c % W16;
        if (c < 67 * W16) *(LAS u32x4*)(dst + r * (W16 * 8) + ch * 8) = v[k]; }
}
__device__ __forceinline__ void ssd_conv8(const LAS bf16_t* raw, int rs, int tok, int ch0, const float* cw, const float* cb, int cidx, float* out) {
    const f32x4 b0 = *(const f32x4*)(cb + cidx), b1 = *(const f32x4*)(cb + cidx + 4);
    out[0] = b0.x; out[1] = b0.y; out[2] = b0.z; out[3] = b0.w; out[4] = b1.x; out[5] = b1.y; out[6] = b1.z; out[7] = b1.w;
#pragma unroll
    for (int tap = 0; tap < 4; ++tap) { float x[8]; unpack8(*(const LAS u32x4*)(raw + (tok + tap) * rs + ch0), x);
        const f32x4 w0 = *(const f32x4*)(cw + tap * 1280 + cidx), w1 = *(const f32x4*)(cw + tap * 1280 + cidx + 4);
        out[0] += w0.x * x[0]; out[1] += w0.y * x[1]; out[2] += w0.z * x[2]; out[3] += w0.w * x[3]; out[4] += w1.x * x[4]; out[5] += w1.y * x[5]; out[6] += w1.z * x[6]; out[7] += w1.w * x[7]; }
#pragma unroll
    for (int i = 0; i < 8; ++i) out[i] = fsilu(out[i]);
}
__device__ __forceinline__ void ssd_gates(const KPV& p, int layer, const bf16_t* proj, int tok0, int h, LAS float* F, int lane) {
    const float dtr = bf2f(proj[(size_t)(tok0 + lane) * PINP + PSDT + h]);
    const float dt = fsoftplus(dtr + p.in(14)[layer * 12 + h]);
    const float a = -expf(p.in(13)[layer * 12 + h]) * dt;
    F[lane] = wave_incl_scan(a, lane); F[64 + lane] = dt;
}
__device__ __forceinline__ void ssd_pre_unit(const KPV& p, int layer, int unit, LAS unsigned char* lds, int tid, int wave, int lane) {
    const int b = unit / (NCH * 12), n = (unit / 12) % NCH, h = unit % 12, g = h / 6;
    const int tok0 = b * SEQ + n * CH; const int u3 = (b * 12 + h) * NCH + n;
    const bf16_t* proj = (const bf16_t*)(p.ws() + WS_AP);
    LAS bf16_t* rawB = (LAS bf16_t*)(lds + S_RAWB); LAS bf16_t* rawX = (LAS bf16_t*)(lds + S_RAWX);
    LAS bf16_t* BT = (LAS bf16_t*)(lds + S_BS); LAS bf16_t* XdT = (LAS bf16_t*)(lds + S_XDT); LAS float* F = (LAS float*)(lds + S_F);
    { u32x4 vb[3], vx[2];
      ssd_raw_ld<16, 3>(proj, tok0, n, PSB + g * 128, tid, vb); ssd_raw_ld<8, 2>(proj, tok0, n, PSX + h * 64, tid, vx);
      if (wave == 0) ssd_gates(p, layer, proj, tok0, h, F, lane);
      ssd_raw_st<16, 3>(rawB, tid, vb); ssd_raw_st<8, 2>(rawX, tid, vx); }
    WG_SYNC();
    { const float* cw = p.in(11) + (size_t)layer * 4 * 1280; const float* cb = p.in(12) + (size_t)layer * 1280;
      const int tok = tid >> 3, sub = tid & 7; float o[8];
#pragma unroll
      for (int half = 0; half < 2; ++half) { const int ch0 = sub * 16 + half * 8;
          ssd_conv8(rawB, 128, tok, ch0, cw, cb, 768 + g * 128 + ch0, o);
#pragma unroll
          for (int i = 0; i < 8; ++i) BT[(ch0 + i) * 72 + tok] = (bf16_t)f2bf(o[i]); }
      const float sc = F[64 + tok] * expf(F[63] - F[tok]);
      ssd_conv8(rawX, 64, tok, sub * 8, cw, cb, h * 64 + sub * 8, o);
#pragma unroll
      for (int i = 0; i < 8; ++i) XdT[(sub * 8 + i) * 72 + tok] = (bf16_t)f2bf(o[i] * sc);
    }
    WG_SYNC();
    { const int fr = lane & 15, fq = lane >> 4; bf16_t* st = (bf16_t*)(p.ws() + WS_ST) + (size_t)u3 * 8192;
      for (int job = wave * 4; job < wave * 4 + 4; ++job) { const int pt = job >> 3, kt = job & 7;
          f32x4 acc = (f32x4){0.f, 0.f, 0.f, 0.f};
          acc = mm16(XdT + pt * 16 * 72, 72, BT + kt * 16 * 72, 72, 64, acc, fr, fq);
          u32x2 w; w.x = pk2(acc[0], acc[1]); w.y = pk2(acc[2], acc[3]);
          *(u32x2*)(st + (pt * 16 + fr) * 128 + kt * 16 + 4 * fq) = w; }
      if (tid == 0) ((float*)(p.ws() + WS_CD))[u3] = expf(F[63]);
    }
    WG_SYNC();
}
__device__ __forceinline__ void ssd_scan_items(const KPV& p, int first, int stride) {
    bf16_t* st = (bf16_t*)(p.ws() + WS_ST); const float* CD = (const float*)(p.ws() + WS_CD);
    for (int it = first; it < 96 * 1024; it += stride) { const int bh = it >> 10, vec = it & 1023;
        float S[8];
#pragma unroll
        for (int i = 0; i < 8; ++i) S[i] = 0.f;
        u32x4* base = (u32x4*)(st + ((size_t)bh * NCH * 8192 + vec * 8));
#pragma unroll 1
        for (int n0 = 0; n0 < NCH; n0 += 8) { u32x4 v[8]; float cd[8];
#pragma unroll
            for (int k = 0; k < 8; ++k) { v[k] = base[(size_t)(n0 + k) * 1024]; cd[k] = CD[bh * NCH + n0 + k]; }
#pragma unroll
            for (int k = 0; k < 8; ++k) { float x[8]; unpack8(v[k], x);
                u32x4 o; o.x = pk2(S[0], S[1]); o.y = pk2(S[2], S[3]); o.z = pk2(S[4], S[5]); o.w = pk2(S[6], S[7]); base[(size_t)(n0 + k) * 1024] = o;
#pragma unroll
                for (int i = 0; i < 8; ++i) S[i] = S[i] * cd[k] + x[i]; } }
    }
}
__device__ __forceinline__ void ssd_out_unit(const KPV& p, int layer, int unit, LAS unsigned char* lds, int tid, int wave, int lane) {
    const int b = unit / (NCH * 12), n = (unit / 12) % NCH, h = unit % 12, g = h / 6;
    const int tok0 = b * SEQ + n * CH; const int u3 = (b * 12 + h) * NCH + n;
    const bf16_t* proj = (const bf16_t*)(p.ws() + WS_AP);
    LAS bf16_t* rawC = (LAS bf16_t*)(lds + S_RAWC); LAS bf16_t* rawB = (LAS bf16_t*)(lds + S_RAWB); LAS bf16_t* rawX = (LAS bf16_t*)(lds + S_RAWX);
    LAS bf16_t* Cs = (LAS bf16_t*)(lds + S_CS); LAS bf16_t* Bs = (LAS bf16_t*)(lds + S_BS); LAS bf16_t* Sp = (LAS bf16_t*)(lds + S_SP);
    LAS bf16_t* XdT = (LAS bf16_t*)(lds + S_XDT); LAS bf16_t* XsN = (LAS bf16_t*)(lds + S_XSN); LAS bf16_t* Ms = (LAS bf16_t*)(lds + S_MS); LAS float* F = (LAS float*)(lds + S_F);
    { u32x4 vc[3], vb[3], vx[2], vs[2]; const bf16_t* st = (const bf16_t*)(p.ws() + WS_ST) + (size_t)u3 * 8192;
      ssd_raw_ld<16, 3>(proj, tok0, n, PSC + g * 128, tid, vc); ssd_raw_ld<16, 3>(proj, tok0, n, PSB + g * 128, tid, vb); ssd_raw_ld<8, 2>(proj, tok0, n, PSX + h * 64, tid, vx);
#pragma unroll
      for (int k = 0; k < 2; ++k) { const int c = tid + 512 * k; vs[k] = *(const u32x4*)(st + (c >> 4) * 128 + (c & 15) * 8); }
      if (wave == 0) ssd_gates(p, layer, proj, tok0, h, F, lane);
      ssd_raw_st<16, 3>(rawC, tid, vc); ssd_raw_st<16, 3>(rawB, tid, vb); ssd_raw_st<8, 2>(rawX, tid, vx);
#pragma unroll
      for (int k = 0; k < 2; ++k) { const int c = tid + 512 * k; *(LAS u32x4*)(Sp + (c >> 4) * 136 + (c & 15) * 8) = vs[k]; } }
    WG_SYNC();
    { const float* cw = p.in(11) + (size_t)layer * 4 * 1280; const float* cb = p.in(12) + (size_t)layer * 1280;
      const int tok = tid >> 3, sub = tid & 7; float o[8];
#pragma unroll
      for (int half = 0; half < 2; ++half) { const int ch0 = sub * 16 + half * 8; u32x4 w;
          ssd_conv8(rawC, 128, tok, ch0, cw, cb, 1024 + g * 128 + ch0, o);
          w.x = pk2(o[0], o[1]); w.y = pk2(o[2], o[3]); w.z = pk2(o[4], o[5]); w.w = pk2(o[6], o[7]); *(LAS u32x4*)(Cs + tok * 136 + ch0) = w;
          ssd_conv8(rawB, 128, tok, ch0, cw, cb, 768 + g * 128 + ch0, o);
          w.x = pk2(o[0], o[1]); w.y = pk2(o[2], o[3]); w.z = pk2(o[4], o[5]); w.w = pk2(o[6], o[7]); *(LAS u32x4*)(Bs + tok * 136 + ch0) = w; }
      const float dt = F[64 + tok];
      ssd_conv8(rawX, 64, tok, sub * 8, cw, cb, h * 64 + sub * 8, o);
      { u32x4 w; w.x = pk2(o[0], o[1]); w.y = pk2(o[2], o[3]); w.z = pk2(o[4], o[5]); w.w = pk2(o[6], o[7]); *(LAS u32x4*)(XsN + tok * 72 + sub * 8) = w; }
#pragma unroll
      for (int i = 0; i < 8; ++i) XdT[(sub * 8 + i) * 72 + tok] = (bf16_t)f2bf(o[i] * dt);
    }
    WG_SYNC();
    const int fr = lane & 15, fq = lane >> 4;
    for (int t = wave * 2; t < wave * 2 + 2; ++t) { const int ti = t >> 2, tj = t & 3;
        f32x4 acc = (f32x4){0.f, 0.f, 0.f, 0.f};
        acc = mm16(Cs + ti * 16 * 136, 136, Bs + tj * 16 * 136, 136, 128, acc, fr, fq);
        const int i = ti * 16 + fr, j0 = tj * 16 + 4 * fq; const float ai = F[i]; float o[4];
#pragma unroll
        for (int jj = 0; jj < 4; ++jj) o[jj] = (i >= j0 + jj) ? acc[jj] * expf(ai - F[j0 + jj]) : 0.f;
        u32x2 w; w.x = pk2(o[0], o[1]); w.y = pk2(o[2], o[3]); *(LAS u32x2*)(Ms + i * 72 + j0) = w; }
    WG_SYNC();
    { const float Dh = p.in(15)[layer * 12 + h]; float* YS = (float*)(p.ws() + WS_XN);
      for (int t = wave * 2; t < wave * 2 + 2; ++t) { const int ti = t >> 2, tp = t & 3;
          f32x4 yd = (f32x4){0.f, 0.f, 0.f, 0.f}, yo = yd;
          yd = mm16(Ms + ti * 16 * 72, 72, XdT + tp * 16 * 72, 72, 64, yd, fr, fq);
          yo = mm16(Cs + ti * 16 * 136, 136, Sp + tp * 16 * 136, 136, 128, yo, fr, fq);
          const int i = ti * 16 + fr, p0 = tp * 16 + 4 * fq; const float ea = expf(F[i]);
          const u32x2 xv = *(const LAS u32x2*)(XsN + i * 72 + p0);
          const u32x2 zv = *(const u32x2*)(proj + (size_t)(tok0 + i) * PINP + PSZ + h * 64 + p0);
          const float xs0 = bf2f(xv.x & 0xffffu), xs1 = __uint_as_float(xv.x & 0xffff0000u), xs2 = bf2f(xv.y & 0xffffu), xs3 = __uint_as_float(xv.y & 0xffff0000u);
          const float z0 = bf2f(zv.x & 0xffffu), z1 = __uint_as_float(zv.x & 0xffff0000u), z2 = bf2f(zv.y & 0xffffu), z3 = __uint_as_float(zv.y & 0xffff0000u);
          f32x4 y; y.x = (yd[0] + yo[0] * ea + Dh * xs0) * fsilu(z0); y.y = (yd[1] + yo[1] * ea + Dh * xs1) * fsilu(z1);
          y.z = (yd[2] + yo[2] * ea + Dh * xs2) * fsilu(z2); y.w = (yd[3] + yo[3] * ea + Dh * xs3) * fsilu(z3);
          *(f32x4*)(YS + (size_t)(tok0 + i) * 768 + h * 64 + p0) = y; }
    }
    WG_SYNC();
}

__device__ __forceinline__ void ssd_gates6(const KPV& p, int layer, const bf16_t* proj, int tok0, int g, LAS float* F, int wave, int lane) {
    if (wave < 6) { const int h = g * 6 + wave;
        const float dtr = bf2f(proj[(size_t)(tok0 + lane) * PINP + PSDT + h]);
        const float dt = fsoftplus(dtr + p.in(14)[layer * 12 + h]);
        const float a = -expf(p.in(13)[layer * 12 + h]) * dt;
        F[wave * 64 + lane] = wave_incl_scan(a, lane); F[384 + wave * 64 + lane] = dt; }
}
constexpr int SG_RAWB = 0, SG_RAWX = 17152, SG_BT = 68608, SG_XDT = 87040, SG_F = 142336;
__device__ __forceinline__ void ssd_pre_g(const KPV& p, int layer, int unit, LAS unsigned char* lds, int tid, int wave, int lane) {
    const int b = unit / (NCH * 2), n = (unit >> 1) % NCH, g = unit & 1;
    const int tok0 = b * SEQ + n * CH;
    const bf16_t* proj = (const bf16_t*)(p.ws() + WS_AP);
    LAS bf16_t* rawB = (LAS bf16_t*)(lds + SG_RAWB); LAS bf16_t* rawX = (LAS bf16_t*)(lds + SG_RAWX);
    LAS bf16_t* BT = (LAS bf16_t*)(lds + SG_BT); LAS bf16_t* XdT = (LAS bf16_t*)(lds + SG_XDT); LAS float* F = (LAS float*)(lds + SG_F);
    { u32x4 vb[3], vx[7];
      ssd_raw_ld<16, 3>(proj, tok0, n, PSB + g * 128, tid, vb); ssd_raw_ld<48, 7>(proj, tok0, n, PSX + g * 384, tid, vx);
      ssd_gates6(p, layer, proj, tok0, g, F, wave, lane);
      ssd_raw_st<16, 3>(rawB, tid, vb); ssd_raw_st<48, 7>(rawX, tid, vx); }
    WG_SYNC();
    { const float* cw = p.in(11) + (size_t)layer * 4 * 1280; const float* cb = p.in(12) + (size_t)layer * 1280;
      const int tok = tid >> 3, sub = tid & 7; float o[8];
#pragma unroll
      for (int half = 0; half < 2; ++half) { const int ch0 = sub * 16 + half * 8;
          ssd_conv8(rawB, 128, tok, ch0, cw, cb, 768 + g * 128 + ch0, o);
#pragma unroll
          for (int i = 0; i < 8; ++i) BT[(ch0 + i) * 72 + tok] = (bf16_t)f2bf(o[i]); }
#pragma unroll 1
      for (int hh = 0; hh < 6; ++hh) { const float sc = F[384 + hh * 64 + tok] * expf(F[hh * 64 + 63] - F[hh * 64 + tok]);
          ssd_conv8(rawX, 384, tok, hh * 64 + sub * 8, cw, cb, (g * 6 + hh) * 64 + sub * 8, o);
#pragma unroll
          for (int i = 0; i < 8; ++i) XdT[(hh * 64 + sub * 8 + i) * 72 + tok] = (bf16_t)f2bf(o[i] * sc); }
    }
    WG_SYNC();
    { const int fr = lane & 15, fq = lane >> 4; bf16_t* stb = (bf16_t*)(p.ws() + WS_ST);
      for (int job = wave * 24; job < wave * 24 + 24; ++job) { const int hh = job >> 5, pt = (job >> 3) & 3, kt = job & 7;
          f32x4 acc = (f32x4){0.f, 0.f, 0.f, 0.f};
          acc = mm16(XdT + (hh * 64 + pt * 16) * 72, 72, BT + kt * 16 * 72, 72, 64, acc, fr, fq);
          u32x2 w; w.x = pk2(acc[0], acc[1]); w.y = pk2(acc[2], acc[3]);
          *(u32x2*)(stb + (size_t)((b * 12 + g * 6 + hh) * NCH + n) * 8192 + (pt * 16 + fr) * 128 + kt * 16 + 4 * fq) = w; }
      if (tid < 6) ((float*)(p.ws() + WS_CD))[(b * 12 + g * 6 + tid) * NCH + n] = expf(F[tid * 64 + 63]);
    }
    WG_SYNC();
}
constexpr int OG_RAWC = 0, OG_RAWB = 17152, OG_RAWX = 34304, OG_CS = 85760, OG_BS = 103168, OG_XDT = 120576, OG_XSN = 129792, OG_F = 139008, OG_SP = 0, OG_MS = 17408;
__device__ __forceinline__ void ssd_out_g(const KPV& p, int layer, int unit, LAS unsigned char* lds, int tid, int wave, int lane) {
    const int b = unit / (NCH * 2), n = (unit >> 1) % NCH, g = unit & 1;
    const int tok0 = b * SEQ + n * CH;
    const bf16_t* proj = (const bf16_t*)(p.ws() + WS_AP);
    LAS bf16_t* rawC = (LAS bf16_t*)(lds + OG_RAWC); LAS bf16_t* rawB = (LAS bf16_t*)(lds + OG_RAWB); LAS bf16_t* rawX = (LAS bf16_t*)(lds + OG_RAWX);
    LAS bf16_t* Cs = (LAS bf16_t*)(lds + OG_CS); LAS bf16_t* Bs = (LAS bf16_t*)(lds + OG_BS); LAS bf16_t* Sp = (LAS bf16_t*)(lds + OG_SP);
    LAS bf16_t* XdT = (LAS bf16_t*)(lds + OG_XDT); LAS bf16_t* XsN = (LAS bf16_t*)(lds + OG_XSN); LAS bf16_t* Ms = (LAS bf16_t*)(lds + OG_MS); LAS float* F = (LAS float*)(lds + OG_F);
    const float* cw = p.in(11) + (size_t)layer * 4 * 1280; const float* cb = p.in(12) + (size_t)layer * 1280;
    const int tok = tid >> 3, sub = tid & 7, fr = lane & 15, fq = lane >> 4;
    { u32x4 vc[3], vb[3], vx[7];
      ssd_raw_ld<16, 3>(proj, tok0, n, PSC + g * 128, tid, vc); ssd_raw_ld<16, 3>(proj, tok0, n, PSB + g * 128, tid, vb); ssd_raw_ld<48, 7>(proj, tok0, n, PSX + g * 384, tid, vx);
      ssd_gates6(p, layer, proj, tok0, g, F, wave, lane);
      ssd_raw_st<16, 3>(rawC, tid, vc); ssd_raw_st<16, 3>(rawB, tid, vb); ssd_raw_st<48, 7>(rawX, tid, vx); }
    WG_SYNC();
    { float o[8];
#pragma unroll
      for (int half = 0; half < 2; ++half) { const int ch0 = sub * 16 + half * 8; u32x4 w;
          ssd_conv8(rawC, 128, tok, ch0, cw, cb, 1024 + g * 128 + ch0, o);
          w.x = pk2(o[0], o[1]); w.y = pk2(o[2], o[3]); w.z = pk2(o[4], o[5]); w.w = pk2(o[6], o[7]); *(LAS u32x4*)(Cs + tok * 136 + ch0) = w;
          ssd_conv8(rawB, 128, tok, ch0, cw, cb, 768 + g * 128 + ch0, o);
          w.x = pk2(o[0], o[1]); w.y = pk2(o[2], o[3]); w.z = pk2(o[4], o[5]); w.w = pk2(o[6], o[7]); *(LAS u32x4*)(Bs + tok * 136 + ch0) = w; } }
    WG_SYNC();
    f32x4 cbt[2];
#pragma unroll
    for (int q = 0; q < 2; ++q) { const int t = wave * 2 + q, ti = t >> 2, tj = t & 3; cbt[q] = (f32x4){0.f, 0.f, 0.f, 0.f};
        cbt[q] = mm16(Cs + ti * 16 * 136, 136, Bs + tj * 16 * 136, 136, 128, cbt[q], fr, fq); }
    const bf16_t* stb = (const bf16_t*)(p.ws() + WS_ST); float* YS = (float*)(p.ws() + WS_XN);
    u32x4 vs[2];
#pragma unroll
    for (int k = 0; k < 2; ++k) { const int c = tid + 512 * k; vs[k] = *(const u32x4*)(stb + (size_t)((b * 12 + g * 6) * NCH + n) * 8192 + (c >> 4) * 128 + (c & 15) * 8); }
#pragma unroll 1
    for (int hh = 0; hh < 6; ++hh) { const int h = g * 6 + hh;
#pragma unroll
        for (int k = 0; k < 2; ++k) { const int c = tid + 512 * k; *(LAS u32x4*)(Sp + (c >> 4) * 136 + (c & 15) * 8) = vs[k]; }
        if (hh + 1 < 6) {
#pragma unroll
            for (int k = 0; k < 2; ++k) { const int c = tid + 512 * k; vs[k] = *(const u32x4*)(stb + (size_t)((b * 12 + h + 1) * NCH + n) * 8192 + (c >> 4) * 128 + (c & 15) * 8); } }
        u32x2 zv[2];
#pragma unroll
        for (int q = 0; q < 2; ++q) { const int t = wave * 2 + q, ti = t >> 2, tp = t & 3; zv[q] = *(const u32x2*)(proj + (size_t)(tok0 + ti * 16 + fr) * PINP + PSZ + h * 64 + tp * 16 + 4 * fq); }
        { float o[8]; const float dt = F[384 + hh * 64 + tok];
          ssd_conv8(rawX, 384, tok, hh * 64 + sub * 8, cw, cb, h * 64 + sub * 8, o);
          u32x4 w; w.x = pk2(o[0], o[1]); w.y = pk2(o[2], o[3]); w.z = pk2(o[4], o[5]); w.w = pk2(o[6], o[7]); *(LAS u32x4*)(XsN + tok * 72 + sub * 8) = w;
#pragma unroll
          for (int i = 0; i < 8; ++i) XdT[(sub * 8 + i) * 72 + tok] = (bf16_t)f2bf(o[i] * dt); }
#pragma unroll
        for (int q = 0; q < 2; ++q) { const int t = wave * 2 + q, ti = t >> 2, tj = t & 3, i = ti * 16 + fr, j0 = tj * 16 + 4 * fq; const float ai = F[hh * 64 + i]; float o[4];
#pragma unroll
            for (int jj = 0; jj < 4; ++jj) o[jj] = (i >= j0 + jj) ? cbt[q][jj] * expf(ai - F[hh * 64 + j0 + jj]) : 0.f;
            u32x2 w; w.x = pk2(o[0], o[1]); w.y = pk2(o[2], o[3]); *(LAS u32x2*)(Ms + i * 72 + j0) = w; }
        WG_SYNC();
        { const float Dh = p.in(15)[layer * 12 + h];
#pragma unroll
          for (int q = 0; q < 2; ++q) { const int t = wave * 2 + q, ti = t >> 2, tp = t & 3;
              f32x4 yd = (f32x4){0.f, 0.f, 0.f, 0.f}, yo = yd;
              yd = mm16(Ms + ti * 16 * 72, 72, XdT + tp * 16 * 72, 72, 64, yd, fr, fq);
              yo = mm16(Cs + ti * 16 * 136, 136, Sp + tp * 16 * 136, 136, 128, yo, fr, fq);
              const int i = ti * 16 + fr, p0 = tp * 16 + 4 * fq; const float ea = expf(F[hh * 64 + i]);
              const u32x2 xv = *(const LAS u32x2*)(XsN + i * 72 + p0); const u32x2 z2 = zv[q];
              const float xs0 = bf2f(xv.x & 0xffffu), xs1 = __uint_as_float(xv.x & 0xffff0000u), xs2 = bf2f(xv.y & 0xffffu), xs3 = __uint_as_float(xv.y & 0xffff0000u);
              const float z0 = bf2f(z2.x & 0xffffu), z1 = __uint_as_float(z2.x & 0xffff0000u), z2f = bf2f(z2.y & 0xffffu), z3 = __uint_as_float(z2.y & 0xffff0000u);
              f32x4 y; y.x = (yd[0] + yo[0] * ea + Dh * xs0) * fsilu(z0); y.y = (yd[1] + yo[1] * ea + Dh * xs1) * fsilu(z1);
              y.z = (yd[2] + yo[2] * ea + Dh * xs2) * fsilu(z2f); y.w = (yd[3] + yo[3] * ea + Dh * xs3) * fsilu(z3);
              *(f32x4*)(YS + (size_t)(tok0 + i) * 768 + h * 64 + p0) = y; }
        }
        WG_SYNC();
    }
}

constexpr int S5_WAVE_LDS = 12800;
struct S5Par { float abr, abi; float bbr[16], bbi[16]; };
__device__ __forceinline__ void s5_params(const KPV& p, int layer, int g, int n, S5Par& P) {
    const int gi = (layer * 32 + g) * 64 + n;
    const float are = p.in(17)[gi], aim = p.in(18)[gi], delta = expf(p.in(24)[layer * 32 + g]);
    const float mag = expf(are * delta); float sn, cs; sincosf(aim * delta, &sn, &cs);
    P.abr = mag * cs; P.abi = mag * sn;
    const float den = are * are + aim * aim, pre = P.abr - 1.f, pim = P.abi;
    const float fre = (pre * are + pim * aim) / den, fim = (pim * are - pre * aim) / den;
    const float* br = p.in(19) + (size_t)gi * 16; const float* bi = p.in(20) + (size_t)gi * 16;
#pragma unroll
    for (int i4 = 0; i4 < 4; ++i4) { const f32x4 r = *(const f32x4*)(br + 4 * i4), im = *(const f32x4*)(bi + 4 * i4);
#pragma unroll
        for (int j = 0; j < 4; ++j) { P.bbr[4 * i4 + j] = fre * r[j] - fim * im[j]; P.bbi[4 * i4 + j] = fre * im[j] + fim * r[j]; } }
}
__device__ __forceinline__ void s5_load_u(const bf16_t* proj, int tok0, int g, LAS float* Us, int lane) {
    const bf16_t* src = proj + (size_t)(tok0 + lane) * PINP + PU + g * 16;
    float x[16]; unpack8(*(const u32x4*)src, x); unpack8(*(const u32x4*)(src + 8), x + 8);
#pragma unroll
    for (int i4 = 0; i4 < 4; ++i4) *(LAS f32x4*)(Us + lane * 16 + 4 * i4) = (f32x4){x[4 * i4], x[4 * i4 + 1], x[4 * i4 + 2], x[4 * i4 + 3]};
    asm volatile("s_waitcnt lgkmcnt(0)" ::: "memory"); __builtin_amdgcn_wave_barrier();
}
__device__ __forceinline__ void s5_step(const S5Par& P, const LAS float* Us, int t, float& hr, float& hi) {
    float bur = 0.f, bui = 0.f;
#pragma unroll
    for (int i4 = 0; i4 < 4; ++i4) { const f32x4 u = *(const LAS f32x4*)(Us + t * 16 + 4 * i4);
#pragma unroll
        for (int j = 0; j < 4; ++j) { bur += u[j] * P.bbr[4 * i4 + j]; bui += u[j] * P.bbi[4 * i4 + j]; } }
    const float nr = P.abr * hr - P.abi * hi + bur, ni = P.abr * hi + P.abi * hr + bui; hr = nr; hi = ni;
}
__device__ __forceinline__ void s5_pass1(const KPV& p, int layer, int wu, LAS unsigned char* wl, int lane, const S5Par& P) {
    const int b = wu / (NCH * 32), c = (wu / 32) % NCH, g = wu % 32;
    const bf16_t* proj = (const bf16_t*)(p.ws() + WS_AP); LAS float* Us = (LAS float*)wl;
    s5_load_u(proj, b * SEQ + c * CH, g, Us, lane);
    float hr = 0.f, hi = 0.f;
#pragma unroll 4
    for (int t = 0; t < CH; ++t) s5_step(P, Us, t, hr, hi);
    ((f32x2*)(p.ws() + WS_E5))[(size_t)((b * NCH + c) * 32 + g) * 64 + lane] = (f32x2){hr, hi};
    asm volatile("s_waitcnt lgkmcnt(0)" ::: "memory"); __builtin_amdgcn_wave_barrier();
}
__device__ __forceinline__ void s5_shadow_unit(const KPV& p, int layer, int wu, LAS unsigned char* wl, int lane) { S5Par P; s5_params(p, layer, wu & 31, lane, P); s5_pass1(p, layer, wu, wl, lane, P); }
__device__ __forceinline__ float gelu_tanh(float y) { const float x = 0.7978845608028654f * (y + 0.044715f * y * y * y); const float t = 1.f - 2.f / (__expf(2.f * x) + 1.f); return 0.5f * y * (1.f + t); }
__device__ __forceinline__ void s5_setup_c(const KPV& p, int layer, int g, LAS unsigned char* wl, int lane) {
    LAS bf16_t* Cc = (LAS bf16_t*)(wl + 8448);
    const float* cr = p.in(21) + (size_t)(layer * 32 + g) * 16 * 64; const float* ci = p.in(22) + (size_t)(layer * 32 + g) * 16 * 64;
#pragma unroll
    for (int i = 0; i < 16; ++i) *(LAS unsigned*)(Cc + i * 136 + 2 * lane) = pk2(cr[i * 64 + lane], -ci[i * 64 + lane]);
}
__device__ __forceinline__ void s5_pass2(const KPV& p, int layer, int wu, LAS unsigned char* wl, int lane, const S5Par& P) {
    const int b = wu / (NCH * 32), c = (wu / 32) % NCH, g = wu % 32;
    const bf16_t* proj = (const bf16_t*)(p.ws() + WS_AP); LAS float* Us = (LAS float*)wl; LAS bf16_t* Hs = (LAS bf16_t*)(wl + 4096); LAS bf16_t* Cc = (LAS bf16_t*)(wl + 8448);
    const int tok0 = b * SEQ + c * CH;
    s5_load_u(proj, tok0, g, Us, lane);
    float a64r = P.abr, a64i = P.abi;
#pragma unroll
    for (int s = 0; s < 6; ++s) { const float r = a64r * a64r - a64i * a64i, i2 = 2.f * a64r * a64i; a64r = r; a64i = i2; }
    float hr = 0.f, hi = 0.f;
    { const f32x2* E = (const f32x2*)(p.ws() + WS_E5) + (size_t)(b * NCH * 32 + g) * 64 + lane;
#pragma unroll 1
      for (int cc0 = 0; cc0 < c; cc0 += 8) { f32x2 e[8];
#pragma unroll
          for (int k = 0; k < 8; ++k) e[k] = (cc0 + k < c) ? E[(size_t)(cc0 + k) * 32 * 64] : (f32x2){0.f, 0.f};
#pragma unroll
          for (int k = 0; k < 8; ++k) if (cc0 + k < c) { const float nr = a64r * hr - a64i * hi + e[k].x, ni = a64r * hi + a64i * hr + e[k].y; hr = nr; hi = ni; } } }
    const int fr = lane & 15, fq = lane >> 4;
    const f32x4 dsk = *(const f32x4*)(p.in(23) + layer * 512 + g * 16 + 4 * fq);
    bf16_t* G5 = (bf16_t*)(p.ws() + WS_G5);
    for (int sb = 0; sb < 4; ++sb) {
        for (int t = 0; t < 16; ++t) { s5_step(P, Us, sb * 16 + t, hr, hi); *(LAS unsigned*)(Hs + t * 136 + 2 * lane) = pk2(hr, hi); }
        asm volatile("s_waitcnt lgkmcnt(0)" ::: "memory"); __builtin_amdgcn_wave_barrier();
        f32x4 acc = (f32x4){0.f, 0.f, 0.f, 0.f};
        acc = mm16(Hs, 136, Cc, 136, 128, acc, fr, fq);
        const f32x4 uu = *(const LAS f32x4*)(Us + (sb * 16 + fr) * 16 + 4 * fq);
        u32x2 w; w.x = pk2(gelu_tanh(acc[0] + dsk.x * uu.x), gelu_tanh(acc[1] + dsk.y * uu.y)); w.y = pk2(gelu_tanh(acc[2] + dsk.z * uu.z), gelu_tanh(acc[3] + dsk.w * uu.w));
        *(u32x2*)(G5 + (size_t)(tok0 + sb * 16 + fr) * 512 + g * 16 + 4 * fq) = w;
        asm volatile("s_waitcnt lgkmcnt(0)" ::: "memory"); __builtin_amdgcn_wave_barrier();
    }
}

__device__ __forceinline__ void gdn_finish(const KPV& p, int layer, int first, int stride, int lane) {
    const bf16_t* GO = (const bf16_t*)(p.ws() + WS_GO); const bf16_t* proj = (const bf16_t*)(p.ws() + WS_AP); bf16_t* MX = (bf16_t*)(p.ws() + WS_MIX);
    const int l = lane & 31; const f32x4 wv = *(const f32x4*)(p.in(10) + layer * 128 + 4 * l);
    constexpr int NIT = M * 6 / 2;
    for (int it0 = first; it0 < NIT; it0 += 4 * stride) { u32x2 ov[4], zv[4];
#pragma unroll
        for (int k = 0; k < 4; ++k) { const int it = it0 + k * stride; if (it < NIT) { const int th = it * 2 + (lane >> 5), tok = th / 6, h = th % 6;
            ov[k] = *(const u32x2*)(GO + (size_t)tok * 768 + h * 128 + 4 * l); zv[k] = *(const u32x2*)(proj + (size_t)tok * PINP + PZ + h * 128 + 4 * l); } }
#pragma unroll
        for (int k = 0; k < 4; ++k) { const int it = it0 + k * stride; if (it < NIT) { const int th = it * 2 + (lane >> 5), tok = th / 6, h = th % 6;
            const float o0 = bf2f(ov[k].x & 0xffffu), o1 = __uint_as_float(ov[k].x & 0xffff0000u), o2 = bf2f(ov[k].y & 0xffffu), o3 = __uint_as_float(ov[k].y & 0xffff0000u);
            const float z0 = bf2f(zv[k].x & 0xffffu), z1 = __uint_as_float(zv[k].x & 0xffff0000u), z2 = bf2f(zv[k].y & 0xffffu), z3 = __uint_as_float(zv[k].y & 0xffff0000u);
            float ss = (o0 * o0 + o1 * o1) + (o2 * o2 + o3 * o3);
            ss += __shfl_xor(ss, 1); ss += __shfl_xor(ss, 2); ss += __shfl_xor(ss, 4); ss += __shfl_xor(ss, 8); ss += __shfl_xor(ss, 16);
            const float r = rsqrtf(ss * (1.f / 128.f) + EPS);
            u32x2 w; w.x = pk2(o0 * r * wv.x * fsilu(z0), o1 * r * wv.y * fsilu(z1)); w.y = pk2(o2 * r * wv.z * fsilu(z2), o3 * r * wv.w * fsilu(z3));
            *(u32x2*)(MX + (size_t)tok * 2048 + h * 128 + 4 * l) = w; } }
    }
}
__device__ __forceinline__ void ssd_finish(const KPV& p, int layer, int first, int stride, int lane) {
    const float* YS = (const float*)(p.ws() + WS_XN); bf16_t* MX = (bf16_t*)(p.ws() + WS_MIX); const float* nw = p.in(16) + layer * 768;
    for (int it0 = first; it0 < M * 2; it0 += 4 * stride) { f32x2 v[4][3];
#pragma unroll
        for (int k = 0; k < 4; ++k) { const int it = it0 + k * stride; if (it < M * 2) { const float* y = YS + (size_t)(it >> 1) * 768 + (it & 1) * 384;
#pragma unroll
            for (int q = 0; q < 3; ++q) v[k][q] = *(const f32x2*)(y + 2 * lane + 128 * q); } }
#pragma unroll
        for (int k = 0; k < 4; ++k) { const int it = it0 + k * stride; if (it < M * 2) { const int tok = it >> 1, g = it & 1; float ss = 0.f;
#pragma unroll
            for (int q = 0; q < 3; ++q) ss += v[k][q].x * v[k][q].x + v[k][q].y * v[k][q].y;
            const float r = rsqrtf(wave_sum(ss) * (1.f / 384.f) + EPS);
#pragma unroll
            for (int q = 0; q < 3; ++q) { const f32x2 w = *(const f32x2*)(nw + g * 384 + 2 * lane + 128 * q);
                *(unsigned*)(MX + (size_t)tok * 2048 + 768 + g * 384 + 2 * lane + 128 * q) = pk2(v[k][q].x * r * w.x, v[k][q].y * r * w.y); } } }
    }
}

#define XB_TMO      128
#define XB_XCNT(j)  (256  + 64 * (j))
#define XB_XSUB(j)  (1280 + 64 * (j))
#define XB_XGEN(j)  (2304 + 64 * (j))
#define XB_TOP      3328
#define XB_TOPGEN   3392
#define XCD_BAR_WORDS 3456
#define XB_SPIN_CAP (1u << 18)

__device__ __forceinline__ unsigned xb_ld(unsigned* p)              { return __hip_atomic_load(p, __ATOMIC_RELAXED, __HIP_MEMORY_SCOPE_AGENT); }
__device__ __forceinline__ unsigned xb_add(unsigned* p, unsigned v) { return __hip_atomic_fetch_add(p, v, __ATOMIC_RELAXED, __HIP_MEMORY_SCOPE_AGENT); }
__device__ __forceinline__ unsigned xb_xcc_id() { return (unsigned)__builtin_amdgcn_s_getreg((3 << 11) | 20) & 0xFu; }
#define XB_SPIN(cond, bar) do { unsigned _sp = 0; while (cond) { __builtin_amdgcn_s_sleep(1); \
    if ((++_sp & 255u) == 0u) { if (xb_ld(&(bar)[XB_TMO])) break; if (_sp > XB_SPIN_CAP) { atomicAdd(&(bar)[XB_TMO], 1u); break; } } } } while (0)

struct XcdBarrier {
    unsigned* bar; unsigned x;
    volatile LAS unsigned* st;
};

__device__ __forceinline__ XcdBarrier xcd_barrier_post(unsigned* bar, volatile LAS unsigned* st) {
    XcdBarrier b; b.bar = bar; b.x = xb_xcc_id(); b.st = st;
    if (threadIdx.x == 0) (void)xb_add(&bar[XB_XCNT(b.x)], 1u);
    return b;
}
__device__ __forceinline__ void xcd_barrier_complete(unsigned* bar, unsigned x, unsigned& nloc, unsigned& nx) {
    const unsigned G = gridDim.x * gridDim.y * gridDim.z;
    unsigned sum, cnt, mine, sp = 0u;
    for (;;) {
        sum = 0u; cnt = 0u; mine = 0u;
#pragma unroll
        for (unsigned j = 0; j < 16; ++j) { const unsigned c = xb_ld(&bar[XB_XCNT(j)]); sum += c; cnt += (c > 0u) ? 1u : 0u; mine = (j == x) ? c : mine; }
        if (sum == G) break;
        __builtin_amdgcn_s_sleep(1);
        if ((++sp & 255u) == 0u) { if (xb_ld(&bar[XB_TMO])) break; if (sp > XB_SPIN_CAP) { atomicAdd(&bar[XB_TMO], 1u); break; } }
    }
    nloc = mine > 0u ? mine : 1u; nx = cnt > 0u ? cnt : 1u;
}

__device__ __forceinline__ void xcd_barrier(const XcdBarrier& b) {
    asm volatile("s_waitcnt vmcnt(0)" ::: "memory");
    __syncthreads();
    if (threadIdx.x == 0) {
        unsigned* bar = b.bar;
        __builtin_amdgcn_s_waitcnt(0);
        unsigned nloc = b.st[0], nx = b.st[1];
        if (nloc == 0u) { xcd_barrier_complete(bar, b.x, nloc, nx); b.st[0] = nloc; b.st[1] = nx; }
        const unsigned old = xb_add(&bar[XB_XSUB(b.x)], 1u);
        const unsigned gen = old / nloc;
        if (old + 1u == (gen + 1u) * nloc) {
            __builtin_amdgcn_fence(__ATOMIC_RELEASE, "agent");
            asm volatile("s_waitcnt vmcnt(0)" ::: "memory");
            const unsigned og = xb_add(&bar[XB_TOP], 1u);
            const unsigned tg = og / nx;
            if (og + 1u == (tg + 1u) * nx) xb_add(&bar[XB_TOPGEN], 1u);
            else XB_SPIN(xb_ld(&bar[XB_TOPGEN]) == tg, bar);
            __builtin_amdgcn_fence(__ATOMIC_ACQUIRE, "agent");
            xb_add(&bar[XB_XGEN(b.x)], 1u);
            asm volatile("s_waitcnt vmcnt(0)" ::: "memory");
        } else {
            XB_SPIN(xb_ld(&bar[XB_XGEN(b.x)]) == gen, bar);
            __builtin_amdgcn_fence(__ATOMIC_ACQUIRE, "agent");
            asm volatile("s_waitcnt vmcnt(0)" ::: "memory");
        }
    }
    __syncthreads();
}

constexpr int NPH_LAYER = 13, NPHASES = 2 * NPH_LAYER + 1;
template <int PH, int SEL = 7>
__device__ __forceinline__ void run_phase(LAS unsigned char* lds) {
    const AS4 KP* kp_ = (const AS4 KP*)__builtin_amdgcn_kernarg_segment_ptr();
    asm volatile("" : "+s"(kp_));
    const KPV p{kp_};
    int tid = threadIdx.x; asm volatile("" : "+v"(tid));
    int G = gridDim.x, bid = blockIdx.x; asm volatile("" : "+s"(G), "+s"(bid)); const int NGW = G * 8;
    const int lane = tid & 63, wave = __builtin_amdgcn_readfirstlane(tid >> 6), gw = bid * 8 + wave;
    unsigned char* ws = p.ws(); float* hbuf = p.out();
    bf16_t* HB = (bf16_t*)(ws + WS_H); bf16_t* AP = (bf16_t*)(ws + WS_AP); bf16_t* MX = (bf16_t*)(ws + WS_MIX);
    if constexpr (PH == NPHASES - 1) { norm_phase<true>(hbuf, p.in(32), nullptr, p.out(), gw, NGW, lane); return; }
    constexpr int layer = PH / NPH_LAYER, s = PH % NPH_LAYER;
    if constexpr (s == 0) {
        convert_phase(p, layer, lds, gw, NGW, wave, lane);
        if constexpr (layer == 0) { float* SSQ = (float*)(ws + WS_SSQ);
            norm_raw_phase(p.in(0), nullptr, HB, SSQ, gw, NGW, lane); }
    } else if constexpr (s == 1 || s == 11) {
        pg8::Gemm g{HB, (const bf16_t*)(ws + (s == 1 ? WS_WGU1 : WS_WGU2)), M, 2 * FF, D}; pg8::FixedOrder<64, 44> S{G, bid};
        pg8::rstd_table(S, (const float*)(ws + WS_SSQ) + (size_t)(layer * 3 + (s == 1 ? 0 : 2)) * M * 32, (LAS float*)(lds + 131072));
        pg8::EpiSwiGLU E{AP, FF, (const LAS float*)(lds + 131072)};
        pg8::gemm_phase<pg8::EpiSwiGLU, decltype(S), true, true>(lds, g, S, E);
    } else if constexpr (s == 2 || s == 12) {
        pg8::Gemm g{AP, (const bf16_t*)(ws + (s == 2 ? WS_WD1 : WS_WD2)), M, D, FF}; pg8::FixedOrder<64, 8> S{G, bid};
        if constexpr (layer == 1 && s == 12) { pg8::EpiResidOut E{HB, hbuf, D, 0.5f}; pg8::gemm_phase<pg8::EpiResidOut, decltype(S), false, true>(lds, g, S, E); }
        else { pg8::EpiResidH E{(layer == 0 && s == 2 && SEL != 0) ? p.in(0) : nullptr, HB, D, SEL == 0 ? 0.f : 0.5f,
                                (float*)(ws + WS_SSQ) + (size_t)(s == 2 ? layer * 3 + 1 : (layer + 1) * 3) * M * 32};
            pg8::gemm_phase<pg8::EpiResidH, decltype(S), false, true>(lds, g, S, E); }
    } else if constexpr (s == 4) {
        pg8::Gemm g{HB, (const bf16_t*)(ws + WS_WIN), M, PINP, D}; pg8::FixedOrder<64, 23> S{G, bid};
        pg8::rstd_table(S, (const float*)(ws + WS_SSQ) + (size_t)(layer * 3 + 1) * M * 32, (LAS float*)(lds + 131072));
        pg8::EpiBf16 E{AP, PINP, (const LAS float*)(lds + 131072)};
        pg8::gemm_phase<pg8::EpiBf16, decltype(S), true, true>(lds, g, S, E);
    } else if constexpr (s == 5) {
        int s5_done = 0;
        if (SEL & 1) for (int u = bid, it = 0; u < NBATCH * 6 * NCH; u += G, ++it) { int wu = -1;
            if ((SEL & 4) && wave > 0) { const int slot = it * 7 + (wave - 1); const int cand = bid * 8 + (slot & 7) + (slot >> 3) * NGW; if (cand < NBATCH * NCH * 32) wu = cand; }
            gdn_pre_unit(p, layer, u, lds, tid, wave, lane, wu); if (SEL & 4) s5_done = (it + 1) * 7; }
        if (SEL & 2) for (int u = bid; u < NBATCH * NCH * 2; u += G) ssd_pre_g(p, layer, u, lds, tid, wave, lane);
        if (SEL & 4) for (int slot = s5_done + wave; ; slot += 8) { const int wu = bid * 8 + (slot & 7) + (slot >> 3) * NGW; if (wu >= NBATCH * NCH * 32) break;
            s5_shadow_unit(p, layer, wu, lds + wave * S5_WAVE_LDS, lane); }
    } else if constexpr (s == 6) {
        const int NSC = NBATCH * 6 * 4;
        if (SEL & 1) for (int u = bid; u < NSC; u += G) gdn_scan_unit(p, u, lds, tid, wave, lane);
        if (SEL & 2) { if (G > NSC) { if (bid >= NSC) ssd_scan_items(p, (bid - NSC) * 512 + tid, (G - NSC) * 512); }
        else ssd_scan_items(p, bid * 512 + tid, G * 512); }
    } else if constexpr (s == 7) {
        if (SEL & 2) for (int u = bid; u < NBATCH * NCH * 2; u += G) ssd_out_g(p, layer, u, lds, tid, wave, lane);
        if (SEL & 4) { if ((NGW & 31) == 0) { S5Par P; s5_params(p, layer, gw & 31, lane, P); s5_setup_c(p, layer, gw & 31, lds + wave * S5_WAVE_LDS, lane);
                for (int u = gw; u < NBATCH * NCH * 32; u += NGW) s5_pass2(p, layer, u, lds + wave * S5_WAVE_LDS, lane, P); }
            else for (int u = gw; u < NBATCH * NCH * 32; u += NGW) { S5Par P; s5_params(p, layer, u & 31, lane, P); s5_setup_c(p, layer, u & 31, lds + wave * S5_WAVE_LDS, lane); s5_pass2(p, layer, u, lds + wave * S5_WAVE_LDS, lane, P); } }
    } else if constexpr (s == 8) {
        pg8::Gemm g{(const bf16_t*)(ws + WS_G5), (const bf16_t*)(ws + WS_WGLU), M, 512, 512}; pg8::FixedOrder<64, 2> S{G, bid};
        pg8::EpiGlu E{(const bf16_t*)(ws + WS_G5), 512, MX, 2048, 1536, p.in(26) + layer * 512};
        pg8::gemm_phase<pg8::EpiGlu, decltype(S), true, true>(lds, g, S, E);
        gdn_finish(p, layer, gw, NGW, lane); ssd_finish(p, layer, gw, NGW, lane);
    } else if constexpr (s == 9) {
        pg8::Gemm g{MX, (const bf16_t*)(ws + WS_WOUT), M, D, D}; pg8::FixedOrder<64, 8> S{G, bid};
        pg8::EpiResidH E{nullptr, HB, D, SEL == 0 ? 0.f : 1.0f, (float*)(ws + WS_SSQ) + (size_t)(layer * 3 + 2) * M * 32};
        pg8::gemm_phase<pg8::EpiResidH, decltype(S), false, true>(lds, g, S, E);
    }
}
__global__ void __launch_bounds__(512) mk_fwd(KP pk) {
    extern __shared__ __attribute__((aligned(16))) unsigned char lds_raw[];
    LAS unsigned char* lds = (LAS unsigned char*)lds_raw;
    const int lo = pk.ph_lo, hi = pk.ph_hi;
    volatile LAS unsigned* xst = (volatile LAS unsigned*)(lds + LDS_BYTES - 64);
    if (threadIdx.x < 2) xst[threadIdx.x] = 0u;
    __syncthreads();
    XcdBarrier xbar = xcd_barrier_post((unsigned*)pk.ws, xst);
    bool first_sync = true;
#ifndef DUP_MASK
#define DUP_MASK 0
#endif
#ifndef DUPSEL5
#define DUPSEL5 DUPSEL
#endif
#ifndef DUPSEL
#define DUPSEL 7
#endif
#ifndef DUP_MIXTO
#define DUP_MIXTO 0
#endif
#ifndef EXTRA_SYNCS
#define EXTRA_SYNCS 0
#endif
#define RUN(k) if (lo <= (k) && (k) < hi && (k) % NPH_LAYER != 3 && (k) % NPH_LAYER != 10) { if ((k) > lo) { if (first_sync) { cg::this_grid().sync(); first_sync = false; } else xcd_barrier(xbar); } for (int xs_ = 0; xs_ < EXTRA_SYNCS; ++xs_) xcd_barrier(xbar); run_phase<(k)>(lds); \
        if (((DUP_MASK >> ((k) % NPH_LAYER)) & 1) && (k) < NPHASES - 1) { xcd_barrier(xbar); run_phase<(k), (((k) % NPH_LAYER == 2 || (k) % NPH_LAYER == 9 || (k) % NPH_LAYER == 12) ? 0 : 7)>(lds); } \
        if ((k) % NPH_LAYER == 8 && (k) < NPHASES - 1) { \
            if (DUP_MIXTO >= 5) { cg::this_grid().sync(); run_phase<(k) - 3, DUPSEL5>(lds); } if (DUP_MIXTO >= 6) { cg::this_grid().sync(); run_phase<(k) - 2, DUPSEL>(lds); } \
            if (DUP_MIXTO >= 7) { cg::this_grid().sync(); run_phase<(k) - 1, DUPSEL>(lds); } if (DUP_MIXTO >= 8) { cg::this_grid().sync(); run_phase<(k)>(lds); } } }
    RUN(0) RUN(1) RUN(2) RUN(3) RUN(4) RUN(5) RUN(6) RUN(7) RUN(8) RUN(9) RUN(10) RUN(11) RUN(12)
    RUN(13) RUN(14) RUN(15) RUN(16) RUN(17) RUN(18) RUN(19) RUN(20) RUN(21) RUN(22) RUN(23) RUN(24) RUN(25) RUN(26)
#undef RUN
}

extern "C" void kernel_launch(void* const* d_in, const int* in_sizes, int n_in, void* d_out, int out_size, void* d_ws, size_t ws_size, hipStream_t stream) {
    static int grid = 0;
    if (grid == 0) {
        if (n_in != 33 || in_sizes[0] != M * D || out_size != M * D || ws_size < WS_END) { fprintf(stderr, "kernel_launch: unexpected shapes / workspace (n_in %d, ws %zu < %zu)\n", n_in, ws_size, (size_t)WS_END); grid = -1; return; }
        int dev = 0, cus = 0, per_cu = 0;
        hipGetDevice(&dev); hipDeviceGetAttribute(&cus, hipDeviceAttributeMultiprocessorCount, dev);
        if (hipFuncSetAttribute((const void*)mk_fwd, hipFuncAttributeMaxDynamicSharedMemorySize, LDS_BYTES) != hipSuccess) { fprintf(stderr, "kernel_launch: hipFuncSetAttribute failed\n"); grid = -1; return; }
        if (hipOccupancyMaxActiveBlocksPerMultiprocessor(&per_cu, (const void*)mk_fwd, 512, LDS_BYTES) != hipSuccess || per_cu < 1) { fprintf(stderr, "kernel_launch: occupancy query says %d\n", per_cu); per_cu = 1; }
        (void)hipGetLastError();
        grid = cus;
    }
    if (grid < 0) return;
    if (hipMemsetAsync(d_ws, 0, 16384, stream) != hipSuccess) { fprintf(stderr, "kernel_launch: memset of the barrier words failed\n"); return; }
    KP a{};
    for (int i = 0; i < 33; ++i) a.in[i] = (const float*)d_in[i];
    a.out = (float*)d_out; a.ws = (unsigned char*)d_ws;
#if MK_MULTI
    for (int ph = 0; ph < NPHASES; ++ph) { if (ph % NPH_LAYER == 3 || ph % NPH_LAYER == 10) continue; a.ph_lo = ph; a.ph_hi = ph + 1; hipLaunchKernelGGL(mk_fwd, dim3(grid), dim3(512), LDS_BYTES, stream, a); }
#else
    a.ph_lo = 0; a.ph_hi = NPHASES;
    void* args[] = {&a};
    hipError_t e = hipLaunchCooperativeKernel((const void*)mk_fwd, dim3(grid), dim3(512), args, LDS_BYTES, stream);
    if (e != hipSuccess) fprintf(stderr, "cooperative launch failed: %s (grid %d)\n", hipGetErrorString(e), grid);
#endif
}
```

```cpp
#include <hip/hip_runtime.h>
#include <hip/hip_cooperative_groups.h>
#include <cstdio>
#include <cstdint>
namespace cg = cooperative_groups;
#ifndef MK_MULTI
#define MK_MULTI 0
#endif
#ifndef MIXSEL
#define MIXSEL 7
#endif
namespace pg8 {
#define PG8_LAS __attribute__((address_space(3)))
typedef unsigned short bf16_t;
typedef short bf16x8 __attribute__((ext_vector_type(8)));
typedef float f32x4 __attribute__((ext_vector_type(4)));
typedef unsigned u32x4 __attribute__((ext_vector_type(4)));
constexpr int BM = 256, BK = 64, HALF = 128, HTB = HALF * BK * 2  , STAGE_BYTES = 8 * HTB, NXCD = 8, WGM = 8;

__host__ __device__ __forceinline__ int lds_byte(int r, int c) { const int st = (r >> 4) * 2 + (c >> 5), rr = r & 15, cc = c & 31, ob = rr * 64 + cc * 2; return st * 1024 + (ob ^ (((ob >> 9) & 1) << 5)); }
__host__ __device__ __forceinline__ void stage_rc(int b, int& R, int& C) { const int st = b / 1024, sb = b % 1024, swz = sb ^ (((sb >> 9) & 1) << 5); R = (st >> 1) * 16 + swz / 64; C = (st & 1) * 32 + (swz % 64) / 2; }
__host__ __device__ __forceinline__ int perm32(int rho) { const int n = rho >> 4, i = rho & 15; return 8 * (i >> 2) + 4 * n + (i & 3); }

struct Unit { int pm, pn; };
struct Gemm { const bf16_t* A; const bf16_t* Bt; int M, N, K; };

struct StaticOrder {
    int nM, nN, nwg, G, c;
    __host__ __device__ void init(int M, int N, int G_, int c_) { nM = M / BM; nN = N / BM; nwg = nM * nN; G = G_; c = c_; }
    __host__ __device__ bool next(int i, Unit& u) const {
        const long L = (long)i * G + c; if (L >= nwg) return false;
        int wgid = (int)L; { const int q = nwg / NXCD, r = nwg % NXCD, xcd = wgid % NXCD, off = wgid / NXCD; wgid = (xcd < r ? xcd * (q + 1) : r * (q + 1) + (xcd - r) * q) + off; }
        const int nig = WGM * nN, gid = wgid / nig, fm = gid * WGM, gsz = (nM - fm) < WGM ? (nM - fm) : WGM;
        u.pm = fm + ((wgid % nig) % gsz); u.pn = (wgid % nig) / gsz; return true;
    }
    __device__ __forceinline__ void a_ready(const Unit&) const {}
    __device__ __forceinline__ void done(const Unit&) const {}
};

typedef __bf16 bf16v2_t __attribute__((ext_vector_type(2)));
typedef float f32x2c_t __attribute__((ext_vector_type(2)));
__device__ __forceinline__ unsigned cvt_pk_bf16(float lo, float hi) { const bf16v2_t v = __builtin_convertvector((f32x2c_t){lo, hi}, bf16v2_t); return __builtin_bit_cast(unsigned, v); }
typedef float f32x2 __attribute__((ext_vector_type(2)));
typedef unsigned u32x2 __attribute__((ext_vector_type(2)));
__device__ __forceinline__ float fsilu(float x) { return x / (1.f + __expf(-x)); }
__device__ __forceinline__ float fsigmoid(float x) { return 1.f / (1.f + __expf(-x)); }
template <class Sched>
__device__ __forceinline__ void rstd_table(const Sched& S, const float* ssq, PG8_LAS float* rtab) {
    const int t = threadIdx.x, row = t >> 1, half = t & 1; unsigned done = 0u; Unit u;
    for (int i = 0; S.next(i, u); ++i) { const unsigned bit = 1u << (u.pm & 15); if (done & bit) continue; done |= bit;
        const f32x4* q = (const f32x4*)(ssq + (size_t)(u.pm * BM + row) * 32 + half * 16);
        f32x4 a = (q[0] + q[1]) + (q[2] + q[3]); float s = (a[0] + a[1]) + (a[2] + a[3]); s += __shfl_xor(s, 1);
        if (half == 0) rtab[(u.pm & 15) * 256 + row] = rsqrtf(s * (1.f / 2048.f) + 1e-6f); }
    __syncthreads();
}
struct EpiBf16 {
    static constexpr bool PERM = true, AFTER_DRAIN = false;
    bf16_t* O; int ldc; const PG8_LAS float* rtab;
    __device__ __forceinline__ void operator()(const f32x4 (&acc)[2][2][4][2], const Unit& u, int wr, int wc, int fr, int fq) const {
        const int row0 = u.pm * BM + wr * 64 + fr, col0 = u.pn * BM + wc * 32 + 8 * fq;
#pragma unroll
        for (int ai = 0; ai < 2; ++ai)
#pragma unroll
            for (int m = 0; m < 4; ++m) { bf16_t* rowp = O + (size_t)(row0 + ai * HALF + m * 16) * ldc + col0;
                const float rs = rtab[(u.pm & 15) * 256 + wr * 64 + fr + ai * HALF + m * 16];
#pragma unroll
                for (int bj = 0; bj < 2; ++bj) { const f32x4 v0 = acc[ai][bj][m][0] * rs, v1 = acc[ai][bj][m][1] * rs;
                    u32x4 w; w.x = cvt_pk_bf16(v0[0], v0[1]); w.y = cvt_pk_bf16(v0[2], v0[3]); w.z = cvt_pk_bf16(v1[0], v1[1]); w.w = cvt_pk_bf16(v1[2], v1[3]);
                    *(u32x4*)(rowp + bj * HALF) = w; } }
    }
};
struct EpiSwiGLU {
    static constexpr bool PERM = true, AFTER_DRAIN = false;
    bf16_t* O; int ldc; const PG8_LAS float* rtab;
    __device__ __forceinline__ void operator()(const f32x4 (&acc)[2][2][4][2], const Unit& u, int wr, int wc, int fr, int fq) const {
        const int row0 = u.pm * BM + wr * 64 + fr, col0 = u.pn * HALF + wc * 32 + 8 * fq;
#pragma unroll
        for (int ai = 0; ai < 2; ++ai)
#pragma unroll
            for (int m = 0; m < 4; ++m) { bf16_t* rowp = O + (size_t)(row0 + ai * HALF + m * 16) * ldc + col0;
                const float rs = rtab[(u.pm & 15) * 256 + wr * 64 + fr + ai * HALF + m * 16];
                const f32x4 g0 = acc[ai][0][m][0] * rs, g1 = acc[ai][0][m][1] * rs, u0 = acc[ai][1][m][0] * rs, u1 = acc[ai][1][m][1] * rs;
                u32x4 w; w.x = cvt_pk_bf16(fsilu(g0[0]) * u0[0], fsilu(g0[1]) * u0[1]); w.y = cvt_pk_bf16(fsilu(g0[2]) * u0[2], fsilu(g0[3]) * u0[3]);
                w.z = cvt_pk_bf16(fsilu(g1[0]) * u1[0], fsilu(g1[1]) * u1[1]); w.w = cvt_pk_bf16(fsilu(g1[2]) * u1[2], fsilu(g1[3]) * u1[3]);
                *(u32x4*)rowp = w; }
    }
};
struct EpiResid {
    static constexpr bool PERM = false, AFTER_DRAIN = false;
    const float* base; float* out; int ldc; float s;
    __device__ __forceinline__ void operator()(const f32x4 (&acc)[2][2][4][2], const Unit& u, int wr, int wc, int fr, int fq) const {
        const int row0 = u.pm * BM + wr * 64 + fr, col0 = u.pn * BM + wc * 32 + 4 * fq;
#pragma unroll
        for (int ai = 0; ai < 2; ++ai)
#pragma unroll
            for (int m = 0; m < 4; ++m) { const size_t off = (size_t)(row0 + ai * HALF + m * 16) * ldc + col0;
#pragma unroll
                for (int bj = 0; bj < 2; ++bj)
#pragma unroll
                    for (int n = 0; n < 2; ++n) { const f32x4 b = *(const f32x4*)(base + off + bj * HALF + n * 16);
                        *(f32x4*)(out + off + bj * HALF + n * 16) = b + acc[ai][bj][m][n] * s; } }
    }
};
struct EpiResidH {
    static constexpr bool PERM = false, AFTER_DRAIN = false;
    const float* basef; bf16_t* H; int ldc; float s; float* ssq;
    __device__ __forceinline__ void operator()(const f32x4 (&acc)[2][2][4][2], const Unit& u, int wr, int wc, int fr, int fq) const {
        const int row0 = u.pm * BM + wr * 64 + fr, col0 = u.pn * BM + wc * 32 + 4 * fq;
#pragma unroll
        for (int ai = 0; ai < 2; ++ai)
#pragma unroll
            for (int m = 0; m < 4; ++m) { const int row = row0 + ai * HALF + m * 16; const size_t off = (size_t)row * ldc + col0; float ss = 0.f;
#pragma unroll
                for (int bj = 0; bj < 2; ++bj)
#pragma unroll
                    for (int n = 0; n < 2; ++n) { const int co = bj * HALF + n * 16; f32x4 b;
                        if (basef) b = *(const f32x4*)(basef + off + co);
                        else { const u32x2 hb = *(const u32x2*)(H + off + co); b[0] = __uint_as_float(hb.x << 16); b[1] = __uint_as_float(hb.x & 0xffff0000u); b[2] = __uint_as_float(hb.y << 16); b[3] = __uint_as_float(hb.y & 0xffff0000u); }
                        const f32x4 o = b + acc[ai][bj][m][n] * s;
                        ss += (o[0] * o[0] + o[1] * o[1]) + (o[2] * o[2] + o[3] * o[3]);
                        u32x2 q; q.x = cvt_pk_bf16(o[0], o[1]); q.y = cvt_pk_bf16(o[2], o[3]);
                        *(u32x2*)(H + off + co) = q; }
                ss += __shfl_xor(ss, 16); ss += __shfl_xor(ss, 32);
                if (fq == 0) ssq[(size_t)row * 32 + u.pn * 4 + wc] = ss; }
    }
};
struct EpiResidOut {
    static constexpr bool PERM = false, AFTER_DRAIN = false;
    const bf16_t* H; float* out; int ldc; float s;
    __device__ __forceinline__ void operator()(const f32x4 (&acc)[2][2][4][2], const Unit& u, int wr, int wc, int fr, int fq) const {
        const int row0 = u.pm * BM + wr * 64 + fr, col0 = u.pn * BM + wc * 32 + 4 * fq;
#pragma unroll
        for (int ai = 0; ai < 2; ++ai)
#pragma unroll
            for (int m = 0; m < 4; ++m) { const size_t off = (size_t)(row0 + ai * HALF + m * 16) * ldc + col0;
#pragma unroll
                for (int bj = 0; bj < 2; ++bj)
#pragma unroll
                    for (int n = 0; n < 2; ++n) { const int co = bj * HALF + n * 16; const u32x2 hb = *(const u32x2*)(H + off + co);
                        f32x4 b; b[0] = __uint_as_float(hb.x << 16); b[1] = __uint_as_float(hb.x & 0xffff0000u); b[2] = __uint_as_float(hb.y << 16); b[3] = __uint_as_float(hb.y & 0xffff0000u);
                        *(f32x4*)(out + off + co) = b + acc[ai][bj][m][n] * s; } }
    }
};
struct EpiGlu {
    static constexpr bool PERM = true, AFTER_DRAIN = false;
    const bf16_t* G; int ldg; bf16_t* O; int ldo, ocol; const float* bias;
    __device__ __forceinline__ void operator()(const f32x4 (&acc)[2][2][4][2], const Unit& u, int wr, int wc, int fr, int fq) const {
        const int row0 = u.pm * BM + wr * 64 + fr, col0 = u.pn * BM + wc * 32 + 8 * fq;
#pragma unroll
        for (int ai = 0; ai < 2; ++ai)
#pragma unroll
            for (int m = 0; m < 4; ++m) { const int row = row0 + ai * HALF + m * 16;
#pragma unroll
                for (int bj = 0; bj < 2; ++bj) { const int c = col0 + bj * HALF;
                    const f32x4 b0 = *(const f32x4*)(bias + c), b1 = *(const f32x4*)(bias + c + 4);
                    const u32x4 gv = *(const u32x4*)(G + (size_t)row * ldg + c);
                    const f32x4 v0 = acc[ai][bj][m][0] + b0, v1 = acc[ai][bj][m][1] + b1;
                    float g[8]; g[0] = __uint_as_float(gv.x << 16); g[1] = __uint_as_float(gv.x & 0xffff0000u); g[2] = __uint_as_float(gv.y << 16); g[3] = __uint_as_float(gv.y & 0xffff0000u);
                    g[4] = __uint_as_float(gv.z << 16); g[5] = __uint_as_float(gv.z & 0xffff0000u); g[6] = __uint_as_float(gv.w << 16); g[7] = __uint_as_float(gv.w & 0xffff0000u);
                    u32x4 w; w.x = cvt_pk_bf16(g[0] * fsigmoid(v0[0]), g[1] * fsigmoid(v0[1])); w.y = cvt_pk_bf16(g[2] * fsigmoid(v0[2]), g[3] * fsigmoid(v0[3]));
                    w.z = cvt_pk_bf16(g[4] * fsigmoid(v1[0]), g[5] * fsigmoid(v1[1])); w.w = cvt_pk_bf16(g[6] * fsigmoid(v1[2]), g[7] * fsigmoid(v1[3]));
                    *(u32x4*)(O + (size_t)row * ldo + ocol + c) = w; } }
    }
};

template <int NM, int NN> struct FixedOrder {
    int G, c;
    __device__ __forceinline__ bool next(int i, Unit& u) const {
        constexpr int nwg = NM * NN, q = nwg / 8, r = nwg % 8, nig = 8 * NN;
        const int L = i * G + c; if (L >= nwg) return false;
        const int xcd = L & 7, off = L >> 3;
        const int wgid = (xcd < r ? xcd * (q + 1) : r * (q + 1) + (xcd - r) * q) + off;
        const int gid = wgid / nig, rem = wgid % nig;
        u.pm = gid * 8 + (rem & 7); u.pn = rem >> 3; return true;
    }
    __device__ __forceinline__ void a_ready(const Unit&) const {}
    __device__ __forceinline__ void done(const Unit&) const {}
};

template <class Epi, class Sched, bool ALIGN_EPI = false, bool SP2 = false>
__device__ __forceinline__ void gemm_phase(PG8_LAS unsigned char* lds, const Gemm g, const Sched& S, const Epi& E) {
    int tid_ = threadIdx.x; asm volatile("" : "+v"(tid_));
    const int tid = tid_, wid = __builtin_amdgcn_readfirstlane(tid >> 6), lane = tid & 63, wr = wid >> 2, wc = wid & 3, fr = lane & 15, fq = lane >> 4;
    const int K = g.K, nt = K / BK;
    unsigned voffA[2], voffB[2];
#pragma unroll
    for (int i = 0; i < 2; ++i) { int R, C; stage_rc(tid * 16 + i * 8192, R, C); const int Rb = Epi::PERM ? ((R & ~31) + perm32(R & 31)) : R;
        voffA[i] = (unsigned)(R * K + C) * 2u; voffB[i] = (unsigned)(Rb * K + C) * 2u; }
    const size_t kstep = (size_t)(BK * 2);
    const size_t hstep = (size_t)HALF * K * 2;
    const size_t tstep = 2 * hstep;
    const unsigned ldsw = (unsigned)wid * 1024u;
    const int aoff = lds_byte(wr * 64 + fr, fq * 8), boff = lds_byte(wc * 32 + fr, fq * 8);
#define PG8_SA(b, h) (((b) * 2 + (h)) * HTB)
#define PG8_SB(b, h) ((4 + (b) * 2 + (h)) * HTB)
#define PG8_STAGE(bufoff, gbase, voff) do { _Pragma("unroll") for (int _i = 0; _i < 2; ++_i) \
        __builtin_amdgcn_global_load_lds((const unsigned*)((const char*)(gbase) + (voff)[_i]), (PG8_LAS unsigned*)(lds + (bufoff) + ldsw + _i * 8192), 16, 0, 0); } while (0)
#define PG8_LDA(dst, b, h) do { _Pragma("unroll") for (int m = 0; m < 4; ++m) _Pragma("unroll") for (int k = 0; k < 2; ++k) dst[m][k] = *(const PG8_LAS bf16x8*)(lds + PG8_SA(b, h) + aoff + m * 2048 + k * 1024); } while (0)
#define PG8_LDB(dst, b, h) do { _Pragma("unroll") for (int n = 0; n < 2; ++n) _Pragma("unroll") for (int k = 0; k < 2; ++k) dst[n][k] = *(const PG8_LAS bf16x8*)(lds + PG8_SB(b, h) + boff + n * 2048 + k * 1024); } while (0)
#define PG8_MMA(ai, bj, At, Bt) do { __builtin_amdgcn_s_setprio(1); _Pragma("unroll") for (int m = 0; m < 4; ++m) _Pragma("unroll") for (int n = 0; n < 2; ++n) _Pragma("unroll") for (int k = 0; k < 2; ++k) \
        acc[ai][bj][m][n] = __builtin_amdgcn_mfma_f32_16x16x32_bf16(Bt[n][k], At[m][k], acc[ai][bj][m][n], 0, 0, 0); __builtin_amdgcn_s_setprio(0); } while (0)
#define PG8_WAIT_V(n) asm volatile("s_waitcnt vmcnt(" #n ")" ::: "memory")
#define PG8_WAIT_L(n) asm volatile("s_waitcnt lgkmcnt(" #n ")" ::: "memory")
#define PG8_BAR __builtin_amdgcn_s_barrier()
#define PG8_SCHED __builtin_amdgcn_sched_barrier(0)
    Unit cur, nxt; int ui = 0;
    if (!S.next(0, cur)) return;
    f32x4 acc[2][2][4][2];
#pragma unroll
    for (int a = 0; a < 2; ++a)
#pragma unroll
        for (int b = 0; b < 2; ++b)
#pragma unroll
            for (int m = 0; m < 4; ++m)
#pragma unroll
                for (int n = 0; n < 2; ++n) acc[a][b][m][n] = (f32x4){0.f, 0.f, 0.f, 0.f};
    bf16x8 At[4][2], B0[2][2], B1[2][2];
    const char* cA = (const char*)g.A + (size_t)cur.pm * tstep; const char* cB = (const char*)g.Bt + (size_t)cur.pn * tstep;
    S.a_ready(cur);
    if constexpr (SP2) {
        PG8_STAGE(PG8_SB(0, 0), cB, voffB); PG8_STAGE(PG8_SB(0, 1), cB + hstep, voffB); PG8_STAGE(PG8_SA(0, 0), cA, voffA); PG8_STAGE(PG8_SA(0, 1), cA + hstep, voffA);
        if (wr == 1) PG8_BAR;
        PG8_WAIT_V(2); PG8_BAR;
        PG8_STAGE(PG8_SB(1, 0), cB + kstep, voffB); PG8_STAGE(PG8_SA(1, 0), cA + kstep, voffA); PG8_STAGE(PG8_SB(1, 1), cB + hstep + kstep, voffB);
        PG8_WAIT_V(6); PG8_BAR;
    } else {
        PG8_STAGE(PG8_SB(0, 0), cB, voffB); PG8_STAGE(PG8_SA(0, 0), cA, voffA); PG8_STAGE(PG8_SB(0, 1), cB + hstep, voffB); PG8_STAGE(PG8_SA(0, 1), cA + hstep, voffA);
        if (wr == 1) PG8_BAR;
        PG8_WAIT_V(4); PG8_BAR;
        PG8_STAGE(PG8_SB(1, 0), cB + kstep, voffB); PG8_STAGE(PG8_SA(1, 0), cA + kstep, voffA); PG8_STAGE(PG8_SB(1, 1), cB + hstep + kstep, voffB);
        PG8_WAIT_V(6); PG8_BAR;
    }
    for (;;) {
        const bool has_next = S.next(ui + 1, nxt);
        const char* nA = has_next ? (const char*)g.A + (size_t)nxt.pm * tstep : cA; const char* nB = has_next ? (const char*)g.Bt + (size_t)nxt.pn * tstep : cB;
        for (int t = 0; t < nt; t += 2) {
            const bool last = (t == nt - 2);
            const char* a1 = cA + (size_t)(t + 1) * kstep;
            const char* a2 = last ? nA : cA + (size_t)(t + 2) * kstep; const char* b2 = last ? nB : cB + (size_t)(t + 2) * kstep;
            const char* a3 = a2 + kstep; const char* b3 = b2 + kstep;
            if (last && has_next) S.a_ready(nxt);
            if constexpr (SP2) {
            PG8_LDB(B0, 0, 0); PG8_LDB(B1, 0, 1); PG8_SCHED; PG8_LDA(At, 0, 0); PG8_STAGE(PG8_SA(1, 1), a1 + hstep, voffA);
            PG8_WAIT_V(8); PG8_WAIT_L(0); PG8_BAR; PG8_MMA(0, 0, At, B0); PG8_MMA(0, 1, At, B1); PG8_BAR; PG8_SCHED;
            PG8_LDA(At, 0, 1); PG8_STAGE(PG8_SB(0, 0), b2, voffB); PG8_STAGE(PG8_SB(0, 1), b2 + hstep, voffB); PG8_STAGE(PG8_SA(0, 0), a2, voffA);
            PG8_WAIT_V(8); PG8_WAIT_L(0); PG8_BAR; PG8_MMA(1, 0, At, B0); PG8_MMA(1, 1, At, B1); PG8_BAR; PG8_SCHED;
            PG8_LDB(B0, 1, 0); PG8_LDB(B1, 1, 1); PG8_SCHED; PG8_LDA(At, 1, 0); PG8_STAGE(PG8_SA(0, 1), a2 + hstep, voffA);
            PG8_WAIT_V(8); PG8_WAIT_L(0); PG8_BAR; PG8_MMA(0, 0, At, B0); PG8_MMA(0, 1, At, B1); PG8_BAR; PG8_SCHED;
            PG8_LDA(At, 1, 1); PG8_STAGE(PG8_SB(1, 0), b3, voffB); PG8_STAGE(PG8_SB(1, 1), b3 + hstep, voffB); PG8_STAGE(PG8_SA(1, 0), a3, voffA);
            PG8_WAIT_V(8); PG8_WAIT_L(0); PG8_BAR; PG8_MMA(1, 0, At, B0); PG8_MMA(1, 1, At, B1); PG8_BAR; PG8_SCHED;
            } else {
            PG8_LDB(B0, 0, 0); PG8_SCHED; PG8_LDA(At, 0, 0); PG8_STAGE(PG8_SA(1, 1), a1 + hstep, voffA);
            PG8_WAIT_L(8); PG8_BAR; PG8_WAIT_L(0); PG8_MMA(0, 0, At, B0); PG8_BAR; PG8_SCHED;
            PG8_LDB(B1, 0, 1); PG8_STAGE(PG8_SB(0, 0), b2, voffB);
            PG8_BAR; PG8_WAIT_L(0); PG8_MMA(0, 1, At, B1); PG8_BAR;
            PG8_LDA(At, 0, 1); PG8_STAGE(PG8_SA(0, 0), a2, voffA);
            PG8_BAR; PG8_WAIT_L(0); PG8_MMA(1, 0, At, B0); PG8_BAR; PG8_SCHED;
            PG8_STAGE(PG8_SB(0, 1), b2 + hstep, voffB);
            PG8_WAIT_V(6); PG8_BAR; PG8_MMA(1, 1, At, B1); PG8_BAR;
            PG8_LDB(B0, 1, 0); PG8_SCHED; PG8_LDA(At, 1, 0); PG8_STAGE(PG8_SA(0, 1), a2 + hstep, voffA);
            PG8_WAIT_L(8); PG8_BAR; PG8_WAIT_L(0); PG8_MMA(0, 0, At, B0); PG8_BAR; PG8_SCHED;
            PG8_LDB(B1, 1, 1); PG8_STAGE(PG8_SB(1, 0), b3, voffB);
            PG8_BAR; PG8_WAIT_L(0); PG8_MMA(0, 1, At, B1); PG8_BAR;
            PG8_LDA(At, 1, 1); PG8_STAGE(PG8_SA(1, 0), a3, voffA);
            PG8_BAR; PG8_WAIT_L(0); PG8_MMA(1, 0, At, B0); PG8_BAR; PG8_SCHED;
            PG8_STAGE(PG8_SB(1, 1), b3 + hstep, voffB);
            PG8_WAIT_V(6); PG8_BAR; PG8_MMA(1, 1, At, B1); PG8_BAR;
            }
        }
        if constexpr (ALIGN_EPI) { if (wr == 0) PG8_BAR; }
        if constexpr (!Epi::AFTER_DRAIN) { E(acc, cur, wr, wc, fr, fq); S.done(cur); }
        if (!has_next) break;
#pragma unroll
        for (int a = 0; a < 2; ++a)
#pragma unroll
            for (int b = 0; b < 2; ++b)
#pragma unroll
                for (int m = 0; m < 4; ++m)
#pragma unroll
                    for (int n = 0; n < 2; ++n) acc[a][b][m][n] = (f32x4){0.f, 0.f, 0.f, 0.f};
        cur = nxt; cA = nA; cB = nB; ++ui;
        if constexpr (ALIGN_EPI) { if (wr == 1) PG8_BAR; }
    }
    PG8_WAIT_V(0);
    if constexpr (!ALIGN_EPI) { if (wr == 0) PG8_BAR; }
    PG8_BAR;
    if constexpr (Epi::AFTER_DRAIN) { E.fused(acc, cur, wr, wc, fr, fq, lds, wid, lane); S.done(cur); }
#undef PG8_SA
#undef PG8_SB
#undef PG8_STAGE
#undef PG8_LDA
#undef PG8_LDB
#undef PG8_MMA
#undef PG8_WAIT_V
#undef PG8_WAIT_L
#undef PG8_BAR
#undef PG8_SCHED
}
}

#define LAS __attribute__((address_space(3)))
typedef unsigned short bf16_t;
typedef short bf16x8 __attribute__((ext_vector_type(8)));
typedef float f32x4 __attribute__((ext_vector_type(4)));
typedef float f32x2 __attribute__((ext_vector_type(2)));
typedef unsigned u32x4 __attribute__((ext_vector_type(4)));
typedef unsigned u32x2 __attribute__((ext_vector_type(2)));

constexpr int M = 16384, D = 2048, FF = 5632, SEQ = 2048, NBATCH = 8, NCH = 32, CH = 64;
constexpr int PIN = 5656, PINP = 5888;
constexpr int PQ = 0, PK = 768, PV = 1536, PZ = 2304;
constexpr int PSZ = 3072, PSX = 3840, PSB = 4608, PSC = 4864;
constexpr int PU = 5120;
constexpr int PGB = 5632, PGA = 5638, PSDT = 5648;
constexpr float EPS = 1e-6f;
constexpr size_t MiB = 1u << 20;
constexpr size_t WS_CTL = 0, WS_GL = 64 * 1024, WS_CD = 128 * 1024;
constexpr size_t WS_WGU1 = 1 * MiB, WS_WD1 = 45 * MiB, WS_WIN = 67 * MiB, WS_WGLU = 90 * MiB, WS_WOUT = 91 * MiB, WS_WGU2 = 99 * MiB, WS_WD2 = 143 * MiB;
constexpr size_t WS_XN = 166 * MiB;
constexpr size_t WS_AP = 230 * MiB;
constexpr size_t WS_MIX = 414 * MiB;
constexpr size_t WS_GT = 478 * MiB;
constexpr size_t WS_GO = 586 * MiB;
constexpr size_t WS_ST = 610 * MiB;
constexpr size_t WS_G5 = 658 * MiB;
constexpr size_t WS_E5 = 674 * MiB;
constexpr size_t WS_SSQ = 678 * MiB;
constexpr size_t WS_H = 690 * MiB;
constexpr size_t WS_END = 754 * MiB;
constexpr int GT_UNIT = 73728, GT_U = 0, GT_W = 16384, GT_QD = 32768, GT_KDT = 49152, GT_ATT = 65536;
constexpr int LDS_BYTES = 155648;

__device__ __forceinline__ float bf2f(unsigned v) { return __uint_as_float(v << 16); }
__device__ __forceinline__ unsigned f2bf(float f) { unsigned u = __float_as_uint(f); return (u + 0x7fffu + ((u >> 16) & 1u)) >> 16; }
__device__ __forceinline__ unsigned pk2(float lo, float hi) { return pg8::cvt_pk_bf16(lo, hi); }
__device__ __forceinline__ float fsilu(float x) { return x / (1.f + __expf(-x)); }
__device__ __forceinline__ float fsigmoid(float x) { return 1.f / (1.f + __expf(-x)); }
__device__ __forceinline__ float fsoftplus(float x) { return x > 20.f ? x : log1pf(expf(x)); }
__device__ __forceinline__ void unpack8(const u32x4 v, float* f) {
    f[0] = __uint_as_float(v.x << 16); f[1] = __uint_as_float(v.x & 0xffff0000u); f[2] = __uint_as_float(v.y << 16); f[3] = __uint_as_float(v.y & 0xffff0000u);
    f[4] = __uint_as_float(v.z << 16); f[5] = __uint_as_float(v.z & 0xffff0000u); f[6] = __uint_as_float(v.w << 16); f[7] = __uint_as_float(v.w & 0xffff0000u); }
__device__ __forceinline__ float wave_sum(float v) {
#pragma unroll
    for (int o = 1; o < 64; o <<= 1) v += __shfl_xor(v, o);
    return v;
}
__device__ __forceinline__ float wave_incl_scan(float v, int lane) {
#pragma unroll
    for (int o = 1; o < 64; o <<= 1) { const float t = __shfl_up(v, o); if (lane >= o) v += t; }
    return v;
}
__device__ __forceinline__ f32x4 mm16(const LAS bf16_t* X, int ldx, const LAS bf16_t* Y, int ldy, int K, f32x4 acc, int fr, int fq) {
    const LAS bf16_t* xp = X + fr * ldx + fq * 8; const LAS bf16_t* yp = Y + fr * ldy + fq * 8;
#if defined(MM16_NAIVE)
    for (int k = 0; k < K; ++k) { const float xv = bf2f(X[fr * ldx + k]);
#pragma unroll
        for (int j = 0; j < 4; ++j) acc[j] += xv * bf2f(Y[(4 * fq + j) * ldy + k]); }
    (void)xp; (void)yp;
#else
    for (int k = 0; k < K; k += 32) { const bf16x8 x = *(const LAS bf16x8*)(xp + k); const bf16x8 y = *(const LAS bf16x8*)(yp + k);
        acc = __builtin_amdgcn_mfma_f32_16x16x32_bf16(y, x, acc, 0, 0, 0);
        asm volatile("" :: "v"(x), "v"(y)); }
#endif
    return acc;
}
#define WG_SYNC() do { asm volatile("s_waitcnt lgkmcnt(0)" ::: "memory"); __builtin_amdgcn_s_barrier(); asm volatile("" ::: "memory"); } while (0)

struct KP { const float* in[33]; float* out; unsigned char* ws; int ph_lo, ph_hi; };
#define AS4 __attribute__((address_space(4)))
struct KPV {
    const AS4 KP* k;
    __device__ __forceinline__ const float* in(int i) const { return k->in[i]; }
    __device__ __forceinline__ unsigned char* ws() const { return k->ws; }
    __device__ __forceinline__ float* out() const { return k->out; }
};

__device__ __forceinline__ int map_row(int mode, int n) {
    if (mode == 0) return n;
    if (mode == 1) return ((n >> 7) << 8) + (n & 127);
    if (mode == 2) return ((n >> 7) << 8) + 128 + (n & 127);
    if (n < 3072) return n;
    if (n < 3084) return PGB + (n - 3072);
    if (n < 5132) return 3072 + (n - 3084);
    if (n < 5144) return PSDT + (n - 5132);
    return PU + (n - 5144);
}
__device__ __forceinline__ void transpose_item(const float* W, int K, int N, bf16_t* WT, int mode, LAS float* scr, int item, int lane, const float* nw = nullptr) {
    const int nblk = (N + 31) / 32, kb = item / nblk, nb = item % nblk, k0 = 64 * kb, n0 = 32 * nb;
    const int nn = n0 + (lane & 31); const bool ok = nn < N;
    float wv[32];
#pragma unroll
    for (int i = 0; i < 32; ++i) { const int kk = 2 * i + (lane >> 5); wv[i] = ok ? __builtin_nontemporal_load(W + (size_t)(k0 + kk) * N + nn) : 0.f; }
#pragma unroll
    for (int i = 0; i < 32; ++i) { const int kk = 2 * i + (lane >> 5); scr[kk * 33 + (lane & 31)] = nw ? wv[i] * nw[k0 + kk] : wv[i]; }
    asm volatile("s_waitcnt lgkmcnt(0)" ::: "memory"); __builtin_amdgcn_wave_barrier();
    const int c = lane & 7;
#pragma unroll
    for (int j = 0; j < 4; ++j) { const int n = (lane >> 3) + 8 * j; const LAS float* s = scr + (8 * c) * 33 + n;
        u32x4 o; o.x = pk2(s[0 * 33], s[1 * 33]); o.y = pk2(s[2 * 33], s[3 * 33]); o.z = pk2(s[4 * 33], s[5 * 33]); o.w = pk2(s[6 * 33], s[7 * 33]);
        if (n0 + n < N) *(u32x4*)(WT + (size_t)map_row(mode, n0 + n) * K + k0 + 8 * c) = o; }
    asm volatile("s_waitcnt lgkmcnt(0)" ::: "memory"); __builtin_amdgcn_wave_barrier();
}
__device__ __forceinline__ void convert_phase(const KPV& p, int layer, LAS unsigned char* lds, int gw, int NGW, int wave, int lane) {
    LAS float* scr = (LAS float*)(lds + wave * 16384);
    unsigned char* ws = p.ws();
    constexpr int I_GU = (D / 64) * (FF / 32), I_DN = (FF / 64) * (D / 32), I_IN = (D / 64) * ((PIN + 31) / 32), I_GLU = (512 / 64) * (512 / 32), I_OUT = (D / 64) * (D / 32);
    constexpr int NITEMS = 4 * I_GU + 2 * I_DN + I_IN + I_GLU + I_OUT;
    for (int it = gw; it < NITEMS; it += NGW) {
        int r = it;
        if (r < I_GU) { transpose_item(p.in(2) + (size_t)layer * D * FF, D, FF, (bf16_t*)(ws + WS_WGU1), 1, scr, r, lane, p.in(1) + layer * D); continue; } r -= I_GU;
        if (r < I_GU) { transpose_item(p.in(3) + (size_t)layer * D * FF, D, FF, (bf16_t*)(ws + WS_WGU1), 2, scr, r, lane, p.in(1) + layer * D); continue; } r -= I_GU;
        if (r < I_DN) { transpose_item(p.in(4) + (size_t)layer * D * FF, FF, D, (bf16_t*)(ws + WS_WD1), 0, scr, r, lane); continue; } r -= I_DN;
        if (r < I_IN) { transpose_item(p.in(6) + (size_t)layer * D * PIN, D, PIN, (bf16_t*)(ws + WS_WIN), 3, scr, r, lane, p.in(5) + layer * D); continue; } r -= I_IN;
        if (r < I_GLU) { transpose_item(p.in(25) + (size_t)layer * 512 * 512, 512, 512, (bf16_t*)(ws + WS_WGLU), 0, scr, r, lane); continue; } r -= I_GLU;
        if (r < I_OUT) { transpose_item(p.in(27) + (size_t)layer * D * D, D, D, (bf16_t*)(ws + WS_WOUT), 0, scr, r, lane); continue; } r -= I_OUT;
        if (r < I_GU) { transpose_item(p.in(29) + (size_t)layer * D * FF, D, FF, (bf16_t*)(ws + WS_WGU2), 1, scr, r, lane, p.in(28) + layer * D); continue; } r -= I_GU;
        if (r < I_GU) { transpose_item(p.in(30) + (size_t)layer * D * FF, D, FF, (bf16_t*)(ws + WS_WGU2), 2, scr, r, lane, p.in(28) + layer * D); continue; } r -= I_GU;
        transpose_item(p.in(31) + (size_t)layer * D * FF, FF, D, (bf16_t*)(ws + WS_WD2), 0, scr, r, lane);
    }
}
__device__ __forceinline__ void norm_raw_phase(const float* h, const float* w, bf16_t* xn, float* ssq, int gw, int NGW, int lane) {
    for (int row = gw; row < M; row += NGW) {
        const f32x4* xr = (const f32x4*)(h + (size_t)row * D) + lane; float s = 0.f;
#pragma unroll
        for (int j = 0; j < 8; ++j) { const f32x4 v = xr[64 * j]; s += (v.x * v.x + v.y * v.y) + (v.z * v.z + v.w * v.w);
            u32x2 q; q.x = pk2(v.x, v.y); q.y = pk2(v.z, v.w);
            *((u32x2*)(xn + (size_t)row * D) + lane + 64 * j) = q; }
        s = wave_sum(s); if (lane < 32) ssq[(size_t)row * 32 + lane] = (lane == 0) ? s : 0.f;
    }
}
template <bool FINAL>
__device__ __forceinline__ void norm_phase(const float* h, const float* w, bf16_t* xn, float* fout, int gw, int NGW, int lane) {
    for (int row = gw; row < M; row += NGW) {
        const f32x4* xr = (const f32x4*)(h + (size_t)row * D) + lane;
        f32x4 v[8]; float s = 0.f;
#pragma unroll
        for (int j = 0; j < 8; ++j) { v[j] = xr[64 * j]; s += (v[j].x * v[j].x + v[j].y * v[j].y) + (v[j].z * v[j].z + v[j].w * v[j].w); }
        const float rstd = rsqrtf(wave_sum(s) * (1.f / D) + EPS);
#pragma unroll
        for (int j = 0; j < 8; ++j) { const f32x4 wv = *((const f32x4*)w + lane + 64 * j); const f32x4 o = v[j] * rstd * wv;
            if (FINAL) *((f32x4*)(fout + (size_t)row * D) + lane + 64 * j) = o;
            else { u32x2 q; q.x = pk2(o.x, o.y); q.y = pk2(o.z, o.w); *((u32x2*)(xn + (size_t)row * D) + lane + 64 * j) = q; } }
    }
}

constexpr int G_RAW = 0;
constexpr int G_LF = 0, G_TS = 17408, G_TF = 26624;
constexpr int G_QS = 51456, G_KS = 68864, G_KDT = 86272, G_VBT = 104704, G_KGT = 123136, G_GATE = 141568;
struct S5Par;
__device__ __forceinline__ void s5_shadow_unit(const KPV& p, int layer, int wu, LAS unsigned char* wl, int lane);
__device__ __forceinline__ void gdn_pre_unit(const KPV& p, int layer, int unit, LAS unsigned char* lds, int tid, int wave, int lane, int s5_wu = -1) {
    asm volatile("" : "+v"(tid)); lane = tid & 63;
    const int b = unit / (6 * NCH), h = (unit / NCH) % 6, n = unit % NCH;
    const int tok0 = b * SEQ + n * CH;
    const bf16_t* proj = (const bf16_t*)(p.ws() + WS_AP);
    unsigned char* gt = p.ws() + WS_GT + (size_t)unit * GT_UNIT;
    LAS bf16_t* raw = (LAS bf16_t*)(lds + G_RAW);
    LAS float* Gs = (LAS float*)(lds + G_GATE); LAS float* Bt = Gs + 64;
    { u32x4 rv[7];
#pragma unroll
      for (int k = 0; k < 7; ++k) { const int c = tid + 512 * k, part = c / (67 * 16), rc = c % (67 * 16), r = rc >> 4, ch = rc & 15;
          rv[k] = (u32x4){0u, 0u, 0u, 0u};
          if (c < 3 * 67 * 16 && (n > 0 || r >= 3)) rv[k] = *(const u32x4*)(proj + (size_t)(tok0 + r - 3) * PINP + part * 768 + h * 128 + ch * 8); }
#pragma unroll
      for (int k = 0; k < 7; ++k) { const int c = tid + 512 * k, part = c / (67 * 16), rc = c % (67 * 16), r = rc >> 4, ch = rc & 15;
          if (c < 3 * 67 * 16) *(LAS u32x4*)(raw + (part * 67 + r) * 128 + ch * 8) = rv[k]; } }
    if (wave == 0) { const size_t ro = (size_t)(tok0 + lane) * PINP;
        const float braw = bf2f(proj[ro + PGB + h]), araw = bf2f(proj[ro + PGA + h]);
        const float g = -expf(p.in(8)[layer * 6 + h]) * fsoftplus(araw + p.in(9)[layer * 6 + h]);
        Gs[lane] = wave_incl_scan(g, lane); Bt[lane] = 1.f / (1.f + expf(-braw)); }
    WG_SYNC();
    { const int tok = tid >> 3, sub = tid & 7, c0 = sub * 16;
      const float* cw = p.in(7) + (size_t)layer * 4 * 2304 + h * 128 + c0;
      const float G = Gs[tok], beta = Bt[tok], Glast = Gs[63];
      const float eG = expf(G), eGl = expf(Glast - G);
      LAS bf16_t* Qs = (LAS bf16_t*)(lds + G_QS); LAS bf16_t* Ks = (LAS bf16_t*)(lds + G_KS);
      LAS bf16_t* KdT = (LAS bf16_t*)(lds + G_KDT); LAS bf16_t* VbT = (LAS bf16_t*)(lds + G_VBT); LAS bf16_t* KgT = (LAS bf16_t*)(lds + G_KGT);
#pragma unroll 1
      for (int part = 0; part < 3; ++part) {
          float acc[16];
#pragma unroll
          for (int i = 0; i < 16; ++i) acc[i] = 0.f;
#pragma unroll
          for (int tap = 0; tap < 4; ++tap) {
              const LAS bf16_t* rp = raw + (part * 67 + tok + tap) * 128 + c0;
              float x[16]; unpack8(*(const LAS u32x4*)rp, x); unpack8(*(const LAS u32x4*)(rp + 8), x + 8);
              const float* wp = cw + tap * 2304 + part * 768;
#pragma unroll
              for (int i4 = 0; i4 < 4; ++i4) { const f32x4 wv = *(const f32x4*)(wp + 4 * i4);
                  acc[4 * i4 + 0] += wv.x * x[4 * i4 + 0]; acc[4 * i4 + 1] += wv.y * x[4 * i4 + 1]; acc[4 * i4 + 2] += wv.z * x[4 * i4 + 2]; acc[4 * i4 + 3] += wv.w * x[4 * i4 + 3]; }
          }
          float ss = 0.f;
#pragma unroll
          for (int i = 0; i < 16; ++i) { acc[i] = fsilu(acc[i]); ss += acc[i] * acc[i]; }
          ss += __shfl_xor(ss, 1); ss += __shfl_xor(ss, 2); ss += __shfl_xor(ss, 4);
          const float r = (part == 2) ? 1.f : rsqrtf(ss + EPS) * (part == 0 ? 0.08838834764831845f : 1.f);
#pragma unroll
          for (int i = 0; i < 16; ++i) acc[i] *= r;
          u32x4 a, c;
          a.x = pk2(acc[0], acc[1]); a.y = pk2(acc[2], acc[3]); a.z = pk2(acc[4], acc[5]); a.w = pk2(acc[6], acc[7]);
          c.x = pk2(acc[8], acc[9]); c.y = pk2(acc[10], acc[11]); c.z = pk2(acc[12], acc[13]); c.w = pk2(acc[14], acc[15]);
          if (part == 0) {
              *(LAS u32x4*)(Qs + tok * 136 + c0) = a; *(LAS u32x4*)(Qs + tok * 136 + c0 + 8) = c;
              a.x = pk2(acc[0] * eG, acc[1] * eG); a.y = pk2(acc[2] * eG, acc[3] * eG); a.z = pk2(acc[4] * eG, acc[5] * eG); a.w = pk2(acc[6] * eG, acc[7] * eG);
              c.x = pk2(acc[8] * eG, acc[9] * eG); c.y = pk2(acc[10] * eG, acc[11] * eG); c.z = pk2(acc[12] * eG, acc[13] * eG); c.w = pk2(acc[14] * eG, acc[15] * eG);
              bf16_t* qd = (bf16_t*)(gt + GT_QD) + tok * 128 + c0; *(u32x4*)qd = a; *(u32x4*)(qd + 8) = c;
          } else if (part == 1) {
              *(LAS u32x4*)(Ks + tok * 136 + c0) = a; *(LAS u32x4*)(Ks + tok * 136 + c0 + 8) = c;
              const float kbg = beta * eG;
#pragma unroll
              for (int i = 0; i < 16; ++i) { KdT[(c0 + i) * 72 + tok] = (bf16_t)f2bf(acc[i] * eGl); KgT[(c0 + i) * 72 + tok] = (bf16_t)f2bf(acc[i] * kbg); }
          } else {
#pragma unroll
              for (int i = 0; i < 16; ++i) VbT[(c0 + i) * 72 + tok] = (bf16_t)f2bf(acc[i] * beta);
          }
      }
    }
    WG_SYNC();
    { LAS float* Lf = (LAS float*)(lds + G_LF);
      const LAS bf16_t* Qs = (const LAS bf16_t*)(lds + G_QS); const LAS bf16_t* Ks = (const LAS bf16_t*)(lds + G_KS);
      const int fr = lane & 15, fq = lane >> 4;
      for (int job = wave * 4; job < wave * 4 + 4; ++job) { const int mat = job >> 4, ti = (job >> 2) & 3, tj = job & 3;
          f32x4 acc = (f32x4){0.f, 0.f, 0.f, 0.f};
          acc = mm16((mat == 0 ? Ks : Qs) + ti * 16 * 136, 136, Ks + tj * 16 * 136, 136, 128, acc, fr, fq);
          const int i = ti * 16 + fr, j0 = tj * 16 + 4 * fq; const float Gi = Gs[i], bi = Bt[i];
          float o[4];
#pragma unroll
          for (int jj = 0; jj < 4; ++jj) { const int j = j0 + jj; const float dec = (i >= j) ? expf(Gi - Gs[j]) : 0.f;
              o[jj] = (mat == 0) ? ((i > j) ? acc[jj] * bi * dec : 0.f) : acc[jj] * dec; }
          if (mat == 0) { Lf[(j0 + 0) * 68 + i] = o[0]; Lf[(j0 + 1) * 68 + i] = o[1]; Lf[(j0 + 2) * 68 + i] = o[2]; Lf[(j0 + 3) * 68 + i] = o[3]; }
          else { u32x2 w; w.x = pk2(o[0], o[1]); w.y = pk2(o[2], o[3]); *(u32x2*)((bf16_t*)(gt + GT_ATT) + i * 64 + j0) = w; } }
    }
    WG_SYNC();
    if (wave == 0) { const LAS float* LfT = (const LAS float*)(lds + G_LF); LAS bf16_t* Ts = (LAS bf16_t*)(lds + G_TS); LAS float* Tf = (LAS float*)(lds + G_TF);
#pragma unroll 1
        for (int I = 0; I < 4; ++I) { float s[16];
#pragma unroll
            for (int ii = 0; ii < 16; ++ii) s[ii] = (16 * I + ii == lane) ? 1.f : 0.f;
#pragma unroll 2
            for (int j = 0; j < 16 * I; ++j) { const float tj = Tf[j * 64 + lane]; const LAS f32x4* lc = (const LAS f32x4*)(LfT + j * 68 + 16 * I);
#pragma unroll
                for (int q = 0; q < 4; ++q) { const f32x4 l = lc[q]; s[4 * q + 0] -= l.x * tj; s[4 * q + 1] -= l.y * tj; s[4 * q + 2] -= l.z * tj; s[4 * q + 3] -= l.w * tj; } }
#pragma unroll
            for (int jj = 0; jj < 16; ++jj) { const float t = s[jj]; Tf[(16 * I + jj) * 64 + lane] = t; Ts[(16 * I + jj) * 72 + lane] = (bf16_t)f2bf(t);
                const LAS f32x4* lc = (const LAS f32x4*)(LfT + (16 * I + jj) * 68 + 16 * I);
#pragma unroll
                for (int q = 0; q < 4; ++q) { if (4 * q + 3 > jj) { const f32x4 l = lc[q];
                    if (4 * q + 0 > jj) s[4 * q + 0] -= l.x * t; if (4 * q + 1 > jj) s[4 * q + 1] -= l.y * t; if (4 * q + 2 > jj) s[4 * q + 2] -= l.z * t; if (4 * q + 3 > jj) s[4 * q + 3] -= l.w * t; } } }
        }
        if (lane == 0) ((float*)(p.ws() + WS_GL))[unit] = expf(Gs[63]);
    } else { const LAS bf16_t* KdT = (const LAS bf16_t*)(lds + G_KDT);
        for (int c = tid - 64; c < 128 * 8; c += 448) { const int r = c >> 3, ch = c & 7; *(u32x4*)((bf16_t*)(gt + GT_KDT) + r * 64 + ch * 8) = *(const LAS u32x4*)(KdT + r * 72 + ch * 8); }
        if (s5_wu >= 0) s5_shadow_unit(p, layer, s5_wu, lds + G_QS + (wave - 1) * 4096, lane); }
    WG_SYNC();
    asm volatile("" : "+v"(tid)); lane = tid & 63;
    { const LAS bf16_t* Ts = (const LAS bf16_t*)(lds + G_TS); const LAS bf16_t* VbT = (const LAS bf16_t*)(lds + G_VBT); const LAS bf16_t* KgT = (const LAS bf16_t*)(lds + G_KGT);
      const int fr = lane & 15, fq = lane >> 4;
      for (int job = wave * 8; job < wave * 8 + 8; ++job) { const int mat = job >> 5, ti = (job >> 3) & 3, te = job & 7;
          f32x4 acc = (f32x4){0.f, 0.f, 0.f, 0.f};
          acc = mm16(Ts + ti * 16 * 72, 72, (mat == 0 ? VbT : KgT) + te * 16 * 72, 72, 64, acc, fr, fq);
          u32x2 w; w.x = pk2(acc[0], acc[1]); w.y = pk2(acc[2], acc[3]);
          *(u32x2*)((bf16_t*)(gt + (mat == 0 ? GT_U : GT_W)) + (ti * 16 + fr) * 128 + te * 16 + 4 * fq) = w; }
    }
    WG_SYNC();
}

constexpr int GS_BUF = 66560;
constexpr int GS_WB = 0, GS_QB = 17408, GS_KT = 34816, GS_AT = 53248, GS_UB = 62464;
constexpr int GS_ST = 2 * GS_BUF, GS_VNT = GS_ST + 8704;
__device__ __forceinline__ void gs_load(const unsigned char* gt, int es, int tid, u32x4 (&v)[8]) {
#pragma unroll
    for (int k = 0; k < 8; ++k) { const int c = tid + 512 * k; const bf16_t* src;
        if (k < 2) src = (const bf16_t*)(gt + GT_W) + (c >> 4) * 128 + (c & 15) * 8;
        else if (k < 4) { const int c2 = c - 1024; src = (const bf16_t*)(gt + GT_QD) + (c2 >> 4) * 128 + (c2 & 15) * 8; }
        else if (k < 6) { const int c2 = c - 2048; src = (const bf16_t*)(gt + GT_KDT) + (c2 >> 3) * 64 + (c2 & 7) * 8; }
        else if (k < 7) { const int c2 = c - 3072; src = (const bf16_t*)(gt + GT_ATT) + (c2 >> 3) * 64 + (c2 & 7) * 8; }
        else { const int c2 = (c - 3584) & 255; src = (const bf16_t*)(gt + GT_U) + (c2 >> 2) * 128 + es * 32 + (c2 & 3) * 8; }
        v[k] = *(const u32x4*)src; }
}
__device__ __forceinline__ void gs_store(LAS unsigned char* buf, int tid, const u32x4 (&v)[8]) {
#pragma unroll
    for (int k = 0; k < 8; ++k) { const int c = tid + 512 * k; LAS bf16_t* dst;
        if (k < 2) dst = (LAS bf16_t*)(buf + GS_WB) + (c >> 4) * 136 + (c & 15) * 8;
        else if (k < 4) { const int c2 = c - 1024; dst = (LAS bf16_t*)(buf + GS_QB) + (c2 >> 4) * 136 + (c2 & 15) * 8; }
        else if (k < 6) { const int c2 = c - 2048; dst = (LAS bf16_t*)(buf + GS_KT) + (c2 >> 3) * 72 + (c2 & 7) * 8; }
        else if (k < 7) { const int c2 = c - 3072; dst = (LAS bf16_t*)(buf + GS_AT) + (c2 >> 3) * 72 + (c2 & 7) * 8; }
        else { const int c2 = (c - 3584) & 255; dst = (LAS bf16_t*)(buf + GS_UB) + (c2 >> 2) * 32 + (c2 & 3) * 8; }
        if (k < 7 || tid < 256) *(LAS u32x4*)dst = v[k]; }
}
__device__ __forceinline__ void gdn_scan_step(LAS unsigned char* buf, LAS bf16_t* ST, LAS bf16_t* VnT, f32x4 (&sacc)[2], float gl, bf16_t* gop, int wave, int fr, int fq) {
    const int d0 = wave * 16, ti = wave >> 1, te = wave & 1, i0 = ti * 16, e0 = te * 16;
#pragma unroll
    for (int et = 0; et < 2; ++et)
#pragma unroll
        for (int jj = 0; jj < 4; ++jj) ST[(16 * et + 4 * fq + jj) * 136 + d0 + fr] = (bf16_t)f2bf(sacc[et][jj]);
    WG_SYNC();
    f32x4 accv = (f32x4){0.f, 0.f, 0.f, 0.f}, acco = accv;
    accv = mm16((const LAS bf16_t*)(buf + GS_WB) + i0 * 136, 136, ST + e0 * 136, 136, 128, accv, fr, fq);
    acco = mm16((const LAS bf16_t*)(buf + GS_QB) + i0 * 136, 136, ST + e0 * 136, 136, 128, acco, fr, fq);
    { const u32x2 uu = *(const LAS u32x2*)((const LAS bf16_t*)(buf + GS_UB) + (i0 + fr) * 32 + e0 + 4 * fq);
      const float u0 = bf2f(uu.x & 0xffffu), u1 = __uint_as_float(uu.x & 0xffff0000u), u2 = bf2f(uu.y & 0xffffu), u3 = __uint_as_float(uu.y & 0xffff0000u);
      accv[0] = u0 - accv[0]; accv[1] = u1 - accv[1]; accv[2] = u2 - accv[2]; accv[3] = u3 - accv[3]; }
#pragma unroll
    for (int jj = 0; jj < 4; ++jj) VnT[(e0 + 4 * fq + jj) * 72 + i0 + fr] = (bf16_t)f2bf(accv[jj]);
    WG_SYNC();
    acco = mm16((const LAS bf16_t*)(buf + GS_AT) + i0 * 72, 72, VnT + e0 * 72, 72, 64, acco, fr, fq);
    { u32x2 w; w.x = pk2(acco[0], acco[1]); w.y = pk2(acco[2], acco[3]); *(u32x2*)(gop + (size_t)(i0 + fr) * 768 + e0 + 4 * fq) = w; }
#pragma unroll
    for (int et = 0; et < 2; ++et) { sacc[et] = sacc[et] * gl;
        sacc[et] = mm16((const LAS bf16_t*)(buf + GS_KT) + d0 * 72, 72, VnT + 16 * et * 72, 72, 64, sacc[et], fr, fq); }
}
__device__ __forceinline__ void gdn_scan_unit(const KPV& p, int unit, LAS unsigned char* lds, int tid, int wave, int lane) {
    const int bh = unit >> 2, es = unit & 3, b = bh / 6, h = bh % 6;
    const unsigned char* gt0 = p.ws() + WS_GT + (size_t)bh * NCH * GT_UNIT;
    const float* GL = (const float*)(p.ws() + WS_GL) + bh * NCH;
    bf16_t* GO = (bf16_t*)(p.ws() + WS_GO) + (size_t)(b * SEQ) * 768 + h * 128 + es * 32;
    const int fr = lane & 15, fq = lane >> 4;
    LAS bf16_t* ST = (LAS bf16_t*)(lds + GS_ST); LAS bf16_t* VnT = (LAS bf16_t*)(lds + GS_VNT);
    u32x4 pa[8], pb[8];
    gs_load(gt0, es, tid, pa); gs_store(lds, tid, pa);
    gs_load(gt0 + (size_t)GT_UNIT, es, tid, pa);
    LAS float* GLs = (LAS float*)(lds + GS_VNT + 4608);
    if (tid < 32) GLs[tid] = GL[tid];
    f32x4 sacc[2]; sacc[0] = (f32x4){0.f, 0.f, 0.f, 0.f}; sacc[1] = sacc[0];
#pragma unroll 1
    for (int n = 0; n < NCH; n += 2) {
        if (n + 2 < NCH) gs_load(gt0 + (size_t)(n + 2) * GT_UNIT, es, tid, pb);
        gdn_scan_step(lds, ST, VnT, sacc, GLs[n], GO + (size_t)(n * CH) * 768, wave, fr, fq);
        gs_store(lds + GS_BUF, tid, pa);
        if (n + 3 < NCH) gs_load(gt0 + (size_t)(n + 3) * GT_UNIT, es, tid, pa);
        gdn_scan_step(lds + GS_BUF, ST, VnT, sacc, GLs[n + 1], GO + (size_t)((n + 1) * CH) * 768, wave, fr, fq);
        if (n + 2 < NCH) gs_store(lds, tid, pb);
    }
    WG_SYNC();
}

constexpr int S_RAWC = 0, S_RAWB = 17152, S_RAWX = 34304;
constexpr int S_CS = 42880, S_BS = 60288, S_SP = 77696;
constexpr int S_XDT = 95104, S_XSN = 104320, S_MS = 113536;
constexpr int S_F = 122752;
template <int W16, int NI>
__device__ __forceinline__ void ssd_raw_ld(const bf16_t* proj, int tok0, int n, int col, int tid, u32x4 (&v)[NI]) {
#pragma unroll
    for (int k = 0; k < NI; ++k) { const int c = tid + 512 * k, r = c / W16, ch = c % W16; v[k] = (u32x4){0u, 0u, 0u, 0u};
        if (c < 67 * W16 && (n > 0 || r >= 3)) v[k] = *(const u32x4*)(proj + (size_t)(tok0 + r - 3) * PINP + col + ch * 8); }
}
template <int W16, int NI>
__device__ __forceinline__ void ssd_raw_st(LAS bf16_t* dst, int tid, const u32x4 (&v)[NI]) {
#pragma unroll
    for (int k = 0; k < NI; ++k) { const int c = tid + 512 * k, r = c / W16, ch = c % W16;
        if (c < 67 * W16) *(LAS u32x4*)(dst + r * (W16 * 8) + ch * 8) = v[k]; }
}
__device__ __forceinline__ void ssd_conv8(const LAS bf16_t* raw, int rs, int tok, int ch0, const float* cw, const float* cb, int cidx, float* out) {
    const f32x4 b0 = *(const f32x4*)(cb + cidx), b1 = *(const f32x4*)(cb + cidx + 4);
    out[0] = b0.x; out[1] = b0.y; out[2] = b0.z; out[3] = b0.w; out[4] = b1.x; out[5] = b1.y; out[6] = b1.z; out[7] = b1.w;
#pragma unroll
    for (int tap = 0; tap < 4; ++tap) { float x[8]; unpack8(*(const LAS u32x4*)(raw + (tok + tap) * rs + ch0), x);
        const f32x4 w0 = *(const f32x4*)(cw + tap * 1280 + cidx), w1 = *(const f32x4*)(cw + tap * 1280 + cidx + 4);
        out[0] += w0.x * x[0]; out[1] += w0.y * x[1]; out[2] += w0.z * x[2]; out[3] += w0.w * x[3]; out[4] += w1.x * x[4]; out[5] += w1.y * x[5]; out[6] += w1.z * x[6]; out[7] += w1.w * x[7]; }
#pragma unroll
    for (int i = 0; i < 8; ++i) out[i] = fsilu(out[i]);
}
__device__ __forceinline__ void ssd_gates(const KPV& p, int layer, const bf16_t* proj, int tok0, int h, LAS float* F, int lane) {
    const float dtr = bf2f(proj[(size_t)(tok0 + lane) * PINP + PSDT + h]);
    const float dt = fsoftplus(dtr + p.in(14)[layer * 12 + h]);
    const float a = -expf(p.in(13)[layer * 12 + h]) * dt;
    F[lane] = wave_incl_scan(a, lane); F[64 + lane] = dt;
}
__device__ __forceinline__ void ssd_pre_unit(const KPV& p, int layer, int unit, LAS unsigned char* lds, int tid, int wave, int lane) {
    const int b = unit / (NCH * 12), n = (unit / 12) % NCH, h = unit % 12, g = h / 6;
    const int tok0 = b * SEQ + n * CH; const int u3 = (b * 12 + h) * NCH + n;
    const bf16_t* proj = (const bf16_t*)(p.ws() + WS_AP);
    LAS bf16_t* rawB = (LAS bf16_t*)(lds + S_RAWB); LAS bf16_t* rawX = (LAS bf16_t*)(lds + S_RAWX);
    LAS bf16_t* BT = (LAS bf16_t*)(lds + S_BS); LAS bf16_t* XdT = (LAS bf16_t*)(lds + S_XDT); LAS float* F = (LAS float*)(lds + S_F);
    { u32x4 vb[3], vx[2];
      ssd_raw_ld<16, 3>(proj, tok0, n, PSB + g * 128, tid, vb); ssd_raw_ld<8, 2>(proj, tok0, n, PSX + h * 64, tid, vx);
      if (wave == 0) ssd_gates(p, layer, proj, tok0, h, F, lane);
      ssd_raw_st<16, 3>(rawB, tid, vb); ssd_raw_st<8, 2>(rawX, tid, vx); }
    WG_SYNC();
    { const float* cw = p.in(11) + (size_t)layer * 4 * 1280; const float* cb = p.in(12) + (size_t)layer * 1280;
      const int tok = tid >> 3, sub = tid & 7; float o[8];
#pragma unroll
      for (int half = 0; half < 2; ++half) { const int ch0 = sub * 16 + half * 8;
          ssd_conv8(rawB, 128, tok, ch0, cw, cb, 768 + g * 128 + ch0, o);
#pragma unroll
          for (int i = 0; i < 8; ++i) BT[(ch0 + i) * 72 + tok] = (bf16_t)f2bf(o[i]); }
      const float sc = F[64 + tok] * expf(F[63] - F[tok]);
      ssd_conv8(rawX, 64, tok, sub * 8, cw, cb, h * 64 + sub * 8, o);
#pragma unroll
      for (int i = 0; i < 8; ++i) XdT[(sub * 8 + i) * 72 + tok] = (bf16_t)f2bf(o[i] * sc);
    }
    WG_SYNC();
    { const int fr = lane & 15, fq = lane >> 4; bf16_t* st = (bf16_t*)(p.ws() + WS_ST) + (size_t)u3 * 8192;
      for (int job = wave * 4; job < wave * 4 + 4; ++job) { const int pt = job >> 3, kt = job & 7;
          f32x4 acc = (f32x4){0.f, 0.f, 0.f, 0.f};
          acc = mm16(XdT + pt * 16 * 72, 72, BT + kt * 16 * 72, 72, 64, acc, fr, fq);
          u32x2 w; w.x = pk2(acc[0], acc[1]); w.y = pk2(acc[2], acc[3]);
          *(u32x2*)(st + (pt * 16 + fr) * 128 + kt * 16 + 4 * fq) = w; }
      if (tid == 0) ((float*)(p.ws() + WS_CD))[u3] = expf(F[63]);
    }
    WG_SYNC();
}
__device__ __forceinline__ void ssd_scan_items(const KPV& p, int first, int stride) {
    bf16_t* st = (bf16_t*)(p.ws() + WS_ST); const float* CD = (const float*)(p.ws() + WS_CD);
    for (int it = first; it < 96 * 1024; it += stride) { const int bh = it >> 10, vec = it & 1023;
        float S[8];
#pragma unroll
        for (int i = 0; i < 8; ++i) S[i] = 0.f;
        u32x4* base = (u32x4*)(st + ((size_t)bh * NCH * 8192 + vec * 8));
#pragma unroll 1
        for (int n0 = 0; n0 < NCH; n0 += 8) { u32x4 v[8]; float cd[8];
#pragma unroll
            for (int k = 0; k < 8; ++k) { v[k] = base[(size_t)(n0 + k) * 1024]; cd[k] = CD[bh * NCH + n0 + k]; }
#pragma unroll
            for (int k = 0; k < 8; ++k) { float x[8]; unpack8(v[k], x);
                u32x4 o; o.x = pk2(S[0], S[1]); o.y = pk2(S[2], S[3]); o.z = pk2(S[4], S[5]); o.w = pk2(S[6], S[7]); base[(size_t)(n0 + k) * 1024] = o;
#pragma unroll
                for (int i = 0; i < 8; ++i) S[i] = S[i] * cd[k] + x[i]; } }
    }
}
__device__ __forceinline__ void ssd_out_unit(const KPV& p, int layer, int unit, LAS unsigned char* lds, int tid, int wave, int lane) {
    const int b = unit / (NCH * 12), n = (unit / 12) % NCH, h = unit % 12, g = h / 6;
    const int tok0 = b * SEQ + n * CH; const int u3 = (b * 12 + h) * NCH + n;
    const bf16_t* proj = (const bf16_t*)(p.ws() + WS_AP);
    LAS bf16_t* rawC = (LAS bf16_t*)(lds + S_RAWC); LAS bf16_t* rawB = (LAS bf16_t*)(lds + S_RAWB); LAS bf16_t* rawX = (LAS bf16_t*)(lds + S_RAWX);
    LAS bf16_t* Cs = (LAS bf16_t*)(lds + S_CS); LAS bf16_t* Bs = (LAS bf16_t*)(lds + S_BS); LAS bf16_t* Sp = (LAS bf16_t*)(lds + S_SP);
    LAS bf16_t* XdT = (LAS bf16_t*)(lds + S_XDT); LAS bf16_t* XsN = (LAS bf16_t*)(lds + S_XSN); LAS bf16_t* Ms = (LAS bf16_t*)(lds + S_MS); LAS float* F = (LAS float*)(lds + S_F);
    { u32x4 vc[3], vb[3], vx[2], vs[2]; const bf16_t* st = (const bf16_t*)(p.ws() + WS_ST) + (size_t)u3 * 8192;
      ssd_raw_ld<16, 3>(proj, tok0, n, PSC + g * 128, tid, vc); ssd_raw_ld<16, 3>(proj, tok0, n, PSB + g * 128, tid, vb); ssd_raw_ld<8, 2>(proj, tok0, n, PSX + h * 64, tid, vx);
#pragma unroll
      for (int k = 0; k < 2; ++k) { const int c = tid + 512 * k; vs[k] = *(const u32x4*)(st + (c >> 4) * 128 + (c & 15) * 8); }
      if (wave == 0) ssd_gates(p, layer, proj, tok0, h, F, lane);
      ssd_raw_st<16, 3>(rawC, tid, vc); ssd_raw_st<16, 3>(rawB, tid, vb); ssd_raw_st<8, 2>(rawX, tid, vx);
#pragma unroll
      for (int k = 0; k < 2; ++k) { const int c = tid + 512 * k; *(LAS u32x4*)(Sp + (c >> 4) * 136 + (c & 15) * 8) = vs[k]; } }
    WG_SYNC();
    { const float* cw = p.in(11) + (size_t)layer * 4 * 1280; const float* cb = p.in(12) + (size_t)layer * 1280;
      const int tok = tid >> 3, sub = tid & 7; float o[8];
#pragma unroll
      for (int half = 0; half < 2; ++half) { const int ch0 = sub * 16 + half * 8; u32x4 w;
          ssd_conv8(rawC, 128, tok, ch0, cw, cb, 1024 + g * 128 + ch0, o);
          w.x = pk2(o[0], o[1]); w.y = pk2(o[2], o[3]); w.z = pk2(o[4], o[5]); w.w = pk2(o[6], o[7]); *(LAS u32x4*)(Cs + tok * 136 + ch0) = w;
          ssd_conv8(rawB, 128, tok, ch0, cw, cb, 768 + g * 128 + ch0, o);
          w.x = pk2(o[0], o[1]); w.y = pk2(o[2], o[3]); w.z = pk2(o[4], o[5]); w.w = pk2(o[6], o[7]); *(LAS u32x4*)(Bs + tok * 136 + ch0) = w; }
      const float dt = F[64 + tok];
      ssd_conv8(rawX, 64, tok, sub * 8, cw, cb, h * 64 + sub * 8, o);
      { u32x4 w; w.x = pk2(o[0], o[1]); w.y = pk2(o[2], o[3]); w.z = pk2(o[4], o[5]); w.w = pk2(o[6], o[7]); *(LAS u32x4*)(XsN + tok * 72 + sub * 8) = w; }
#pragma unroll
      for (int i = 0; i < 8; ++i) XdT[(sub * 8 + i) * 72 + tok] = (bf16_t)f2bf(o[i] * dt);
    }
    WG_SYNC();
    const int fr = lane & 15, fq = lane >> 4;
    for (int t = wave * 2; t < wave * 2 + 2; ++t) { const int ti = t >> 2, tj = t & 3;
        f32x4 acc = (f32x4){0.f, 0.f, 0.f, 0.f};
        acc = mm16(Cs + ti * 16 * 136, 136, Bs + tj * 16 * 136, 136, 128, acc, fr, fq);
        const int i = ti * 16 + fr, j0 = tj * 16 + 4 * fq; const float ai = F[i]; float o[4];
#pragma unroll
        for (int jj = 0; jj < 4; ++jj) o[jj] = (i >= j0 + jj) ? acc[jj] * expf(ai - F[j0 + jj]) : 0.f;
        u32x2 w; w.x = pk2(o[0], o[1]); w.y = pk2(o[2], o[3]); *(LAS u32x2*)(Ms + i * 72 + j0) = w; }
    WG_SYNC();
    { const float Dh = p.in(15)[layer * 12 + h]; float* YS = (float*)(p.ws() + WS_XN);
      for (int t = wave * 2; t < wave * 2 + 2; ++t) { const int ti = t >> 2, tp = t & 3;
          f32x4 yd = (f32x4){0.f, 0.f, 0.f, 0.f}, yo = yd;
          yd = mm16(Ms + ti * 16 * 72, 72, XdT + tp * 16 * 72, 72, 64, yd, fr, fq);
          yo = mm16(Cs + ti * 16 * 136, 136, Sp + tp * 16 * 136, 136, 128, yo, fr, fq);
          const int i = ti * 16 + fr, p0 = tp * 16 + 4 * fq; const float ea = expf(F[i]);
          const u32x2 xv = *(const LAS u32x2*)(XsN + i * 72 + p0);
          const u32x2 zv = *(const u32x2*)(proj + (size_t)(tok0 + i) * PINP + PSZ + h * 64 + p0);
          const float xs0 = bf2f(xv.x & 0xffffu), xs1 = __uint_as_float(xv.x & 0xffff0000u), xs2 = bf2f(xv.y & 0xffffu), xs3 = __uint_as_float(xv.y & 0xffff0000u);
          const float z0 = bf2f(zv.x & 0xffffu), z1 = __uint_as_float(zv.x & 0xffff0000u), z2 = bf2f(zv.y & 0xffffu), z3 = __uint_as_float(zv.y & 0xffff0000u);
          f32x4 y; y.x = (yd[0] + yo[0] * ea + Dh * xs0) * fsilu(z0); y.y = (yd[1] + yo[1] * ea + Dh * xs1) * fsilu(z1);
          y.z = (yd[2] + yo[2] * ea + Dh * xs2) * fsilu(z2); y.w = (yd[3] + yo[3] * ea + Dh * xs3) * fsilu(z3);
          *(f32x4*)(YS + (size_t)(tok0 + i) * 768 + h * 64 + p0) = y; }
    }
    WG_SYNC();
}

__device__ __forceinline__ void ssd_gates6(const KPV& p, int layer, const bf16_t* proj, int tok0, int g, LAS float* F, int wave, int lane) {
    if (wave < 6) { const int h = g * 6 + wave;
        const float dtr = bf2f(proj[(size_t)(tok0 + lane) * PINP + PSDT + h]);
        const float dt = fsoftplus(dtr + p.in(14)[layer * 12 + h]);
        const float a = -expf(p.in(13)[layer * 12 + h]) * dt;
        F[wave * 64 + lane] = wave_incl_scan(a, lane); F[384 + wave * 64 + lane] = dt; }
}
constexpr int SG_RAWB = 0, SG_RAWX = 17152, SG_BT = 68608, SG_XDT = 87040, SG_F = 142336;
__device__ __forceinline__ void ssd_pre_g(const KPV& p, int layer, int unit, LAS unsigned char* lds, int tid, int wave, int lane) {
    const int b = unit / (NCH * 2), n = (unit >> 1) % NCH, g = unit & 1;
    const int tok0 = b * SEQ + n * CH;
    const bf16_t* proj = (const bf16_t*)(p.ws() + WS_AP);
    LAS bf16_t* rawB = (LAS bf16_t*)(lds + SG_RAWB); LAS bf16_t* rawX = (LAS bf16_t*)(lds + SG_RAWX);
    LAS bf16_t* BT = (LAS bf16_t*)(lds + SG_BT); LAS bf16_t* XdT = (LAS bf16_t*)(lds + SG_XDT); LAS float* F = (LAS float*)(lds + SG_F);
    { u32x4 vb[3], vx[7];
      ssd_raw_ld<16, 3>(proj, tok0, n, PSB + g * 128, tid, vb); ssd_raw_ld<48, 7>(proj, tok0, n, PSX + g * 384, tid, vx);
      ssd_gates6(p, layer, proj, tok0, g, F, wave, lane);
      ssd_raw_st<16, 3>(rawB, tid, vb); ssd_raw_st<48, 7>(rawX, tid, vx); }
    WG_SYNC();
    { const float* cw = p.in(11) + (size_t)layer * 4 * 1280; const float* cb = p.in(12) + (size_t)layer * 1280;
      const int tok = tid >> 3, sub = tid & 7; float o[8];
#pragma unroll
      for (int half = 0; half < 2; ++half) { const int ch0 = sub * 16 + half * 8;
          ssd_conv8(rawB, 128, tok, ch0, cw, cb, 768 + g * 128 + ch0, o);
#pragma unroll
          for (int i = 0; i < 8; ++i) BT[(ch0 + i) * 72 + tok] = (bf16_t)f2bf(o[i]); }
#pragma unroll 1
      for (int hh = 0; hh < 6; ++hh) { const float sc = F[384 + hh * 64 + tok] * expf(F[hh * 64 + 63] - F[hh * 64 + tok]);
          ssd_conv8(rawX, 384, tok, hh * 64 + sub * 8, cw, cb, (g * 6 + hh) * 64 + sub * 8, o);
#pragma unroll
          for (int i = 0; i < 8; ++i) XdT[(hh * 64 + sub * 8 + i) * 72 + tok] = (bf16_t)f2bf(o[i] * sc); }
    }
    WG_SYNC();
    { const int fr = lane & 15, fq = lane >> 4; bf16_t* stb = (bf16_t*)(p.ws() + WS_ST);
      for (int job = wave * 24; job < wave * 24 + 24; ++job) { const int hh = job >> 5, pt = (job >> 3) & 3, kt = job & 7;
          f32x4 acc = (f32x4){0.f, 0.f, 0.f, 0.f};
          acc = mm16(XdT + (hh * 64 + pt * 16) * 72, 72, BT + kt * 16 * 72, 72, 64, acc, fr, fq);
          u32x2 w; w.x = pk2(acc[0], acc[1]); w.y = pk2(acc[2], acc[3]);
          *(u32x2*)(stb + (size_t)((b * 12 + g * 6 + hh) * NCH + n) * 8192 + (pt * 16 + fr) * 128 + kt * 16 + 4 * fq) = w; }
      if (tid < 6) ((float*)(p.ws() + WS_CD))[(b * 12 + g * 6 + tid) * NCH + n] = expf(F[tid * 64 + 63]);
    }
    WG_SYNC();
}
constexpr int OG_RAWC = 0, OG_RAWB = 17152, OG_RAWX = 34304, OG_CS = 85760, OG_BS = 103168, OG_XDT = 120576, OG_XSN = 129792, OG_F = 139008, OG_SP = 0, OG_MS = 17408;
__device__ __forceinline__ void ssd_out_g(const KPV& p, int layer, int unit, LAS unsigned char* lds, int tid, int wave, int lane) {
    const int b = unit / (NCH * 2), n = (unit >> 1) % NCH, g = unit & 1;
    const int tok0 = b * SEQ + n * CH;
    const bf16_t* proj = (const bf16_t*)(p.ws() + WS_AP);
    LAS bf16_t* rawC = (LAS bf16_t*)(lds + OG_RAWC); LAS bf16_t* rawB = (LAS bf16_t*)(lds + OG_RAWB); LAS bf16_t* rawX = (LAS bf16_t*)(lds + OG_RAWX);
    LAS bf16_t* Cs = (LAS bf16_t*)(lds + OG_CS); LAS bf16_t* Bs = (LAS bf16_t*)(lds + OG_BS); LAS bf16_t* Sp = (LAS bf16_t*)(lds + OG_SP);
    LAS bf16_t* XdT = (LAS bf16_t*)(lds + OG_XDT); LAS bf16_t* XsN = (LAS bf16_t*)(lds + OG_XSN); LAS bf16_t* Ms = (LAS bf16_t*)(lds + OG_MS); LAS float* F = (LAS float*)(lds + OG_F);
    const float* cw = p.in(11) + (size_t)layer * 4 * 1280; const float* cb = p.in(12) + (size_t)layer * 1280;
    const int tok = tid >> 3, sub = tid & 7, fr = lane & 15, fq = lane >> 4;
    { u32x4 vc[3], vb[3], vx[7];
      ssd_raw_ld<16, 3>(proj, tok0, n, PSC + g * 128, tid, vc); ssd_raw_ld<16, 3>(proj, tok0, n, PSB + g * 128, tid, vb); ssd_raw_ld<48, 7>(proj, tok0, n, PSX + g * 384, tid, vx);
      ssd_gates6(p, layer, proj, tok0, g, F, wave, lane);
      ssd_raw_st<16, 3>(rawC, tid, vc); ssd_raw_st<16, 3>(rawB, tid, vb); ssd_raw_st<48, 7>(rawX, tid, vx); }
    WG_SYNC();
    { float o[8];
#pragma unroll
      for (int half = 0; half < 2; ++half) { const int ch0 = sub * 16 + half * 8; u32x4 w;
          ssd_conv8(rawC, 128, tok, ch0, cw, cb, 1024 + g * 128 + ch0, o);
          w.x = pk2(o[0], o[1]); w.y = pk2(o[2], o[3]); w.z = pk2(o[4], o[5]); w.w = pk2(o[6], o[7]); *(LAS u32x4*)(Cs + tok * 136 + ch0) = w;
          ssd_conv8(rawB, 128, tok, ch0, cw, cb, 768 + g * 128 + ch0, o);
          w.x = pk2(o[0], o[1]); w.y = pk2(o[2], o[3]); w.z = pk2(o[4], o[5]); w.w = pk2(o[6], o[7]); *(LAS u32x4*)(Bs + tok * 136 + ch0) = w; } }
    WG_SYNC();
    f32x4 cbt[2];
#pragma unroll
    for (int q = 0; q < 2; ++q) { const int t = wave * 2 + q, ti = t >> 2, tj = t & 3; cbt[q] = (f32x4){0.f, 0.f, 0.f, 0.f};
        cbt[q] = mm16(Cs + ti * 16 * 136, 136, Bs + tj * 16 * 136, 136, 128, cbt[q], fr, fq); }
    const bf16_t* stb = (const bf16_t*)(p.ws() + WS_ST); float* YS = (float*)(p.ws() + WS_XN);
    u32x4 vs[2];
#pragma unroll
    for (int k = 0; k < 2; ++k) { const int c = tid + 512 * k; vs[k] = *(const u32x4*)(stb + (size_t)((b * 12 + g * 6) * NCH + n) * 8192 + (c >> 4) * 128 + (c & 15) * 8); }
#pragma unroll 1
    for (int hh = 0; hh < 6; ++hh) { const int h = g * 6 + hh;
#pragma unroll
        for (int k = 0; k < 2; ++k) { const int c = tid + 512 * k; *(LAS u32x4*)(Sp + (c >> 4) * 136 + (c & 15) * 8) = vs[k]; }
        if (hh + 1 < 6) {
#pragma unroll
            for (int k = 0; k < 2; ++k) { const int c = tid + 512 * k; vs[k] = *(const u32x4*)(stb + (size_t)((b * 12 + h + 1) * NCH + n) * 8192 + (c >> 4) * 128 + (c & 15) * 8); } }
        u32x2 zv[2];
#pragma unroll
        for (int q = 0; q < 2; ++q) { const int t = wave * 2 + q, ti = t >> 2, tp = t & 3; zv[q] = *(const u32x2*)(proj + (size_t)(tok0 + ti * 16 + fr) * PINP + PSZ + h * 64 + tp * 16 + 4 * fq); }
        { float o[8]; const float dt = F[384 + hh * 64 + tok];
          ssd_conv8(rawX, 384, tok, hh * 64 + sub * 8, cw, cb, h * 64 + sub * 8, o);
          u32x4 w; w.x = pk2(o[0], o[1]); w.y = pk2(o[2], o[3]); w.z = pk2(o[4], o[5]); w.w = pk2(o[6], o[7]); *(LAS u32x4*)(XsN + tok * 72 + sub * 8) = w;
#pragma unroll
          for (int i = 0; i < 8; ++i) XdT[(sub * 8 + i) * 72 + tok] = (bf16_t)f2bf(o[i] * dt); }
#pragma unroll
        for (int q = 0; q < 2; ++q) { const int t = wave * 2 + q, ti = t >> 2, tj = t & 3, i = ti * 16 + fr, j0 = tj * 16 + 4 * fq; const float ai = F[hh * 64 + i]; float o[4];
#pragma unroll
            for (int jj = 0; jj < 4; ++jj) o[jj] = (i >= j0 + jj) ? cbt[q][jj] * expf(ai - F[hh * 64 + j0 + jj]) : 0.f;
            u32x2 w; w.x = pk2(o[0], o[1]); w.y = pk2(o[2], o[3]); *(LAS u32x2*)(Ms + i * 72 + j0) = w; }
        WG_SYNC();
        { const float Dh = p.in(15)[layer * 12 + h];
#pragma unroll
          for (int q = 0; q < 2; ++q) { const int t = wave * 2 + q, ti = t >> 2, tp = t & 3;
              f32x4 yd = (f32x4){0.f, 0.f, 0.f, 0.f}, yo = yd;
              yd = mm16(Ms + ti * 16 * 72, 72, XdT + tp * 16 * 72, 72, 64, yd, fr, fq);
              yo = mm16(Cs + ti * 16 * 136, 136, Sp + tp * 16 * 136, 136, 128, yo, fr, fq);
              const int i = ti * 16 + fr, p0 = tp * 16 + 4 * fq; const float ea = expf(F[hh * 64 + i]);
              const u32x2 xv = *(const LAS u32x2*)(XsN + i * 72 + p0); const u32x2 z2 = zv[q];
              const float xs0 = bf2f(xv.x & 0xffffu), xs1 = __uint_as_float(xv.x & 0xffff0000u), xs2 = bf2f(xv.y & 0xffffu), xs3 = __uint_as_float(xv.y & 0xffff0000u);
              const float z0 = bf2f(z2.x & 0xffffu), z1 = __uint_as_float(z2.x & 0xffff0000u), z2f = bf2f(z2.y & 0xffffu), z3 = __uint_as_float(z2.y & 0xffff0000u);
              f32x4 y; y.x = (yd[0] + yo[0] * ea + Dh * xs0) * fsilu(z0); y.y = (yd[1] + yo[1] * ea + Dh * xs1) * fsilu(z1);
              y.z = (yd[2] + yo[2] * ea + Dh * xs2) * fsilu(z2f); y.w = (yd[3] + yo[3] * ea + Dh * xs3) * fsilu(z3);
              *(f32x4*)(YS + (size_t)(tok0 + i) * 768 + h * 64 + p0) = y; }
        }
        WG_SYNC();
    }
}

constexpr int S5_WAVE_LDS = 12800, S5P2_WAVE_LDS = 17152;
struct S5Par { float abr, abi; float bbr[16], bbi[16]; };
__device__ __forceinline__ void s5_params(const KPV& p, int layer, int g, int n, S5Par& P) {
    const int gi = (layer * 32 + g) * 64 + n;
    const float are = p.in(17)[gi], aim = p.in(18)[gi], delta = expf(p.in(24)[layer * 32 + g]);
    const float mag = expf(are * delta); float sn, cs; sincosf(aim * delta, &sn, &cs);
    P.abr = mag * cs; P.abi = mag * sn;
    const float den = are * are + aim * aim, pre = P.abr - 1.f, pim = P.abi;
    const float fre = (pre * are + pim * aim) / den, fim = (pim * are - pre * aim) / den;
    const float* br = p.in(19) + (size_t)gi * 16; const float* bi = p.in(20) + (size_t)gi * 16;
#pragma unroll
    for (int i4 = 0; i4 < 4; ++i4) { const f32x4 r = *(const f32x4*)(br + 4 * i4), im = *(const f32x4*)(bi + 4 * i4);
#pragma unroll
        for (int j = 0; j < 4; ++j) { P.bbr[4 * i4 + j] = fre * r[j] - fim * im[j]; P.bbi[4 * i4 + j] = fre * im[j] + fim * r[j]; } }
}
__device__ __forceinline__ void s5_load_u(const bf16_t* proj, int tok0, int g, LAS float* Us, int lane) {
    const bf16_t* src = proj + (size_t)(tok0 + lane) * PINP + PU + g * 16;
    float x[16]; unpack8(*(const u32x4*)src, x); unpack8(*(const u32x4*)(src + 8), x + 8);
#pragma unroll
    for (int i4 = 0; i4 < 4; ++i4) *(LAS f32x4*)(Us + lane * 16 + 4 * i4) = (f32x4){x[4 * i4], x[4 * i4 + 1], x[4 * i4 + 2], x[4 * i4 + 3]};
    asm volatile("s_waitcnt lgkmcnt(0)" ::: "memory"); __builtin_amdgcn_wave_barrier();
}
__device__ __forceinline__ void s5_step(const S5Par& P, const LAS float* Us, int t, float& hr, float& hi) {
    float bur = 0.f, bui = 0.f;
#pragma unroll
    for (int i4 = 0; i4 < 4; ++i4) { const f32x4 u = *(const LAS f32x4*)(Us + t * 16 + 4 * i4);
#pragma unroll
        for (int j = 0; j < 4; ++j) { bur += u[j] * P.bbr[4 * i4 + j]; bui += u[j] * P.bbi[4 * i4 + j]; } }
    const float nr = P.abr * hr - P.abi * hi + bur, ni = P.abr * hi + P.abi * hr + bui; hr = nr; hi = ni;
}
__device__ __forceinline__ void s5_pass1(const KPV& p, int layer, int wu, LAS unsigned char* wl, int lane, const S5Par& P) {
    const int b = wu / (NCH * 32), c = (wu / 32) % NCH, g = wu % 32;
    const bf16_t* proj = (const bf16_t*)(p.ws() + WS_AP); LAS float* Us = (LAS float*)wl;
    s5_load_u(proj, b * SEQ + c * CH, g, Us, lane);
    float hr = 0.f, hi = 0.f;
#pragma unroll 4
    for (int t = 0; t < CH; ++t) s5_step(P, Us, t, hr, hi);
    ((f32x2*)(p.ws() + WS_E5))[(size_t)((b * NCH + c) * 32 + g) * 64 + lane] = (f32x2){hr, hi};
    asm volatile("s_waitcnt lgkmcnt(0)" ::: "memory"); __builtin_amdgcn_wave_barrier();
}
__device__ __forceinline__ void s5_shadow_unit(const KPV& p, int layer, int wu, LAS unsigned char* wl, int lane) { S5Par P; s5_params(p, layer, wu & 31, lane, P); s5_pass1(p, layer, wu, wl, lane, P); }
__device__ __forceinline__ float gelu_tanh(float y) { const float x = 0.7978845608028654f * (y + 0.044715f * y * y * y); const float t = 1.f - 2.f / (__expf(2.f * x) + 1.f); return 0.5f * y * (1.f + t); }
__device__ __forceinline__ void s5_setup_c(const KPV& p, int layer, int g, LAS unsigned char* wl, int lane) {
    LAS bf16_t* Cc = (LAS bf16_t*)(wl + 12800);
    const float* cr = p.in(21) + (size_t)(layer * 32 + g) * 16 * 64; const float* ci = p.in(22) + (size_t)(layer * 32 + g) * 16 * 64;
#pragma unroll
    for (int i = 0; i < 16; ++i) *(LAS unsigned*)(Cc + i * 136 + 2 * lane) = pk2(cr[i * 64 + lane], -ci[i * 64 + lane]);
}
struct S5Frag { bf16x8 y[8]; };
__device__ __forceinline__ void s5_bfrag(const KPV& p, int layer, int g, int lane, S5Frag& Fg) {
    const int fr = lane & 15, fq = lane >> 4; const float delta = expf(p.in(24)[layer * 32 + g]);
#pragma unroll
    for (int nt = 0; nt < 8; ++nt) { const int n = nt * 8 + (fr >> 1), gi = (layer * 32 + g) * 64 + n;
        const float are = p.in(17)[gi], aim = p.in(18)[gi]; const float mag = expf(are * delta); float sn, cs; sincosf(aim * delta, &sn, &cs);
        const float abr = mag * cs, abi = mag * sn, den = are * are + aim * aim, pre = abr - 1.f, pim = abi;
        const float fre = (pre * are + pim * aim) / den, fim = (pim * are - pre * aim) / den;
        const float* br = p.in(19) + (size_t)gi * 16 + (fq & 1) * 8; const float* bi = p.in(20) + (size_t)gi * 16 + (fq & 1) * 8;
        const f32x4 r0 = *(const f32x4*)br, r1 = *(const f32x4*)(br + 4), i0 = *(const f32x4*)bi, i1 = *(const f32x4*)(bi + 4);
        f32x4 v0, v1;
        if (fr & 1) { v0 = i0 * fre + r0 * fim; v1 = i1 * fre + r1 * fim; } else { v0 = r0 * fre - i0 * fim; v1 = r1 * fre - i1 * fim; }
        u32x4 w; w.x = pk2(v0[0], v0[1]); w.y = pk2(v0[2], v0[3]); w.z = pk2(v1[0], v1[1]); w.w = pk2(v1[2], v1[3]);
        if (fq >= 2) w = (u32x4){0u, 0u, 0u, 0u};
        Fg.y[nt] = __builtin_bit_cast(bf16x8, w); }
}
__device__ __forceinline__ void s5_pass2(const KPV& p, int layer, int wu, LAS unsigned char* wl, int lane, const S5Par& P, const S5Frag& Fg) {
    const int b = wu / (NCH * 32), c = (wu / 32) % NCH, g = wu % 32;
    const bf16_t* proj = (const bf16_t*)(p.ws() + WS_AP); LAS float* Bu = (LAS float*)wl; LAS bf16_t* Hs = (LAS bf16_t*)(wl + 8448); LAS bf16_t* Cc = (LAS bf16_t*)(wl + 12800);
    const int tok0 = b * SEQ + c * CH, fr = lane & 15, fq = lane >> 4;
    u32x4 xu[4]; u32x2 ud[4];
#pragma unroll
    for (int sb = 0; sb < 4; ++sb) { const bf16_t* row = proj + (size_t)(tok0 + sb * 16 + fr) * PINP + PU + g * 16;
        xu[sb] = (u32x4){0u, 0u, 0u, 0u}; if (fq < 2) xu[sb] = *(const u32x4*)(row + fq * 8);
        ud[sb] = *(const u32x2*)(row + 4 * fq); }
    float a64r = P.abr, a64i = P.abi;
#pragma unroll
    for (int s = 0; s < 6; ++s) { const float r = a64r * a64r - a64i * a64i, i2 = 2.f * a64r * a64i; a64r = r; a64i = i2; }
    float hr = 0.f, hi = 0.f;
    { const f32x2* E = (const f32x2*)(p.ws() + WS_E5) + (size_t)(b * NCH * 32 + g) * 64 + lane;
#pragma unroll 1
      for (int cc0 = 0; cc0 < c; cc0 += 8) { f32x2 e[8];
#pragma unroll
          for (int k = 0; k < 8; ++k) e[k] = (cc0 + k < c) ? E[(size_t)(cc0 + k) * 32 * 64] : (f32x2){0.f, 0.f};
#pragma unroll
          for (int k = 0; k < 8; ++k) if (cc0 + k < c) { const float nr = a64r * hr - a64i * hi + e[k].x, ni = a64r * hi + a64i * hr + e[k].y; hr = nr; hi = ni; } } }
    const f32x4 dsk = *(const f32x4*)(p.in(23) + layer * 512 + g * 16 + 4 * fq);
    bf16_t* G5 = (bf16_t*)(p.ws() + WS_G5);
#pragma unroll
    for (int sb = 0; sb < 4; ++sb) {
        const bf16x8 xf = __builtin_bit_cast(bf16x8, xu[sb]);
#pragma unroll
        for (int nt = 0; nt < 8; ++nt) { f32x4 a = (f32x4){0.f, 0.f, 0.f, 0.f};
            a = __builtin_amdgcn_mfma_f32_16x16x32_bf16(Fg.y[nt], xf, a, 0, 0, 0);
            *(LAS f32x4*)(Bu + fr * 132 + nt * 16 + 4 * fq) = a; }
        asm volatile("s_waitcnt lgkmcnt(0)" ::: "memory"); __builtin_amdgcn_wave_barrier();
#pragma unroll 4
        for (int t = 0; t < 16; ++t) { const f32x2 bu = *(const LAS f32x2*)(Bu + t * 132 + 2 * lane);
            const float nr = P.abr * hr - P.abi * hi + bu.x, ni = P.abr * hi + P.abi * hr + bu.y; hr = nr; hi = ni;
            *(LAS unsigned*)(Hs + t * 136 + 2 * lane) = pk2(hr, hi); }
        asm volatile("s_waitcnt lgkmcnt(0)" ::: "memory"); __builtin_amdgcn_wave_barrier();
        f32x4 acc = (f32x4){0.f, 0.f, 0.f, 0.f};
        acc = mm16(Hs, 136, Cc, 136, 128, acc, fr, fq);
        const float u0 = bf2f(ud[sb].x & 0xffffu), u1 = __uint_as_float(ud[sb].x & 0xffff0000u), u2 = bf2f(ud[sb].y & 0xffffu), u3 = __uint_as_float(ud[sb].y & 0xffff0000u);
        u32x2 w; w.x = pk2(gelu_tanh(acc[0] + dsk.x * u0), gelu_tanh(acc[1] + dsk.y * u1)); w.y = pk2(gelu_tanh(acc[2] + dsk.z * u2), gelu_tanh(acc[3] + dsk.w * u3));
        *(u32x2*)(G5 + (size_t)(tok0 + sb * 16 + fr) * 512 + g * 16 + 4 * fq) = w;
        asm volatile("s_waitcnt lgkmcnt(0)" ::: "memory"); __builtin_amdgcn_wave_barrier();
    }
}

__device__ __forceinline__ void gdn_finish(const KPV& p, int layer, int first, int stride, int lane) {
    const bf16_t* GO = (const bf16_t*)(p.ws() + WS_GO); const bf16_t* proj = (const bf16_t*)(p.ws() + WS_AP); bf16_t* MX = (bf16_t*)(p.ws() + WS_MIX);
    const int l = lane & 31; const f32x4 wv = *(const f32x4*)(p.in(10) + layer * 128 + 4 * l);
    constexpr int NIT = M * 6 / 2;
    for (int it0 = first; it0 < NIT; it0 += 4 * stride) { u32x2 ov[4], zv[4];
#pragma unroll
        for (int k = 0; k < 4; ++k) { const int it = it0 + k * stride; if (it < NIT) { const int th = it * 2 + (lane >> 5), tok = th / 6, h = th % 6;
            ov[k] = *(const u32x2*)(GO + (size_t)tok * 768 + h * 128 + 4 * l); zv[k] = *(const u32x2*)(proj + (size_t)tok * PINP + PZ + h * 128 + 4 * l); } }
#pragma unroll
        for (int k = 0; k < 4; ++k) { const int it = it0 + k * stride; if (it < NIT) { const int th = it * 2 + (lane >> 5), tok = th / 6, h = th % 6;
            const float o0 = bf2f(ov[k].x & 0xffffu), o1 = __uint_as_float(ov[k].x & 0xffff0000u), o2 = bf2f(ov[k].y & 0xffffu), o3 = __uint_as_float(ov[k].y & 0xffff0000u);
            const float z0 = bf2f(zv[k].x & 0xffffu), z1 = __uint_as_float(zv[k].x & 0xffff0000u), z2 = bf2f(zv[k].y & 0xffffu), z3 = __uint_as_float(zv[k].y & 0xffff0000u);
            float ss = (o0 * o0 + o1 * o1) + (o2 * o2 + o3 * o3);
            ss += __shfl_xor(ss, 1); ss += __shfl_xor(ss, 2); ss += __shfl_xor(ss, 4); ss += __shfl_xor(ss, 8); ss += __shfl_xor(ss, 16);
            const float r = rsqrtf(ss * (1.f / 128.f) + EPS);
            u32x2 w; w.x = pk2(o0 * r * wv.x * fsilu(z0), o1 * r * wv.y * fsilu(z1)); w.y = pk2(o2 * r * wv.z * fsilu(z2), o3 * r * wv.w * fsilu(z3));
            *(u32x2*)(MX + (size_t)tok * 2048 + h * 128 + 4 * l) = w; } }
    }
}
__device__ __forceinline__ void ssd_finish(const KPV& p, int layer, int first, int stride, int lane) {
    const float* YS = (const float*)(p.ws() + WS_XN); bf16_t* MX = (bf16_t*)(p.ws() + WS_MIX); const float* nw = p.in(16) + layer * 768;
    for (int it0 = first; it0 < M * 2; it0 += 4 * stride) { f32x2 v[4][3];
#pragma unroll
        for (int k = 0; k < 4; ++k) { const int it = it0 + k * stride; if (it < M * 2) { const float* y = YS + (size_t)(it >> 1) * 768 + (it & 1) * 384;
#pragma unroll
            for (int q = 0; q < 3; ++q) v[k][q] = *(const f32x2*)(y + 2 * lane + 128 * q); } }
#pragma unroll
        for (int k = 0; k < 4; ++k) { const int it = it0 + k * stride; if (it < M * 2) { const int tok = it >> 1, g = it & 1; float ss = 0.f;
#pragma unroll
            for (int q = 0; q < 3; ++q) ss += v[k][q].x * v[k][q].x + v[k][q].y * v[k][q].y;
            const float r = rsqrtf(wave_sum(ss) * (1.f / 384.f) + EPS);
#pragma unroll
            for (int q = 0; q < 3; ++q) { const f32x2 w = *(const f32x2*)(nw + g * 384 + 2 * lane + 128 * q);
                *(unsigned*)(MX + (size_t)tok * 2048 + 768 + g * 384 + 2 * lane + 128 * q) = pk2(v[k][q].x * r * w.x, v[k][q].y * r * w.y); } } }
    }
}

#define XB_TMO      128
#define XB_XCNT(j)  (256  + 64 * (j))
#define XB_XSUB(j)  (1280 + 64 * (j))
#define XB_XGEN(j)  (2304 + 64 * (j))
#define XB_TOP      3328
#define XB_TOPGEN   3392
#define XCD_BAR_WORDS 3456
#define XB_SPIN_CAP (1u << 18)

__device__ __forceinline__ unsigned xb_ld(unsigned* p)              { return __hip_atomic_load(p, __ATOMIC_RELAXED, __HIP_MEMORY_SCOPE_AGENT); }
__device__ __forceinline__ unsigned xb_add(unsigned* p, unsigned v) { return __hip_atomic_fetch_add(p, v, __ATOMIC_RELAXED, __HIP_MEMORY_SCOPE_AGENT); }
__device__ __forceinline__ unsigned xb_xcc_id() { return (unsigned)__builtin_amdgcn_s_getreg((3 << 11) | 20) & 0xFu; }
#define XB_SPIN(cond, bar) do { unsigned _sp = 0; while (cond) { __builtin_amdgcn_s_sleep(1); \
    if ((++_sp & 255u) == 0u) { if (xb_ld(&(bar)[XB_TMO])) break; if (_sp > XB_SPIN_CAP) { atomicAdd(&(bar)[XB_TMO], 1u); break; } } } } while (0)

struct XcdBarrier {
    unsigned* bar; unsigned x;
    volatile LAS unsigned* st;
};

__device__ __forceinline__ XcdBarrier xcd_barrier_post(unsigned* bar, volatile LAS unsigned* st) {
    XcdBarrier b; b.bar = bar; b.x = xb_xcc_id(); b.st = st;
    if (threadIdx.x == 0) (void)xb_add(&bar[XB_XCNT(b.x)], 1u);
    return b;
}
__device__ __forceinline__ void xcd_barrier_complete(unsigned* bar, unsigned x, unsigned& nloc, unsigned& nx) {
    const unsigned G = gridDim.x * gridDim.y * gridDim.z;
    unsigned sum, cnt, mine, sp = 0u;
    for (;;) {
        sum = 0u; cnt = 0u; mine = 0u;
#pragma unroll
        for (unsigned j = 0; j < 16; ++j) { const unsigned c = xb_ld(&bar[XB_XCNT(j)]); sum += c; cnt += (c > 0u) ? 1u : 0u; mine = (j == x) ? c : mine; }
        if (sum == G) break;
        __builtin_amdgcn_s_sleep(1);
        if ((++sp & 255u) == 0u) { if (xb_ld(&bar[XB_TMO])) break; if (sp > XB_SPIN_CAP) { atomicAdd(&bar[XB_TMO], 1u); break; } }
    }
    nloc = mine > 0u ? mine : 1u; nx = cnt > 0u ? cnt : 1u;
}

__device__ __forceinline__ void xcd_barrier(const XcdBarrier& b) {
    asm volatile("s_waitcnt vmcnt(0)" ::: "memory");
    __syncthreads();
    if (threadIdx.x == 0) {
        unsigned* bar = b.bar;
        __builtin_amdgcn_s_waitcnt(0);
        unsigned nloc = b.st[0], nx = b.st[1];
        if (nloc == 0u) { xcd_barrier_complete(bar, b.x, nloc, nx); b.st[0] = nloc; b.st[1] = nx; }
        const unsigned old = xb_add(&bar[XB_XSUB(b.x)], 1u);
        const unsigned gen = old / nloc;
        if (old + 1u == (gen + 1u) * nloc) {
            __builtin_amdgcn_fence(__ATOMIC_RELEASE, "agent");
            asm volatile("s_waitcnt vmcnt(0)" ::: "memory");
            const unsigned og = xb_add(&bar[XB_TOP], 1u);
            const unsigned tg = og / nx;
            if (og + 1u == (tg + 1u) * nx) xb_add(&bar[XB_TOPGEN], 1u);
            else XB_SPIN(xb_ld(&bar[XB_TOPGEN]) == tg, bar);
            __builtin_amdgcn_fence(__ATOMIC_ACQUIRE, "agent");
            xb_add(&bar[XB_XGEN(b.x)], 1u);
            asm volatile("s_waitcnt vmcnt(0)" ::: "memory");
        } else {
            XB_SPIN(xb_ld(&bar[XB_XGEN(b.x)]) == gen, bar);
            __builtin_amdgcn_fence(__ATOMIC_ACQUIRE, "agent");
            asm volatile("s_waitcnt vmcnt(0)" ::: "memory");
        }
    }
    __syncthreads();
}

constexpr int NPH_LAYER = 13, NPHASES = 2 * NPH_LAYER + 1;
template <int PH, int SEL = 7>
__device__ __forceinline__ void run_phase(LAS unsigned char* lds) {
    const AS4 KP* kp_ = (const AS4 KP*)__builtin_amdgcn_kernarg_segment_ptr();
    asm volatile("" : "+s"(kp_));
    const KPV p{kp_};
    int tid = threadIdx.x; asm volatile("" : "+v"(tid));
    int G = gridDim.x, bid = blockIdx.x; asm volatile("" : "+s"(G), "+s"(bid)); const int NGW = G * 8;
    const int lane = tid & 63, wave = __builtin_amdgcn_readfirstlane(tid >> 6), gw = bid * 8 + wave;
    unsigned char* ws = p.ws(); float* hbuf = p.out();
    bf16_t* HB = (bf16_t*)(ws + WS_H); bf16_t* AP = (bf16_t*)(ws + WS_AP); bf16_t* MX = (bf16_t*)(ws + WS_MIX);
    if constexpr (PH == NPHASES - 1) { norm_phase<true>(hbuf, p.in(32), nullptr, p.out(), gw, NGW, lane); return; }
    constexpr int layer = PH / NPH_LAYER, s = PH % NPH_LAYER;
    if constexpr (s == 0) {
        convert_phase(p, layer, lds, gw, NGW, wave, lane);
        if constexpr (layer == 0) { float* SSQ = (float*)(ws + WS_SSQ);
            norm_raw_phase(p.in(0), nullptr, HB, SSQ, gw, NGW, lane); }
    } else if constexpr (s == 1 || s == 11) {
        pg8::Gemm g{HB, (const bf16_t*)(ws + (s == 1 ? WS_WGU1 : WS_WGU2)), M, 2 * FF, D}; pg8::FixedOrder<64, 44> S{G, bid};
        pg8::rstd_table(S, (const float*)(ws + WS_SSQ) + (size_t)(layer * 3 + (s == 1 ? 0 : 2)) * M * 32, (LAS float*)(lds + 131072));
        pg8::EpiSwiGLU E{AP, FF, (const LAS float*)(lds + 131072)};
        pg8::gemm_phase<pg8::EpiSwiGLU, decltype(S), true, true>(lds, g, S, E);
    } else if constexpr (s == 2 || s == 12) {
        pg8::Gemm g{AP, (const bf16_t*)(ws + (s == 2 ? WS_WD1 : WS_WD2)), M, D, FF}; pg8::FixedOrder<64, 8> S{G, bid};
        if constexpr (layer == 1 && s == 12) { pg8::EpiResidOut E{HB, hbuf, D, 0.5f}; pg8::gemm_phase<pg8::EpiResidOut, decltype(S), true, true>(lds, g, S, E); }
        else { pg8::EpiResidH E{(layer == 0 && s == 2 && SEL != 0) ? p.in(0) : nullptr, HB, D, SEL == 0 ? 0.f : 0.5f,
                                (float*)(ws + WS_SSQ) + (size_t)(s == 2 ? layer * 3 + 1 : (layer + 1) * 3) * M * 32};
            pg8::gemm_phase<pg8::EpiResidH, decltype(S), true, true>(lds, g, S, E); }
    } else if constexpr (s == 4) {
        pg8::Gemm g{HB, (const bf16_t*)(ws + WS_WIN), M, PINP, D}; pg8::FixedOrder<64, 23> S{G, bid};
        pg8::rstd_table(S, (const float*)(ws + WS_SSQ) + (size_t)(layer * 3 + 1) * M * 32, (LAS float*)(lds + 131072));
        pg8::EpiBf16 E{AP, PINP, (const LAS float*)(lds + 131072)};
        pg8::gemm_phase<pg8::EpiBf16, decltype(S), true, true>(lds, g, S, E);
    } else if constexpr (s == 5) {
        int s5_done = 0;
        if (SEL & 1) for (int u = bid, it = 0; u < NBATCH * 6 * NCH; u += G, ++it) { int wu = -1;
            if ((SEL & 4) && wave > 0) { const int slot = it * 7 + (wave - 1); const int cand = bid * 8 + (slot & 7) + (slot >> 3) * NGW; if (cand < NBATCH * NCH * 32) wu = cand; }
            gdn_pre_unit(p, layer, u, lds, tid, wave, lane, wu); if (SEL & 4) s5_done = (it + 1) * 7; }
        if (SEL & 2) for (int u = bid; u < NBATCH * NCH * 2; u += G) ssd_pre_g(p, layer, u, lds, tid, wave, lane);
        if (SEL & 4) for (int slot = s5_done + wave; ; slot += 8) { const int wu = bid * 8 + (slot & 7) + (slot >> 3) * NGW; if (wu >= NBATCH * NCH * 32) break;
            s5_shadow_unit(p, layer, wu, lds + wave * S5_WAVE_LDS, lane); }
    } else if constexpr (s == 6) {
        const int NSC = NBATCH * 6 * 4;
        if (SEL & 1) for (int u = bid; u < NSC; u += G) gdn_scan_unit(p, u, lds, tid, wave, lane);
        if (SEL & 2) { if (G > NSC) { if (bid >= NSC) ssd_scan_items(p, (bid - NSC) * 512 + tid, (G - NSC) * 512); }
        else ssd_scan_items(p, bid * 512 + tid, G * 512); }
    } else if constexpr (s == 7) {
        if (SEL & 2) for (int u = bid; u < NBATCH * NCH * 2; u += G) ssd_out_g(p, layer, u, lds, tid, wave, lane);
        if (SEL & 4) { if ((NGW & 31) == 0) { S5Par P; s5_params(p, layer, gw & 31, lane, P); S5Frag Fg; s5_bfrag(p, layer, gw & 31, lane, Fg); s5_setup_c(p, layer, gw & 31, lds + wave * S5P2_WAVE_LDS, lane);
                for (int u = gw; u < NBATCH * NCH * 32; u += NGW) s5_pass2(p, layer, u, lds + wave * S5P2_WAVE_LDS, lane, P, Fg); }
            else for (int u = gw; u < NBATCH * NCH * 32; u += NGW) { S5Par P; s5_params(p, layer, u & 31, lane, P); S5Frag Fg; s5_bfrag(p, layer, u & 31, lane, Fg); s5_setup_c(p, layer, u & 31, lds + wave * S5P2_WAVE_LDS, lane); s5_pass2(p, layer, u, lds + wave * S5P2_WAVE_LDS, lane, P, Fg); } }
    } else if constexpr (s == 8) {
        pg8::Gemm g{(const bf16_t*)(ws + WS_G5), (const bf16_t*)(ws + WS_WGLU), M, 512, 512}; pg8::FixedOrder<64, 2> S{G, bid};
        pg8::EpiGlu E{(const bf16_t*)(ws + WS_G5), 512, MX, 2048, 1536, p.in(26) + layer * 512};
        pg8::gemm_phase<pg8::EpiGlu, decltype(S), true, true>(lds, g, S, E);
        gdn_finish(p, layer, gw, NGW, lane); ssd_finish(p, layer, gw, NGW, lane);
    } else if constexpr (s == 9) {
        pg8::Gemm g{MX, (const bf16_t*)(ws + WS_WOUT), M, D, D}; pg8::FixedOrder<64, 8> S{G, bid};
        pg8::EpiResidH E{nullptr, HB, D, SEL == 0 ? 0.f : 1.0f, (float*)(ws + WS_SSQ) + (size_t)(layer * 3 + 2) * M * 32};
        pg8::gemm_phase<pg8::EpiResidH, decltype(S), true, true>(lds, g, S, E);
    }
}
__global__ void __launch_bounds__(512) mk_fwd(KP pk) {
    extern __shared__ __attribute__((aligned(16))) unsigned char lds_raw[];
    LAS unsigned char* lds = (LAS unsigned char*)lds_raw;
    const int lo = pk.ph_lo, hi = pk.ph_hi;
    volatile LAS unsigned* xst = (volatile LAS unsigned*)(lds + LDS_BYTES - 64);
    if (threadIdx.x < 2) xst[threadIdx.x] = 0u;
    __syncthreads();
    XcdBarrier xbar = xcd_barrier_post((unsigned*)pk.ws, xst);
    bool first_sync = true;
#ifndef DUP_MASK
#define DUP_MASK 0
#endif
#ifndef DUPSEL5
#define DUPSEL5 DUPSEL
#endif
#ifndef DUPSEL
#define DUPSEL 7
#endif
#ifndef DUP_MIXTO
#define DUP_MIXTO 0
#endif
#ifndef EXTRA_SYNCS
#define EXTRA_SYNCS 0
#endif
#define RUN(k) if (lo <= (k) && (k) < hi && (k) % NPH_LAYER != 3 && (k) % NPH_LAYER != 10) { if ((k) > lo) { if (first_sync) { cg::this_grid().sync(); first_sync = false; } else xcd_barrier(xbar); } for (int xs_ = 0; xs_ < EXTRA_SYNCS; ++xs_) xcd_barrier(xbar); run_phase<(k)>(lds); \
        if (((DUP_MASK >> ((k) % NPH_LAYER)) & 1) && (k) < NPHASES - 1) { xcd_barrier(xbar); run_phase<(k), (((k) % NPH_LAYER == 2 || (k) % NPH_LAYER == 9 || (k) % NPH_LAYER == 12) ? 0 : 7)>(lds); } \
        if ((k) % NPH_LAYER == 8 && (k) < NPHASES - 1) { \
            if (DUP_MIXTO >= 5) { cg::this_grid().sync(); run_phase<(k) - 3, DUPSEL5>(lds); } if (DUP_MIXTO >= 6) { cg::this_grid().sync(); run_phase<(k) - 2, DUPSEL>(lds); } \
            if (DUP_MIXTO >= 7) { cg::this_grid().sync(); run_phase<(k) - 1, DUPSEL>(lds); } if (DUP_MIXTO >= 8) { cg::this_grid().sync(); run_phase<(k)>(lds); } } }
    RUN(0) RUN(1) RUN(2) RUN(3) RUN(4) RUN(5) RUN(6) RUN(7) RUN(8) RUN(9) RUN(10) RUN(11) RUN(12)
    RUN(13) RUN(14) RUN(15) RUN(16) RUN(17) RUN(18) RUN(19) RUN(20) RUN(21) RUN(22) RUN(23) RUN(24) RUN(25) RUN(26)
#undef RUN
}

extern "C" void kernel_launch(void* const* d_in, const int* in_sizes, int n_in, void* d_out, int out_size, void* d_ws, size_t ws_size, hipStream_t stream) {
    static int grid = 0;
    if (grid == 0) {
        if (n_in != 33 || in_sizes[0] != M * D || out_size != M * D || ws_size < WS_END) { fprintf(stderr, "kernel_launch: unexpected shapes / workspace (n_in %d, ws %zu < %zu)\n", n_in, ws_size, (size_t)WS_END); grid = -1; return; }
        int dev = 0, cus = 0, per_cu = 0;
        hipGetDevice(&dev); hipDeviceGetAttribute(&cus, hipDeviceAttributeMultiprocessorCount, dev);
        if (hipFuncSetAttribute((const void*)mk_fwd, hipFuncAttributeMaxDynamicSharedMemorySize, LDS_BYTES) != hipSuccess) { fprintf(stderr, "kernel_launch: hipFuncSetAttribute failed\n"); grid = -1; return; }
        if (hipOccupancyMaxActiveBlocksPerMultiprocessor(&per_cu, (const void*)mk_fwd, 512, LDS_BYTES) != hipSuccess || per_cu < 1) { fprintf(stderr, "kernel_launch: occupancy query says %d\n", per_cu); per_cu = 1; }
        (void)hipGetLastError();
        grid = cus;
    }
    if (grid < 0) return;
    if (hipMemsetAsync(d_ws, 0, 16384, stream) != hipSuccess) { fprintf(stderr, "kernel_launch: memset of the barrier words failed\n"); return; }
    KP a{};
    for (int i = 0; i < 33; ++i) a.in[i] = (const float*)d_in[i];
    a.out = (float*)d_out; a.ws = (unsigned char*)d_ws;
#if MK_MULTI
    for (int ph = 0; ph < NPHASES; ++ph) { if (ph % NPH_LAYER == 3 || ph % NPH_LAYER == 10) continue; a.ph_lo = ph; a.ph_hi = ph + 1; hipLaunchKernelGGL(mk_fwd, dim3(grid), dim3(512), LDS_BYTES, stream, a); }
#else
    a.ph_lo = 0; a.ph_hi = NPHASES;
    void* args[] = {&a};
    hipError_t e = hipLaunchCooperativeKernel((const void*)mk_fwd, dim3(grid), dim3(512), args, LDS_BYTES, stream);
    if (e != hipSuccess) fprintf(stderr, "cooperative launch failed: %s (grid %d)\n", hipGetErrorString(e), grid);
#endif
}
```

```cpp
#include <hip/hip_runtime.h>
#include <hip/hip_cooperative_groups.h>
#include <cstdio>
#include <cstdint>
namespace cg = cooperative_groups;
#ifndef MK_MULTI
#define MK_MULTI 0
#endif
#ifndef MIXSEL
#define MIXSEL 7
#endif
namespace pg8 {
#define PG8_LAS __attribute__((address_space(3)))
typedef unsigned short bf16_t;
typedef short bf16x8 __attribute__((ext_vector_type(8)));
typedef float f32x4 __attribute__((ext_vector_type(4)));
typedef unsigned u32x4 __attribute__((ext_vector_type(4)));
constexpr int BM = 256, BK = 64, HALF = 128, HTB = HALF * BK * 2  , STAGE_BYTES = 8 * HTB, NXCD = 8, WGM = 8;

__host__ __device__ __forceinline__ int lds_byte(int r, int c) { const int st = (r >> 4) * 2 + (c >> 5), rr = r & 15, cc = c & 31, ob = rr * 64 + cc * 2; return st * 1024 + (ob ^ (((ob >> 9) & 1) << 5)); }
__host__ __device__ __forceinline__ void stage_rc(int b, int& R, int& C) { const int st = b / 1024, sb = b % 1024, swz = sb ^ (((sb >> 9) & 1) << 5); R = (st >> 1) * 16 + swz / 64; C = (st & 1) * 32 + (swz % 64) / 2; }
__host__ __device__ __forceinline__ int perm32(int rho) { const int n = rho >> 4, i = rho & 15; return 8 * (i >> 2) + 4 * n + (i & 3); }

struct Unit { int pm, pn; };
struct Gemm { const bf16_t* A; const bf16_t* Bt; int M, N, K; };

struct StaticOrder {
    int nM, nN, nwg, G, c;
    __host__ __device__ void init(int M, int N, int G_, int c_) { nM = M / BM; nN = N / BM; nwg = nM * nN; G = G_; c = c_; }
    __host__ __device__ bool next(int i, Unit& u) const {
        const long L = (long)i * G + c; if (L >= nwg) return false;
        int wgid = (int)L; { const int q = nwg / NXCD, r = nwg % NXCD, xcd = wgid % NXCD, off = wgid / NXCD; wgid = (xcd < r ? xcd * (q + 1) : r * (q + 1) + (xcd - r) * q) + off; }
        const int nig = WGM * nN, gid = wgid / nig, fm = gid * WGM, gsz = (nM - fm) < WGM ? (nM - fm) : WGM;
        u.pm = fm + ((wgid % nig) % gsz); u.pn = (wgid % nig) / gsz; return true;
    }
    __device__ __forceinline__ void a_ready(const Unit&) const {}
    __device__ __forceinline__ void done(const Unit&) const {}
};

typedef __bf16 bf16v2_t __attribute__((ext_vector_type(2)));
typedef float f32x2c_t __attribute__((ext_vector_type(2)));
__device__ __forceinline__ unsigned cvt_pk_bf16(float lo, float hi) { const bf16v2_t v = __builtin_convertvector((f32x2c_t){lo, hi}, bf16v2_t); return __builtin_bit_cast(unsigned, v); }
typedef float f32x2 __attribute__((ext_vector_type(2)));
typedef unsigned u32x2 __attribute__((ext_vector_type(2)));
__device__ __forceinline__ float fsilu(float x) { return x / (1.f + __expf(-x)); }
__device__ __forceinline__ float fsigmoid(float x) { return 1.f / (1.f + __expf(-x)); }
template <class Sched>
__device__ __forceinline__ void rstd_table(const Sched& S, const float* ssq, PG8_LAS float* rtab) {
    const int t = threadIdx.x, row = t >> 1, half = t & 1; unsigned done = 0u; Unit u;
    for (int i = 0; S.next(i, u); ++i) { const unsigned bit = 1u << (u.pm & 15); if (done & bit) continue; done |= bit;
        const f32x4* q = (const f32x4*)(ssq + (size_t)(u.pm * BM + row) * 32 + half * 16);
        f32x4 a = (q[0] + q[1]) + (q[2] + q[3]); float s = (a[0] + a[1]) + (a[2] + a[3]); s += __shfl_xor(s, 1);
        if (half == 0) rtab[(u.pm & 15) * 256 + row] = rsqrtf(s * (1.f / 2048.f) + 1e-6f); }
    __syncthreads();
}
struct EpiBf16 {
    static constexpr bool PERM = true, AFTER_DRAIN = false;
    bf16_t* O; int ldc; const PG8_LAS float* rtab;
    __device__ __forceinline__ void operator()(const f32x4 (&acc)[2][2][4][2], const Unit& u, int wr, int wc, int fr, int fq) const {
        const int row0 = u.pm * BM + wr * 64 + fr, col0 = u.pn * BM + wc * 32 + 8 * fq;
#pragma unroll
        for (int ai = 0; ai < 2; ++ai)
#pragma unroll
            for (int m = 0; m < 4; ++m) { bf16_t* rowp = O + (size_t)(row0 + ai * HALF + m * 16) * ldc + col0;
                const float rs = rtab[(u.pm & 15) * 256 + wr * 64 + fr + ai * HALF + m * 16];
#pragma unroll
                for (int bj = 0; bj < 2; ++bj) { const f32x4 v0 = acc[ai][bj][m][0] * rs, v1 = acc[ai][bj][m][1] * rs;
                    u32x4 w; w.x = cvt_pk_bf16(v0[0], v0[1]); w.y = cvt_pk_bf16(v0[2], v0[3]); w.z = cvt_pk_bf16(v1[0], v1[1]); w.w = cvt_pk_bf16(v1[2], v1[3]);
                    *(u32x4*)(rowp + bj * HALF) = w; } }
    }
};
struct EpiSwiGLU {
    static constexpr bool PERM = true, AFTER_DRAIN = false;
    bf16_t* O; int ldc; const PG8_LAS float* rtab;
    __device__ __forceinline__ void operator()(const f32x4 (&acc)[2][2][4][2], const Unit& u, int wr, int wc, int fr, int fq) const {
        const int row0 = u.pm * BM + wr * 64 + fr, col0 = u.pn * HALF + wc * 32 + 8 * fq;
#pragma unroll
        for (int ai = 0; ai < 2; ++ai)
#pragma unroll
            for (int m = 0; m < 4; ++m) { bf16_t* rowp = O + (size_t)(row0 + ai * HALF + m * 16) * ldc + col0;
                const float rs = rtab[(u.pm & 15) * 256 + wr * 64 + fr + ai * HALF + m * 16];
                const f32x4 g0 = acc[ai][0][m][0] * rs, g1 = acc[ai][0][m][1] * rs, u0 = acc[ai][1][m][0] * rs, u1 = acc[ai][1][m][1] * rs;
                u32x4 w; w.x = cvt_pk_bf16(fsilu(g0[0]) * u0[0], fsilu(g0[1]) * u0[1]); w.y = cvt_pk_bf16(fsilu(g0[2]) * u0[2], fsilu(g0[3]) * u0[3]);
                w.z = cvt_pk_bf16(fsilu(g1[0]) * u1[0], fsilu(g1[1]) * u1[1]); w.w = cvt_pk_bf16(fsilu(g1[2]) * u1[2], fsilu(g1[3]) * u1[3]);
                *(u32x4*)rowp = w; }
    }
};
struct EpiResid {
    static constexpr bool PERM = false, AFTER_DRAIN = false;
    const float* base; float* out; int ldc; float s;
    __device__ __forceinline__ void operator()(const f32x4 (&acc)[2][2][4][2], const Unit& u, int wr, int wc, int fr, int fq) const {
        const int row0 = u.pm * BM + wr * 64 + fr, col0 = u.pn * BM + wc * 32 + 4 * fq;
#pragma unroll
        for (int ai = 0; ai < 2; ++ai)
#pragma unroll
            for (int m = 0; m < 4; ++m) { const size_t off = (size_t)(row0 + ai * HALF + m * 16) * ldc + col0;
#pragma unroll
                for (int bj = 0; bj < 2; ++bj)
#pragma unroll
                    for (int n = 0; n < 2; ++n) { const f32x4 b = *(const f32x4*)(base + off + bj * HALF + n * 16);
                        *(f32x4*)(out + off + bj * HALF + n * 16) = b + acc[ai][bj][m][n] * s; } }
    }
};
struct EpiResidH {
    static constexpr bool PERM = false, AFTER_DRAIN = false;
    const float* basef; bf16_t* H; int ldc; float s; float* ssq;
    __device__ __forceinline__ void operator()(const f32x4 (&acc)[2][2][4][2], const Unit& u, int wr, int wc, int fr, int fq) const {
        const int row0 = u.pm * BM + wr * 64 + fr, col0 = u.pn * BM + wc * 32 + 4 * fq;
#pragma unroll
        for (int ai = 0; ai < 2; ++ai)
#pragma unroll
            for (int m = 0; m < 4; ++m) { const int row = row0 + ai * HALF + m * 16; const size_t off = (size_t)row * ldc + col0; float ss = 0.f;
#pragma unroll
                for (int bj = 0; bj < 2; ++bj)
#pragma unroll
                    for (int n = 0; n < 2; ++n) { const int co = bj * HALF + n * 16; f32x4 b;
                        if (basef) b = *(const f32x4*)(basef + off + co);
                        else { const u32x2 hb = *(const u32x2*)(H + off + co); b[0] = __uint_as_float(hb.x << 16); b[1] = __uint_as_float(hb.x & 0xffff0000u); b[2] = __uint_as_float(hb.y << 16); b[3] = __uint_as_float(hb.y & 0xffff0000u); }
                        const f32x4 o = b + acc[ai][bj][m][n] * s;
                        ss += (o[0] * o[0] + o[1] * o[1]) + (o[2] * o[2] + o[3] * o[3]);
                        u32x2 q; q.x = cvt_pk_bf16(o[0], o[1]); q.y = cvt_pk_bf16(o[2], o[3]);
                        *(u32x2*)(H + off + co) = q; }
                ss += __shfl_xor(ss, 16); ss += __shfl_xor(ss, 32);
                if (fq == 0) ssq[(size_t)row * 32 + u.pn * 4 + wc] = ss; }
    }
};
struct EpiResidOut {
    static constexpr bool PERM = false, AFTER_DRAIN = false;
    const bf16_t* H; float* out; int ldc; float s;
    __device__ __forceinline__ void operator()(const f32x4 (&acc)[2][2][4][2], const Unit& u, int wr, int wc, int fr, int fq) const {
        const int row0 = u.pm * BM + wr * 64 + fr, col0 = u.pn * BM + wc * 32 + 4 * fq;
#pragma unroll
        for (int ai = 0; ai < 2; ++ai)
#pragma unroll
            for (int m = 0; m < 4; ++m) { const size_t off = (size_t)(row0 + ai * HALF + m * 16) * ldc + col0;
#pragma unroll
                for (int bj = 0; bj < 2; ++bj)
#pragma unroll
                    for (int n = 0; n < 2; ++n) { const int co = bj * HALF + n * 16; const u32x2 hb = *(const u32x2*)(H + off + co);
                        f32x4 b; b[0] = __uint_as_float(hb.x << 16); b[1] = __uint_as_float(hb.x & 0xffff0000u); b[2] = __uint_as_float(hb.y << 16); b[3] = __uint_as_float(hb.y & 0xffff0000u);
                        *(f32x4*)(out + off + co) = b + acc[ai][bj][m][n] * s; } }
    }
};
struct EpiGlu {
    static constexpr bool PERM = true, AFTER_DRAIN = false;
    const bf16_t* G; int ldg; bf16_t* O; int ldo, ocol; const float* bias;
    __device__ __forceinline__ void operator()(const f32x4 (&acc)[2][2][4][2], const Unit& u, int wr, int wc, int fr, int fq) const {
        const int row0 = u.pm * BM + wr * 64 + fr, col0 = u.pn * BM + wc * 32 + 8 * fq;
#pragma unroll
        for (int ai = 0; ai < 2; ++ai)
#pragma unroll
            for (int m = 0; m < 4; ++m) { const int row = row0 + ai * HALF + m * 16;
#pragma unroll
                for (int bj = 0; bj < 2; ++bj) { const int c = col0 + bj * HALF;
                    const f32x4 b0 = *(const f32x4*)(bias + c), b1 = *(const f32x4*)(bias + c + 4);
                    const u32x4 gv = *(const u32x4*)(G + (size_t)row * ldg + c);
                    const f32x4 v0 = acc[ai][bj][m][0] + b0, v1 = acc[ai][bj][m][1] + b1;
                    float g[8]; g[0] = __uint_as_float(gv.x << 16); g[1] = __uint_as_float(gv.x & 0xffff0000u); g[2] = __uint_as_float(gv.y << 16); g[3] = __uint_as_float(gv.y & 0xffff0000u);
                    g[4] = __uint_as_float(gv.z << 16); g[5] = __uint_as_float(gv.z & 0xffff0000u); g[6] = __uint_as_float(gv.w << 16); g[7] = __uint_as_float(gv.w & 0xffff0000u);
                    u32x4 w; w.x = cvt_pk_bf16(g[0] * fsigmoid(v0[0]), g[1] * fsigmoid(v0[1])); w.y = cvt_pk_bf16(g[2] * fsigmoid(v0[2]), g[3] * fsigmoid(v0[3]));
                    w.z = cvt_pk_bf16(g[4] * fsigmoid(v1[0]), g[5] * fsigmoid(v1[1])); w.w = cvt_pk_bf16(g[6] * fsigmoid(v1[2]), g[7] * fsigmoid(v1[3]));
                    *(u32x4*)(O + (size_t)row * ldo + ocol + c) = w; } }
    }
};

template <int NM, int NN> struct FixedOrder {
    int G, c;
    __device__ __forceinline__ bool next(int i, Unit& u) const {
        constexpr int nwg = NM * NN, q = nwg / 8, r = nwg % 8, nig = 8 * NN;
        const int L = i * G + c; if (L >= nwg) return false;
        const int xcd = L & 7, off = L >> 3;
        const int wgid = (xcd < r ? xcd * (q + 1) : r * (q + 1) + (xcd - r) * q) + off;
        const int gid = wgid / nig, rem = wgid % nig;
        u.pm = gid * 8 + (rem & 7); u.pn = rem >> 3; return true;
    }
    __device__ __forceinline__ void a_ready(const Unit&) const {}
    __device__ __forceinline__ void done(const Unit&) const {}
};

template <class Epi, class Sched, bool ALIGN_EPI = false, bool SP2 = false>
__device__ __forceinline__ void gemm_phase(PG8_LAS unsigned char* lds, const Gemm g, const Sched& S, const Epi& E) {
    int tid_ = threadIdx.x; asm volatile("" : "+v"(tid_));
    const int tid = tid_, wid = __builtin_amdgcn_readfirstlane(tid >> 6), lane = tid & 63, wr = wid >> 2, wc = wid & 3, fr = lane & 15, fq = lane >> 4;
    const int K = g.K, nt = K / BK;
    unsigned voffA[2], voffB[2];
#pragma unroll
    for (int i = 0; i < 2; ++i) { int R, C; stage_rc(tid * 16 + i * 8192, R, C); const int Rb = Epi::PERM ? ((R & ~31) + perm32(R & 31)) : R;
        voffA[i] = (unsigned)(R * K + C) * 2u; voffB[i] = (unsigned)(Rb * K + C) * 2u; }
    const size_t kstep = (size_t)(BK * 2);
    const size_t hstep = (size_t)HALF * K * 2;
    const size_t tstep = 2 * hstep;
    const unsigned ldsw = (unsigned)wid * 1024u;
    const int aoff = lds_byte(wr * 64 + fr, fq * 8), boff = lds_byte(wc * 32 + fr, fq * 8);
#define PG8_SA(b, h) (((b) * 2 + (h)) * HTB)
#define PG8_SB(b, h) ((4 + (b) * 2 + (h)) * HTB)
#define PG8_STAGE(bufoff, gbase, voff) do { _Pragma("unroll") for (int _i = 0; _i < 2; ++_i) \
        __builtin_amdgcn_global_load_lds((const unsigned*)((const char*)(gbase) + (voff)[_i]), (PG8_LAS unsigned*)(lds + (bufoff) + ldsw + _i * 8192), 16, 0, 0); } while (0)
#define PG8_LDA(dst, b, h) do { _Pragma("unroll") for (int m = 0; m < 4; ++m) _Pragma("unroll") for (int k = 0; k < 2; ++k) dst[m][k] = *(const PG8_LAS bf16x8*)(lds + PG8_SA(b, h) + aoff + m * 2048 + k * 1024); } while (0)
#define PG8_LDB(dst, b, h) do { _Pragma("unroll") for (int n = 0; n < 2; ++n) _Pragma("unroll") for (int k = 0; k < 2; ++k) dst[n][k] = *(const PG8_LAS bf16x8*)(lds + PG8_SB(b, h) + boff + n * 2048 + k * 1024); } while (0)
#define PG8_MMA(ai, bj, At, Bt) do { __builtin_amdgcn_s_setprio(1); _Pragma("unroll") for (int m = 0; m < 4; ++m) _Pragma("unroll") for (int n = 0; n < 2; ++n) _Pragma("unroll") for (int k = 0; k < 2; ++k) \
        acc[ai][bj][m][n] = __builtin_amdgcn_mfma_f32_16x16x32_bf16(Bt[n][k], At[m][k], acc[ai][bj][m][n], 0, 0, 0); __builtin_amdgcn_s_setprio(0); } while (0)
#define PG8_WAIT_V(n) asm volatile("s_waitcnt vmcnt(" #n ")" ::: "memory")
#define PG8_WAIT_L(n) asm volatile("s_waitcnt lgkmcnt(" #n ")" ::: "memory")
#define PG8_BAR __builtin_amdgcn_s_barrier()
#define PG8_SCHED __builtin_amdgcn_sched_barrier(0)
    Unit cur, nxt; int ui = 0;
    if (!S.next(0, cur)) return;
    f32x4 acc[2][2][4][2];
#pragma unroll
    for (int a = 0; a < 2; ++a)
#pragma unroll
        for (int b = 0; b < 2; ++b)
#pragma unroll
            for (int m = 0; m < 4; ++m)
#pragma unroll
                for (int n = 0; n < 2; ++n) acc[a][b][m][n] = (f32x4){0.f, 0.f, 0.f, 0.f};
    bf16x8 At[4][2], B0[2][2], B1[2][2];
    const char* cA = (const char*)g.A + (size_t)cur.pm * tstep; const char* cB = (const char*)g.Bt + (size_t)cur.pn * tstep;
    S.a_ready(cur);
    if constexpr (SP2) {
        PG8_STAGE(PG8_SB(0, 0), cB, voffB); PG8_STAGE(PG8_SB(0, 1), cB + hstep, voffB); PG8_STAGE(PG8_SA(0, 0), cA, voffA); PG8_STAGE(PG8_SA(0, 1), cA + hstep, voffA);
        if (wr == 1) PG8_BAR;
        PG8_WAIT_V(2); PG8_BAR;
        PG8_STAGE(PG8_SB(1, 0), cB + kstep, voffB); PG8_STAGE(PG8_SA(1, 0), cA + kstep, voffA); PG8_STAGE(PG8_SB(1, 1), cB + hstep + kstep, voffB);
        PG8_WAIT_V(6); PG8_BAR;
    } else {
        PG8_STAGE(PG8_SB(0, 0), cB, voffB); PG8_STAGE(PG8_SA(0, 0), cA, voffA); PG8_STAGE(PG8_SB(0, 1), cB + hstep, voffB); PG8_STAGE(PG8_SA(0, 1), cA + hstep, voffA);
        if (wr == 1) PG8_BAR;
        PG8_WAIT_V(4); PG8_BAR;
        PG8_STAGE(PG8_SB(1, 0), cB + kstep, voffB); PG8_STAGE(PG8_SA(1, 0), cA + kstep, voffA); PG8_STAGE(PG8_SB(1, 1), cB + hstep + kstep, voffB);
        PG8_WAIT_V(6); PG8_BAR;
    }
    for (;;) {
        const bool has_next = S.next(ui + 1, nxt);
        const char* nA = has_next ? (const char*)g.A + (size_t)nxt.pm * tstep : cA; const char* nB = has_next ? (const char*)g.Bt + (size_t)nxt.pn * tstep : cB;
        for (int t = 0; t < nt; t += 2) {
            const bool last = (t == nt - 2);
            const char* a1 = cA + (size_t)(t + 1) * kstep;
            const char* a2 = last ? nA : cA + (size_t)(t + 2) * kstep; const char* b2 = last ? nB : cB + (size_t)(t + 2) * kstep;
            const char* a3 = a2 + kstep; const char* b3 = b2 + kstep;
            if (last && has_next) S.a_ready(nxt);
            if constexpr (SP2) {
            PG8_LDB(B0, 0, 0); PG8_LDB(B1, 0, 1); PG8_SCHED; PG8_LDA(At, 0, 0); PG8_STAGE(PG8_SA(1, 1), a1 + hstep, voffA);
            PG8_WAIT_V(8); PG8_WAIT_L(0); PG8_BAR; PG8_MMA(0, 0, At, B0); PG8_MMA(0, 1, At, B1); PG8_BAR; PG8_SCHED;
            PG8_LDA(At, 0, 1); PG8_STAGE(PG8_SB(0, 0), b2, voffB); PG8_STAGE(PG8_SB(0, 1), b2 + hstep, voffB); PG8_STAGE(PG8_SA(0, 0), a2, voffA);
            PG8_WAIT_V(8); PG8_WAIT_L(0); PG8_BAR; PG8_MMA(1, 0, At, B0); PG8_MMA(1, 1, At, B1); PG8_BAR; PG8_SCHED;
            PG8_LDB(B0, 1, 0); PG8_LDB(B1, 1, 1); PG8_SCHED; PG8_LDA(At, 1, 0); PG8_STAGE(PG8_SA(0, 1), a2 + hstep, voffA);
            PG8_WAIT_V(8); PG8_WAIT_L(0); PG8_BAR; PG8_MMA(0, 0, At, B0); PG8_MMA(0, 1, At, B1); PG8_BAR; PG8_SCHED;
            PG8_LDA(At, 1, 1); PG8_STAGE(PG8_SB(1, 0), b3, voffB); PG8_STAGE(PG8_SB(1, 1), b3 + hstep, voffB); PG8_STAGE(PG8_SA(1, 0), a3, voffA);
            PG8_WAIT_V(8); PG8_WAIT_L(0); PG8_BAR; PG8_MMA(1, 0, At, B0); PG8_MMA(1, 1, At, B1); PG8_BAR; PG8_SCHED;
            } else {
            PG8_LDB(B0, 0, 0); PG8_SCHED; PG8_LDA(At, 0, 0); PG8_STAGE(PG8_SA(1, 1), a1 + hstep, voffA);
            PG8_WAIT_L(8); PG8_BAR; PG8_WAIT_L(0); PG8_MMA(0, 0, At, B0); PG8_BAR; PG8_SCHED;
            PG8_LDB(B1, 0, 1); PG8_STAGE(PG8_SB(0, 0), b2, voffB);
            PG8_BAR; PG8_WAIT_L(0); PG8_MMA(0, 1, At, B1); PG8_BAR;
            PG8_LDA(At, 0, 1); PG8_STAGE(PG8_SA(0, 0), a2, voffA);
            PG8_BAR; PG8_WAIT_L(0); PG8_MMA(1, 0, At, B0); PG8_BAR; PG8_SCHED;
            PG8_STAGE(PG8_SB(0, 1), b2 + hstep, voffB);
            PG8_WAIT_V(6); PG8_BAR; PG8_MMA(1, 1, At, B1); PG8_BAR;
            PG8_LDB(B0, 1, 0); PG8_SCHED; PG8_LDA(At, 1, 0); PG8_STAGE(PG8_SA(0, 1), a2 + hstep, voffA);
            PG8_WAIT_L(8); PG8_BAR; PG8_WAIT_L(0); PG8_MMA(0, 0, At, B0); PG8_BAR; PG8_SCHED;
            PG8_LDB(B1, 1, 1); PG8_STAGE(PG8_SB(1, 0), b3, voffB);
            PG8_BAR; PG8_WAIT_L(0); PG8_MMA(0, 1, At, B1); PG8_BAR;
            PG8_LDA(At, 1, 1); PG8_STAGE(PG8_SA(1, 0), a3, voffA);
            PG8_BAR; PG8_WAIT_L(0); PG8_MMA(1, 0, At, B0); PG8_BAR; PG8_SCHED;
            PG8_STAGE(PG8_SB(1, 1), b3 + hstep, voffB);
            PG8_WAIT_V(6); PG8_BAR; PG8_MMA(1, 1, At, B1); PG8_BAR;
            }
        }
        if constexpr (ALIGN_EPI) { if (wr == 0) PG8_BAR; }
        if constexpr (!Epi::AFTER_DRAIN) { E(acc, cur, wr, wc, fr, fq); S.done(cur); }
        if (!has_next) break;
#pragma unroll
        for (int a = 0; a < 2; ++a)
#pragma unroll
            for (int b = 0; b < 2; ++b)
#pragma unroll
                for (int m = 0; m < 4; ++m)
#pragma unroll
                    for (int n = 0; n < 2; ++n) acc[a][b][m][n] = (f32x4){0.f, 0.f, 0.f, 0.f};
        cur = nxt; cA = nA; cB = nB; ++ui;
        if constexpr (ALIGN_EPI) { if (wr == 1) PG8_BAR; }
    }
    PG8_WAIT_V(0);
    if constexpr (!ALIGN_EPI) { if (wr == 0) PG8_BAR; }
    PG8_BAR;
    if constexpr (Epi::AFTER_DRAIN) { E.fused(acc, cur, wr, wc, fr, fq, lds, wid, lane); S.done(cur); }
#undef PG8_SA
#undef PG8_SB
#undef PG8_STAGE
#undef PG8_LDA
#undef PG8_LDB
#undef PG8_MMA
#undef PG8_WAIT_V
#undef PG8_WAIT_L
#undef PG8_BAR
#undef PG8_SCHED
}
}

#define LAS __attribute__((address_space(3)))
typedef unsigned short bf16_t;
typedef short bf16x8 __attribute__((ext_vector_type(8)));
typedef float f32x4 __attribute__((ext_vector_type(4)));
typedef float f32x2 __attribute__((ext_vector_type(2)));
typedef unsigned u32x4 __attribute__((ext_vector_type(4)));
typedef unsigned u32x2 __attribute__((ext_vector_type(2)));

constexpr int M = 16384, D = 2048, FF = 5632, SEQ = 2048, NBATCH = 8, NCH = 32, CH = 64;
constexpr int PIN = 5656, PINP = 5888;
constexpr int PQ = 0, PK = 768, PV = 1536, PZ = 2304;
constexpr int PSZ = 3072, PSX = 3840, PSB = 4608, PSC = 4864;
constexpr int PU = 5120;
constexpr int PGB = 5632, PGA = 5638, PSDT = 5648;
constexpr float EPS = 1e-6f;
constexpr size_t MiB = 1u << 20;
constexpr size_t WS_CTL = 0, WS_GL = 64 * 1024, WS_CD = 128 * 1024;
constexpr size_t WS_WGU1 = 1 * MiB, WS_WD1 = 45 * MiB, WS_WIN = 67 * MiB, WS_WGLU = 90 * MiB, WS_WOUT = 91 * MiB, WS_WGU2 = 99 * MiB, WS_WD2 = 143 * MiB;
constexpr size_t WS_XN = 166 * MiB;
constexpr size_t WS_AP = 230 * MiB;
constexpr size_t WS_MIX = 414 * MiB;
constexpr size_t WS_GT = 478 * MiB;
constexpr size_t WS_GO = 586 * MiB;
constexpr size_t WS_ST = 610 * MiB;
constexpr size_t WS_G5 = 658 * MiB;
constexpr size_t WS_E5 = 674 * MiB;
constexpr size_t WS_SSQ = 678 * MiB;
constexpr size_t WS_H = 690 * MiB;
constexpr size_t WS_END = 754 * MiB;
constexpr int GT_UNIT = 73728, GT_U = 0, GT_W = 16384, GT_QD = 32768, GT_KDT = 49152, GT_ATT = 65536;
constexpr int LDS_BYTES = 155648;

__device__ __forceinline__ float bf2f(unsigned v) { return __uint_as_float(v << 16); }
__device__ __forceinline__ unsigned f2bf(float f) { unsigned u = __float_as_uint(f); return (u + 0x7fffu + ((u >> 16) & 1u)) >> 16; }
__device__ __forceinline__ unsigned pk2(float lo, float hi) { return pg8::cvt_pk_bf16(lo, hi); }
__device__ __forceinline__ float fsilu(float x) { return x / (1.f + __expf(-x)); }
__device__ __forceinline__ float fsigmoid(float x) { return 1.f / (1.f + __expf(-x)); }
__device__ __forceinline__ float fsoftplus(float x) { return x > 20.f ? x : log1pf(expf(x)); }
__device__ __forceinline__ void unpack8(const u32x4 v, float* f) {
    f[0] = __uint_as_float(v.x << 16); f[1] = __uint_as_float(v.x & 0xffff0000u); f[2] = __uint_as_float(v.y << 16); f[3] = __uint_as_float(v.y & 0xffff0000u);
    f[4] = __uint_as_float(v.z << 16); f[5] = __uint_as_float(v.z & 0xffff0000u); f[6] = __uint_as_float(v.w << 16); f[7] = __uint_as_float(v.w & 0xffff0000u); }
__device__ __forceinline__ float wave_sum(float v) {
#pragma unroll
    for (int o = 1; o < 64; o <<= 1) v += __shfl_xor(v, o);
    return v;
}
__device__ __forceinline__ float wave_incl_scan(float v, int lane) {
#pragma unroll
    for (int o = 1; o < 64; o <<= 1) { const float t = __shfl_up(v, o); if (lane >= o) v += t; }
    return v;
}
__device__ __forceinline__ f32x4 mm16(const LAS bf16_t* X, int ldx, const LAS bf16_t* Y, int ldy, int K, f32x4 acc, int fr, int fq) {
    const LAS bf16_t* xp = X + fr * ldx + fq * 8; const LAS bf16_t* yp = Y + fr * ldy + fq * 8;
#if defined(MM16_NAIVE)
    for (int k = 0; k < K; ++k) { const float xv = bf2f(X[fr * ldx + k]);
#pragma unroll
        for (int j = 0; j < 4; ++j) acc[j] += xv * bf2f(Y[(4 * fq + j) * ldy + k]); }
    (void)xp; (void)yp;
#else
    for (int k = 0; k < K; k += 32) { const bf16x8 x = *(const LAS bf16x8*)(xp + k); const bf16x8 y = *(const LAS bf16x8*)(yp + k);
        acc = __builtin_amdgcn_mfma_f32_16x16x32_bf16(y, x, acc, 0, 0, 0);
        asm volatile("" :: "v"(x), "v"(y)); }
#endif
    return acc;
}
#define WG_SYNC() do { asm volatile("s_waitcnt lgkmcnt(0)" ::: "memory"); __builtin_amdgcn_s_barrier(); asm volatile("" ::: "memory"); } while (0)

struct KP { const float* in[33]; float* out; unsigned char* ws; int ph_lo, ph_hi; };
#define AS4 __attribute__((address_space(4)))
struct KPV {
    const AS4 KP* k;
    __device__ __forceinline__ const float* in(int i) const { return k->in[i]; }
    __device__ __forceinline__ unsigned char* ws() const { return k->ws; }
    __device__ __forceinline__ float* out() const { return k->out; }
};

__device__ __forceinline__ int map_row(int mode, int n) {
    if (mode == 0) return n;
    if (mode == 1) return ((n >> 7) << 8) + (n & 127);
    if (mode == 2) return ((n >> 7) << 8) + 128 + (n & 127);
    if (n < 3072) return n;
    if (n < 3084) return PGB + (n - 3072);
    if (n < 5132) return 3072 + (n - 3084);
    if (n < 5144) return PSDT + (n - 5132);
    return PU + (n - 5144);
}
__device__ __forceinline__ void transpose_item(const float* W, int K, int N, bf16_t* WT, int mode, LAS float* scr, int item, int lane, const float* nw = nullptr) {
    const int nblk = (N + 31) / 32, kb = item / nblk, nb = item % nblk, k0 = 64 * kb, n0 = 32 * nb;
    const int nn = n0 + (lane & 31); const bool ok = nn < N;
    float wv[32];
#pragma unroll
    for (int i = 0; i < 32; ++i) { const int kk = 2 * i + (lane >> 5); wv[i] = ok ? __builtin_nontemporal_load(W + (size_t)(k0 + kk) * N + nn) : 0.f; }
#pragma unroll
    for (int i = 0; i < 32; ++i) { const int kk = 2 * i + (lane >> 5); scr[kk * 33 + (lane & 31)] = nw ? wv[i] * nw[k0 + kk] : wv[i]; }
    asm volatile("s_waitcnt lgkmcnt(0)" ::: "memory"); __builtin_amdgcn_wave_barrier();
    const int c = lane & 7;
#pragma unroll
    for (int j = 0; j < 4; ++j) { const int n = (lane >> 3) + 8 * j; const LAS float* s = scr + (8 * c) * 33 + n;
        u32x4 o; o.x = pk2(s[0 * 33], s[1 * 33]); o.y = pk2(s[2 * 33], s[3 * 33]); o.z = pk2(s[4 * 33], s[5 * 33]); o.w = pk2(s[6 * 33], s[7 * 33]);
        if (n0 + n < N) *(u32x4*)(WT + (size_t)map_row(mode, n0 + n) * K + k0 + 8 * c) = o; }
    asm volatile("s_waitcnt lgkmcnt(0)" ::: "memory"); __builtin_amdgcn_wave_barrier();
}
__device__ __forceinline__ void convert_phase(const KPV& p, int layer, LAS unsigned char* lds, int gw, int NGW, int wave, int lane) {
    LAS float* scr = (LAS float*)(lds + wave * 16384);
    unsigned char* ws = p.ws();
    constexpr int I_GU = (D / 64) * (FF / 32), I_DN = (FF / 64) * (D / 32), I_IN = (D / 64) * ((PIN + 31) / 32), I_GLU = (512 / 64) * (512 / 32), I_OUT = (D / 64) * (D / 32);
    constexpr int NITEMS = 4 * I_GU + 2 * I_DN + I_IN + I_GLU + I_OUT;
    for (int it = gw; it < NITEMS; it += NGW) {
        int r = it;
        if (r < I_GU) { transpose_item(p.in(2) + (size_t)layer * D * FF, D, FF, (bf16_t*)(ws + WS_WGU1), 1, scr, r, lane, p.in(1) + layer * D); continue; } r -= I_GU;
        if (r < I_GU) { transpose_item(p.in(3) + (size_t)layer * D * FF, D, FF, (bf16_t*)(ws + WS_WGU1), 2, scr, r, lane, p.in(1) + layer * D); continue; } r -= I_GU;
        if (r < I_DN) { transpose_item(p.in(4) + (size_t)layer * D * FF, FF, D, (bf16_t*)(ws + WS_WD1), 0, scr, r, lane); continue; } r -= I_DN;
        if (r < I_IN) { transpose_item(p.in(6) + (size_t)layer * D * PIN, D, PIN, (bf16_t*)(ws + WS_WIN), 3, scr, r, lane, p.in(5) + layer * D); continue; } r -= I_IN;
        if (r < I_GLU) { transpose_item(p.in(25) + (size_t)layer * 512 * 512, 512, 512, (bf16_t*)(ws + WS_WGLU), 0, scr, r, lane); continue; } r -= I_GLU;
        if (r < I_OUT) { transpose_item(p.in(27) + (size_t)layer * D * D, D, D, (bf16_t*)(ws + WS_WOUT), 0, scr, r, lane); continue; } r -= I_OUT;
        if (r < I_GU) { transpose_item(p.in(29) + (size_t)layer * D * FF, D, FF, (bf16_t*)(ws + WS_WGU2), 1, scr, r, lane, p.in(28) + layer * D); continue; } r -= I_GU;
        if (r < I_GU) { transpose_item(p.in(30) + (size_t)layer * D * FF, D, FF, (bf16_t*)(ws + WS_WGU2), 2, scr, r, lane, p.in(28) + layer * D); continue; } r -= I_GU;
        transpose_item(p.in(31) + (size_t)layer * D * FF, FF, D, (bf16_t*)(ws + WS_WD2), 0, scr, r, lane);
    }
}
__device__ __forceinline__ void norm_raw_phase(const float* h, const float* w, bf16_t* xn, float* ssq, int gw, int NGW, int lane) {
    for (int row = gw; row < M; row += NGW) {
        const f32x4* xr = (const f32x4*)(h + (size_t)row * D) + lane; float s = 0.f;
#pragma unroll
        for (int j = 0; j < 8; ++j) { const f32x4 v = xr[64 * j]; s += (v.x * v.x + v.y * v.y) + (v.z * v.z + v.w * v.w);
            u32x2 q; q.x = pk2(v.x, v.y); q.y = pk2(v.z, v.w);
            *((u32x2*)(xn + (size_t)row * D) + lane + 64 * j) = q; }
        s = wave_sum(s); if (lane < 32) ssq[(size_t)row * 32 + lane] = (lane == 0) ? s : 0.f;
    }
}
template <bool FINAL>
__device__ __forceinline__ void norm_phase(const float* h, const float* w, bf16_t* xn, float* fout, int gw, int NGW, int lane) {
    for (int row = gw; row < M; row += NGW) {
        const f32x4* xr = (const f32x4*)(h + (size_t)row * D) + lane;
        f32x4 v[8]; float s = 0.f;
#pragma unroll
        for (int j = 0; j < 8; ++j) { v[j] = xr[64 * j]; s += (v[j].x * v[j].x + v[j].y * v[j].y) + (v[j].z * v[j].z + v[j].w * v[j].w); }
        const float rstd = rsqrtf(wave_sum(s) * (1.f / D) + EPS);
#pragma unroll
        for (int j = 0; j < 8; ++j) { const f32x4 wv = *((const f32x4*)w + lane + 64 * j); const f32x4 o = v[j] * rstd * wv;
            if (FINAL) *((f32x4*)(fout + (size_t)row * D) + lane + 64 * j) = o;
            else { u32x2 q; q.x = pk2(o.x, o.y); q.y = pk2(o.z, o.w); *((u32x2*)(xn + (size_t)row * D) + lane + 64 * j) = q; } }
    }
}

constexpr int G_RAW = 0;
constexpr int G_LF = 0, G_TS = 17408, G_TF = 26624;
constexpr int G_QS = 51456, G_KS = 68864, G_KDT = 86272, G_VBT = 104704, G_KGT = 123136, G_GATE = 141568;
struct S5Par;
__device__ __forceinline__ void s5_shadow_unit(const KPV& p, int layer, int wu, LAS unsigned char* wl, int lane);
__device__ __forceinline__ void gdn_pre_unit(const KPV& p, int layer, int unit, LAS unsigned char* lds, int tid, int wave, int lane, int s5_wu = -1) {
    asm volatile("" : "+v"(tid)); lane = tid & 63;
    const int b = unit / (6 * NCH), h = (unit / NCH) % 6, n = unit % NCH;
    const int tok0 = b * SEQ + n * CH;
    const bf16_t* proj = (const bf16_t*)(p.ws() + WS_AP);
    unsigned char* gt = p.ws() + WS_GT + (size_t)unit * GT_UNIT;
    LAS bf16_t* raw = (LAS bf16_t*)(lds + G_RAW);
    LAS float* Gs = (LAS float*)(lds + G_GATE); LAS float* Bt = Gs + 64;
    { u32x4 rv[7];
#pragma unroll
      for (int k = 0; k < 7; ++k) { const int c = tid + 512 * k, part = c / (67 * 16), rc = c % (67 * 16), r = rc >> 4, ch = rc & 15;
          rv[k] = (u32x4){0u, 0u, 0u, 0u};
          if (c < 3 * 67 * 16 && (n > 0 || r >= 3)) rv[k] = *(const u32x4*)(proj + (size_t)(tok0 + r - 3) * PINP + part * 768 + h * 128 + ch * 8); }
#pragma unroll
      for (int k = 0; k < 7; ++k) { const int c = tid + 512 * k, part = c / (67 * 16), rc = c % (67 * 16), r = rc >> 4, ch = rc & 15;
          if (c < 3 * 67 * 16) *(LAS u32x4*)(raw + (part * 67 + r) * 128 + ch * 8) = rv[k]; } }
    if (wave == 0) { const size_t ro = (size_t)(tok0 + lane) * PINP;
        const float braw = bf2f(proj[ro + PGB + h]), araw = bf2f(proj[ro + PGA + h]);
        const float g = -expf(p.in(8)[layer * 6 + h]) * fsoftplus(araw + p.in(9)[layer * 6 + h]);
        Gs[lane] = wave_incl_scan(g, lane); Bt[lane] = 1.f / (1.f + expf(-braw)); }
    WG_SYNC();
    { const int tok = tid >> 3, sub = tid & 7, c0 = sub * 16;
      const float* cw = p.in(7) + (size_t)layer * 4 * 2304 + h * 128 + c0;
      const float G = Gs[tok], beta = Bt[tok], Glast = Gs[63];
      const float eG = expf(G), eGl = expf(Glast - G);
      LAS bf16_t* Qs = (LAS bf16_t*)(lds + G_QS); LAS bf16_t* Ks = (LAS bf16_t*)(lds + G_KS);
      LAS bf16_t* KdT = (LAS bf16_t*)(lds + G_KDT); LAS bf16_t* VbT = (LAS bf16_t*)(lds + G_VBT); LAS bf16_t* KgT = (LAS bf16_t*)(lds + G_KGT);
#pragma unroll 1
      for (int part = 0; part < 3; ++part) {
          float acc[16];
#pragma unroll
          for (int i = 0; i < 16; ++i) acc[i] = 0.f;
#pragma unroll
          for (int tap = 0; tap < 4; ++tap) {
              const LAS bf16_t* rp = raw + (part * 67 + tok + tap) * 128 + c0;
              float x[16]; unpack8(*(const LAS u32x4*)rp, x); unpack8(*(const LAS u32x4*)(rp + 8), x + 8);
              const float* wp = cw + tap * 2304 + part * 768;
#pragma unroll
              for (int i4 = 0; i4 < 4; ++i4) { const f32x4 wv = *(const f32x4*)(wp + 4 * i4);
                  acc[4 * i4 + 0] += wv.x * x[4 * i4 + 0]; acc[4 * i4 + 1] += wv.y * x[4 * i4 + 1]; acc[4 * i4 + 2] += wv.z * x[4 * i4 + 2]; acc[4 * i4 + 3] += wv.w * x[4 * i4 + 3]; }
          }
          float ss = 0.f;
#pragma unroll
          for (int i = 0; i < 16; ++i) { acc[i] = fsilu(acc[i]); ss += acc[i] * acc[i]; }
          ss += __shfl_xor(ss, 1); ss += __shfl_xor(ss, 2); ss += __shfl_xor(ss, 4);
          const float r = (part == 2) ? 1.f : rsqrtf(ss + EPS) * (part == 0 ? 0.08838834764831845f : 1.f);
#pragma unroll
          for (int i = 0; i < 16; ++i) acc[i] *= r;
          u32x4 a, c;
          a.x = pk2(acc[0], acc[1]); a.y = pk2(acc[2], acc[3]); a.z = pk2(acc[4], acc[5]); a.w = pk2(acc[6], acc[7]);
          c.x = pk2(acc[8], acc[9]); c.y = pk2(acc[10], acc[11]); c.z = pk2(acc[12], acc[13]); c.w = pk2(acc[14], acc[15]);
          if (part == 0) {
              *(LAS u32x4*)(Qs + tok * 136 + c0) = a; *(LAS u32x4*)(Qs + tok * 136 + c0 + 8) = c;
              a.x = pk2(acc[0] * eG, acc[1] * eG); a.y = pk2(acc[2] * eG, acc[3] * eG); a.z = pk2(acc[4] * eG, acc[5] * eG); a.w = pk2(acc[6] * eG, acc[7] * eG);
              c.x = pk2(acc[8] * eG, acc[9] * eG); c.y = pk2(acc[10] * eG, acc[11] * eG); c.z = pk2(acc[12] * eG, acc[13] * eG); c.w = pk2(acc[14] * eG, acc[15] * eG);
              bf16_t* qd = (bf16_t*)(gt + GT_QD) + tok * 128 + c0; *(u32x4*)qd = a; *(u32x4*)(qd + 8) = c;
          } else if (part == 1) {
              *(LAS u32x4*)(Ks + tok * 136 + c0) = a; *(LAS u32x4*)(Ks + tok * 136 + c0 + 8) = c;
              const float kbg = beta * eG;
#pragma unroll
              for (int i = 0; i < 16; ++i) { KdT[(c0 + i) * 72 + tok] = (bf16_t)f2bf(acc[i] * eGl); KgT[(c0 + i) * 72 + tok] = (bf16_t)f2bf(acc[i] * kbg); }
          } else {
#pragma unroll
              for (int i = 0; i < 16; ++i) VbT[(c0 + i) * 72 + tok] = (bf16_t)f2bf(acc[i] * beta);
          }
      }
    }
    WG_SYNC();
    { LAS float* Lf = (LAS float*)(lds + G_LF);
      const LAS bf16_t* Qs = (const LAS bf16_t*)(lds + G_QS); const LAS bf16_t* Ks = (const LAS bf16_t*)(lds + G_KS);
      const int fr = lane & 15, fq = lane >> 4;
      for (int job = wave * 4; job < wave * 4 + 4; ++job) { const int mat = job >> 4, ti = (job >> 2) & 3, tj = job & 3;
          f32x4 acc = (f32x4){0.f, 0.f, 0.f, 0.f};
          acc = mm16((mat == 0 ? Ks : Qs) + ti * 16 * 136, 136, Ks + tj * 16 * 136, 136, 128, acc, fr, fq);
          const int i = ti * 16 + fr, j0 = tj * 16 + 4 * fq; const float Gi = Gs[i], bi = Bt[i];
          float o[4];
#pragma unroll
          for (int jj = 0; jj < 4; ++jj) { const int j = j0 + jj; const float dec = (i >= j) ? expf(Gi - Gs[j]) : 0.f;
              o[jj] = (mat == 0) ? ((i > j) ? acc[jj] * bi * dec : 0.f) : acc[jj] * dec; }
          if (mat == 0) { Lf[(j0 + 0) * 68 + i] = o[0]; Lf[(j0 + 1) * 68 + i] = o[1]; Lf[(j0 + 2) * 68 + i] = o[2]; Lf[(j0 + 3) * 68 + i] = o[3]; }
          else { u32x2 w; w.x = pk2(o[0], o[1]); w.y = pk2(o[2], o[3]); *(u32x2*)((bf16_t*)(gt + GT_ATT) + i * 64 + j0) = w; } }
    }
    WG_SYNC();
    if (wave == 0) { const LAS float* LfT = (const LAS float*)(lds + G_LF); LAS bf16_t* Ts = (LAS bf16_t*)(lds + G_TS); LAS float* Tf = (LAS float*)(lds + G_TF);
#pragma unroll 1
        for (int I = 0; I < 4; ++I) { float s[16];
#pragma unroll
            for (int ii = 0; ii < 16; ++ii) s[ii] = (16 * I + ii == lane) ? 1.f : 0.f;
#pragma unroll 2
            for (int j = 0; j < 16 * I; ++j) { const float tj = Tf[j * 64 + lane]; const LAS f32x4* lc = (const LAS f32x4*)(LfT + j * 68 + 16 * I);
#pragma unroll
                for (int q = 0; q < 4; ++q) { const f32x4 l = lc[q]; s[4 * q + 0] -= l.x * tj; s[4 * q + 1] -= l.y * tj; s[4 * q + 2] -= l.z * tj; s[4 * q + 3] -= l.w * tj; } }
#pragma unroll
            for (int jj = 0; jj < 16; ++jj) { const float t = s[jj]; Tf[(16 * I + jj) * 64 + lane] = t; Ts[(16 * I + jj) * 72 + lane] = (bf16_t)f2bf(t);
                const LAS f32x4* lc = (const LAS f32x4*)(LfT + (16 * I + jj) * 68 + 16 * I);
#pragma unroll
                for (int q = 0; q < 4; ++q) { if (4 * q + 3 > jj) { const f32x4 l = lc[q];
                    if (4 * q + 0 > jj) s[4 * q + 0] -= l.x * t; if (4 * q + 1 > jj) s[4 * q + 1] -= l.y * t; if (4 * q + 2 > jj) s[4 * q + 2] -= l.z * t; if (4 * q + 3 > jj) s[4 * q + 3] -= l.w * t; } } }
        }
        if (lane == 0) ((float*)(p.ws() + WS_GL))[unit] = expf(Gs[63]);
    } else { const LAS bf16_t* KdT = (const LAS bf16_t*)(lds + G_KDT);
        for (int c = tid - 64; c < 128 * 8; c += 448) { const int r = c >> 3, ch = c & 7; *(u32x4*)((bf16_t*)(gt + GT_KDT) + r * 64 + ch * 8) = *(const LAS u32x4*)(KdT + r * 72 + ch * 8); }
        if (s5_wu >= 0) s5_shadow_unit(p, layer, s5_wu, lds + G_QS + (wave - 1) * 4096, lane); }
    WG_SYNC();
    asm volatile("" : "+v"(tid)); lane = tid & 63;
    { const LAS bf16_t* Ts = (const LAS bf16_t*)(lds + G_TS); const LAS bf16_t* VbT = (const LAS bf16_t*)(lds + G_VBT); const LAS bf16_t* KgT = (const LAS bf16_t*)(lds + G_KGT);
      const int fr = lane & 15, fq = lane >> 4;
      for (int job = wave * 8; job < wave * 8 + 8; ++job) { const int mat = job >> 5, ti = (job >> 3) & 3, te = job & 7;
          f32x4 acc = (f32x4){0.f, 0.f, 0.f, 0.f};
          acc = mm16(Ts + ti * 16 * 72, 72, (mat == 0 ? VbT : KgT) + te * 16 * 72, 72, 64, acc, fr, fq);
          u32x2 w; w.x = pk2(acc[0], acc[1]); w.y = pk2(acc[2], acc[3]);
          *(u32x2*)((bf16_t*)(gt + (mat == 0 ? GT_U : GT_W)) + (ti * 16 + fr) * 128 + te * 16 + 4 * fq) = w; }
    }
    WG_SYNC();
}

constexpr int GS_BUF = 66560;
constexpr int GS_WB = 0, GS_QB = 17408, GS_KT = 34816, GS_AT = 53248, GS_UB = 62464;
constexpr int GS_ST = 2 * GS_BUF, GS_VNT = GS_ST + 8704;
__device__ __forceinline__ void gs_load(const unsigned char* gt, int es, int tid, u32x4 (&v)[8]) {
#pragma unroll
    for (int k = 0; k < 8; ++k) { const int c = tid + 512 * k; const bf16_t* src;
        if (k < 2) src = (const bf16_t*)(gt + GT_W) + (c >> 4) * 128 + (c & 15) * 8;
        else if (k < 4) { const int c2 = c - 1024; src = (const bf16_t*)(gt + GT_QD) + (c2 >> 4) * 128 + (c2 & 15) * 8; }
        else if (k < 6) { const int c2 = c - 2048; src = (const bf16_t*)(gt + GT_KDT) + (c2 >> 3) * 64 + (c2 & 7) * 8; }
        else if (k < 7) { const int c2 = c - 3072; src = (const bf16_t*)(gt + GT_ATT) + (c2 >> 3) * 64 + (c2 & 7) * 8; }
        else { const int c2 = (c - 3584) & 255; src = (const bf16_t*)(gt + GT_U) + (c2 >> 2) * 128 + es * 32 + (c2 & 3) * 8; }
        v[k] = *(const u32x4*)src; }
}
__device__ __forceinline__ void gs_store(LAS unsigned char* buf, int tid, const u32x4 (&v)[8]) {
#pragma unroll
    for (int k = 0; k < 8; ++k) { const int c = tid + 512 * k; LAS bf16_t* dst;
        if (k < 2) dst = (LAS bf16_t*)(buf + GS_WB) + (c >> 4) * 136 + (c & 15) * 8;
        else if (k < 4) { const int c2 = c - 1024; dst = (LAS bf16_t*)(buf + GS_QB) + (c2 >> 4) * 136 + (c2 & 15) * 8; }
        else if (k < 6) { const int c2 = c - 2048; dst = (LAS bf16_t*)(buf + GS_KT) + (c2 >> 3) * 72 + (c2 & 7) * 8; }
        else if (k < 7) { const int c2 = c - 3072; dst = (LAS bf16_t*)(buf + GS_AT) + (c2 >> 3) * 72 + (c2 & 7) * 8; }
        else { const int c2 = (c - 3584) & 255; dst = (LAS bf16_t*)(buf + GS_UB) + (c2 >> 2) * 32 + (c2 & 3) * 8; }
        if (k < 7 || tid < 256) *(LAS u32x4*)dst = v[k]; }
}
__device__ __forceinline__ void gdn_scan_step(LAS unsigned char* buf, LAS bf16_t* ST, LAS bf16_t* VnT, f32x4 (&sacc)[2], float gl, bf16_t* gop, int wave, int fr, int fq) {
    const int d0 = wave * 16, ti = wave >> 1, te = wave & 1, i0 = ti * 16, e0 = te * 16;
#pragma unroll
    for (int et = 0; et < 2; ++et)
#pragma unroll
        for (int jj = 0; jj < 4; ++jj) ST[(16 * et + 4 * fq + jj) * 136 + d0 + fr] = (bf16_t)f2bf(sacc[et][jj]);
    WG_SYNC();
    f32x4 accv = (f32x4){0.f, 0.f, 0.f, 0.f}, acco = accv;
    accv = mm16((const LAS bf16_t*)(buf + GS_WB) + i0 * 136, 136, ST + e0 * 136, 136, 128, accv, fr, fq);
    acco = mm16((const LAS bf16_t*)(buf + GS_QB) + i0 * 136, 136, ST + e0 * 136, 136, 128, acco, fr, fq);
    { const u32x2 uu = *(const LAS u32x2*)((const LAS bf16_t*)(buf + GS_UB) + (i0 + fr) * 32 + e0 + 4 * fq);
      const float u0 = bf2f(uu.x & 0xffffu), u1 = __uint_as_float(uu.x & 0xffff0000u), u2 = bf2f(uu.y & 0xffffu), u3 = __uint_as_float(uu.y & 0xffff0000u);
      accv[0] = u0 - accv[0]; accv[1] = u1 - accv[1]; accv[2] = u2 - accv[2]; accv[3] = u3 - accv[3]; }
#pragma unroll
    for (int jj = 0; jj < 4; ++jj) VnT[(e0 + 4 * fq + jj) * 72 + i0 + fr] = (bf16_t)f2bf(accv[jj]);
    WG_SYNC();
    acco = mm16((const LAS bf16_t*)(buf + GS_AT) + i0 * 72, 72, VnT + e0 * 72, 72, 64, acco, fr, fq);
    { u32x2 w; w.x = pk2(acco[0], acco[1]); w.y = pk2(acco[2], acco[3]); *(u32x2*)(gop + (size_t)(i0 + fr) * 768 + e0 + 4 * fq) = w; }
#pragma unroll
    for (int et = 0; et < 2; ++et) { sacc[et] = sacc[et] * gl;
        sacc[et] = mm16((const LAS bf16_t*)(buf + GS_KT) + d0 * 72, 72, VnT + 16 * et * 72, 72, 64, sacc[et], fr, fq); }
}
__device__ __forceinline__ void gdn_scan_unit(const KPV& p, int unit, LAS unsigned char* lds, int tid, int wave, int lane) {
    const int bh = unit >> 2, es = unit & 3, b = bh / 6, h = bh % 6;
    const unsigned char* gt0 = p.ws() + WS_GT + (size_t)bh * NCH * GT_UNIT;
    const float* GL = (const float*)(p.ws() + WS_GL) + bh * NCH;
    bf16_t* GO = (bf16_t*)(p.ws() + WS_GO) + (size_t)(b * SEQ) * 768 + h * 128 + es * 32;
    const int fr = lane & 15, fq = lane >> 4;
    LAS bf16_t* ST = (LAS bf16_t*)(lds + GS_ST); LAS bf16_t* VnT = (LAS bf16_t*)(lds + GS_VNT);
    u32x4 pa[8], pb[8];
    gs_load(gt0, es, tid, pa); gs_store(lds, tid, pa);
    gs_load(gt0 + (size_t)GT_UNIT, es, tid, pa);
    LAS float* GLs = (LAS float*)(lds + GS_VNT + 4608);
    if (tid < 32) GLs[tid] = GL[tid];
    f32x4 sacc[2]; sacc[0] = (f32x4){0.f, 0.f, 0.f, 0.f}; sacc[1] = sacc[0];
#pragma unroll 1
    for (int n = 0; n < NCH; n += 2) {
        if (n + 2 < NCH) gs_load(gt0 + (size_t)(n + 2) * GT_UNIT, es, tid, pb);
        gdn_scan_step(lds, ST, VnT, sacc, GLs[n], GO + (size_t)(n * CH) * 768, wave, fr, fq);
        gs_store(lds + GS_BUF, tid, pa);
        if (n + 3 < NCH) gs_load(gt0 + (size_t)(n + 3) * GT_UNIT, es, tid, pa);
        gdn_scan_step(lds + GS_BUF, ST, VnT, sacc, GLs[n + 1], GO + (size_t)((n + 1) * CH) * 768, wave, fr, fq);
        if (n + 2 < NCH) gs_store(lds, tid, pb);
    }
    WG_SYNC();
}

constexpr int S_RAWC = 0, S_RAWB = 17152, S_RAWX = 34304;
constexpr int S_CS = 42880, S_BS = 60288, S_SP = 77696;
constexpr int S_XDT = 95104, S_XSN = 104320, S_MS = 113536;
constexpr int S_F = 122752;
template <int W16, int NI>
__device__ __forceinline__ void ssd_raw_ld(const bf16_t* proj, int tok0, int n, int col, int tid, u32x4 (&v)[NI]) {
#pragma unroll
    for (int k = 0; k < NI; ++k) { const int c = tid + 512 * k, r = c / W16, ch = c % W16; v[k] = (u32x4){0u, 0u, 0u, 0u};
        if (c < 67 * W16 && (n > 0 || r >= 3)) v[k] = *(const u32x4*)(proj + (size_t)(tok0 + r - 3) * PINP + col + ch * 8); }
}
template <int W16, int NI>
__device__ __forceinline__ void ssd_raw_st(LAS bf16_t* dst, int tid, const u32x4 (&v)[NI]) {
#pragma unroll
    for (int k = 0; k < NI; ++k) { const int c = tid + 512 * k, r = c / W16, ch = c % W16;
        if (c < 67 * W16) *(LAS u32x4*)(dst + r * (W16 * 8) + ch * 8) = v[k]; }
}
__device__ __forceinline__ void ssd_conv8(const LAS bf16_t* raw, int rs, int tok, int ch0, const float* cw, const float* cb, int cidx, float* out) {
    const f32x4 b0 = *(const f32x4*)(cb + cidx), b1 = *(const f32x4*)(cb + cidx + 4);
    out[0] = b0.x; out[1] = b0.y; out[2] = b0.z; out[3] = b0.w; out[4] = b1.x; out[5] = b1.y; out[6] = b1.z; out[7] = b1.w;
#pragma unroll
    for (int tap = 0; tap < 4; ++tap) { float x[8]; unpack8(*(const LAS u32x4*)(raw + (tok + tap) * rs + ch0), x);
        const f32x4 w0 = *(const f32x4*)(cw + tap * 1280 + cidx), w1 = *(const f32x4*)(cw + tap * 1280 + cidx + 4);
        out[0] += w0.x * x[0]; out[1] += w0.y * x[1]; out[2] += w0.z * x[2]; out[3] += w0.w * x[3]; out[4] += w1.x * x[4]; out[5] += w1.y * x[5]; out[6] += w1.z * x[6]; out[7] += w1.w * x[7]; }
#pragma unroll
    for (int i = 0; i < 8; ++i) out[i] = fsilu(out[i]);
}
__device__ __forceinline__ void ssd_gates(const KPV& p, int layer, const bf16_t* proj, int tok0, int h, LAS float* F, int lane) {
    const float dtr = bf2f(proj[(size_t)(tok0 + lane) * PINP + PSDT + h]);
    const float dt = fsoftplus(dtr + p.in(14)[layer * 12 + h]);
    const float a = -expf(p.in(13)[layer * 12 + h]) * dt;
    F[lane] = wave_incl_scan(a, lane); F[64 + lane] = dt;
}
__device__ __forceinline__ void ssd_pre_unit(const KPV& p, int layer, int unit, LAS unsigned char* lds, int tid, int wave, int lane) {
    const int b = unit / (NCH * 12), n = (unit / 12) % NCH, h = unit % 12, g = h / 6;
    const int tok0 = b * SEQ + n * CH; const int u3 = (b * 12 + h) * NCH + n;
    const bf16_t* proj = (const bf16_t*)(p.ws() + WS_AP);
    LAS bf16_t* rawB = (LAS bf16_t*)(lds + S_RAWB); LAS bf16_t* rawX = (LAS bf16_t*)(lds + S_RAWX);
    LAS bf16_t* BT = (LAS bf16_t*)(lds + S_BS); LAS bf16_t* XdT = (LAS bf16_t*)(lds + S_XDT); LAS float* F = (LAS float*)(lds + S_F);
    { u32x4 vb[3], vx[2];
      ssd_raw_ld<16, 3>(proj, tok0, n, PSB + g * 128, tid, vb); ssd_raw_ld<8, 2>(proj, tok0, n, PSX + h * 64, tid, vx);
      if (wave == 0) ssd_gates(p, layer, proj, tok0, h, F, lane);
      ssd_raw_st<16, 3>(rawB, tid, vb); ssd_raw_st<8, 2>(rawX, tid, vx); }
    WG_SYNC();
    { const float* cw = p.in(11) + (size_t)layer * 4 * 1280; const float* cb = p.in(12) + (size_t)layer * 1280;
      const int tok = tid >> 3, sub = tid & 7; float o[8];
#pragma unroll
      for (int half = 0; half < 2; ++half) { const int ch0 = sub * 16 + half * 8;
          ssd_conv8(rawB, 128, tok, ch0, cw, cb, 768 + g * 128 + ch0, o);
#pragma unroll
          for (int i = 0; i < 8; ++i) BT[(ch0 + i) * 72 + tok] = (bf16_t)f2bf(o[i]); }
      const float sc = F[64 + tok] * expf(F[63] - F[tok]);
      ssd_conv8(rawX, 64, tok, sub * 8, cw, cb, h * 64 + sub * 8, o);
#pragma unroll
      for (int i = 0; i < 8; ++i) XdT[(sub * 8 + i) * 72 + tok] = (bf16_t)f2bf(o[i] * sc);
    }
    WG_SYNC();
    { const int fr = lane & 15, fq = lane >> 4; bf16_t* st = (bf16_t*)(p.ws() + WS_ST) + (size_t)u3 * 8192;
      for (int job = wave * 4; job < wave * 4 + 4; ++job) { const int pt = job >> 3, kt = job & 7;
          f32x4 acc = (f32x4){0.f, 0.f, 0.f, 0.f};
          acc = mm16(XdT + pt * 16 * 72, 72, BT + kt * 16 * 72, 72, 64, acc, fr, fq);
          u32x2 w; w.x = pk2(acc[0], acc[1]); w.y = pk2(acc[2], acc[3]);
          *(u32x2*)(st + (pt * 16 + fr) * 128 + kt * 16 + 4 * fq) = w; }
      if (tid == 0) ((float*)(p.ws() + WS_CD))[u3] = expf(F[63]);
    }
    WG_SYNC();
}
__device__ __forceinline__ void ssd_scan_items(const KPV& p, int first, int stride) {
    bf16_t* st = (bf16_t*)(p.ws() + WS_ST); const float* CD = (const float*)(p.ws() + WS_CD);
    for (int it = first; it < 96 * 1024; it += stride) { const int bh = it >> 10, vec = it & 1023;
        float S[8];
#pragma unroll
        for (int i = 0; i < 8; ++i) S[i] = 0.f;
        u32x4* base = (u32x4*)(st + ((size_t)bh * NCH * 8192 + vec * 8));
#pragma unroll 1
        for (int n0 = 0; n0 < NCH; n0 += 8) { u32x4 v[8]; float cd[8];
#pragma unroll
            for (int k = 0; k < 8; ++k) { v[k] = base[(size_t)(n0 + k) * 1024]; cd[k] = CD[bh * NCH + n0 + k]; }
#pragma unroll
            for (int k = 0; k < 8; ++k) { float x[8]; unpack8(v[k], x);
                u32x4 o; o.x = pk2(S[0], S[1]); o.y = pk2(S[2], S[3]); o.z = pk2(S[4], S[5]); o.w = pk2(S[6], S[7]); base[(size_t)(n0 + k) * 1024] = o;
#pragma unroll
                for (int i = 0; i < 8; ++i) S[i] = S[i] * cd[k] + x[i]; } }
    }
}
__device__ __forceinline__ void ssd_out_unit(const KPV& p, int layer, int unit, LAS unsigned char* lds, int tid, int wave, int lane) {
    const int b = unit / (NCH * 12), n = (unit / 12) % NCH, h = unit % 12, g = h / 6;
    const int tok0 = b * SEQ + n * CH; const int u3 = (b * 12 + h) * NCH + n;
    const bf16_t* proj = (const bf16_t*)(p.ws() + WS_AP);
    LAS bf16_t* rawC = (LAS bf16_t*)(lds + S_RAWC); LAS bf16_t* rawB = (LAS bf16_t*)(lds + S_RAWB); LAS bf16_t* rawX = (LAS bf16_t*)(lds + S_RAWX);
    LAS bf16_t* Cs = (LAS bf16_t*)(lds + S_CS); LAS bf16_t* Bs = (LAS bf16_t*)(lds + S_BS); LAS bf16_t* Sp = (LAS bf16_t*)(lds + S_SP);
    LAS bf16_t* XdT = (LAS bf16_t*)(lds + S_XDT); LAS bf16_t* XsN = (LAS bf16_t*)(lds + S_XSN); LAS bf16_t* Ms = (LAS bf16_t*)(lds + S_MS); LAS float* F = (LAS float*)(lds + S_F);
    { u32x4 vc[3], vb[3], vx[2], vs[2]; const bf16_t* st = (const bf16_t*)(p.ws() + WS_ST) + (size_t)u3 * 8192;
      ssd_raw_ld<16, 3>(proj, tok0, n, PSC + g * 128, tid, vc); ssd_raw_ld<16, 3>(proj, tok0, n, PSB + g * 128, tid, vb); ssd_raw_ld<8, 2>(proj, tok0, n, PSX + h * 64, tid, vx);
#pragma unroll
      for (int k = 0; k < 2; ++k) { const int c = tid + 512 * k; vs[k] = *(const u32x4*)(st + (c >> 4) * 128 + (c & 15) * 8); }
      if (wave == 0) ssd_gates(p, layer, proj, tok0, h, F, lane);
      ssd_raw_st<16, 3>(rawC, tid, vc); ssd_raw_st<16, 3>(rawB, tid, vb); ssd_raw_st<8, 2>(rawX, tid, vx);
#pragma unroll
      for (int k = 0; k < 2; ++k) { const int c = tid + 512 * k; *(LAS u32x4*)(Sp + (c >> 4) * 136 + (c & 15) * 8) = vs[k]; } }
    WG_SYNC();
    { const float* cw = p.in(11) + (size_t)layer * 4 * 1280; const float* cb = p.in(12) + (size_t)layer * 1280;
      const int tok = tid >> 3, sub = tid & 7; float o[8];
#pragma unroll
      for (int half = 0; half < 2; ++half) { const int ch0 = sub * 16 + half * 8; u32x4 w;
          ssd_conv8(rawC, 128, tok, ch0, cw, cb, 1024 + g * 128 + ch0, o);
          w.x = pk2(o[0], o[1]); w.y = pk2(o[2], o[3]); w.z = pk2(o[4], o[5]); w.w = pk2(o[6], o[7]); *(LAS u32x4*)(Cs + tok * 136 + ch0) = w;
          ssd_conv8(rawB, 128, tok, ch0, cw, cb, 768 + g * 128 + ch0, o);
          w.x = pk2(o[0], o[1]); w.y = pk2(o[2], o[3]); w.z = pk2(o[4], o[5]); w.w = pk2(o[6], o[7]); *(LAS u32x4*)(Bs + tok * 136 + ch0) = w; }
      const float dt = F[64 + tok];
      ssd_conv8(rawX, 64, tok, sub * 8, cw, cb, h * 64 + sub * 8, o);
      { u32x4 w; w.x = pk2(o[0], o[1]); w.y = pk2(o[2], o[3]); w.z = pk2(o[4], o[5]); w.w = pk2(o[6], o[7]); *(LAS u32x4*)(XsN + tok * 72 + sub * 8) = w; }
#pragma unroll
      for (int i = 0; i < 8; ++i) XdT[(sub * 8 + i) * 72 + tok] = (bf16_t)f2bf(o[i] * dt);
    }
    WG_SYNC();
    const int fr = lane & 15, fq = lane >> 4;
    for (int t = wave * 2; t < wave * 2 + 2; ++t) { const int ti = t >> 2, tj = t & 3;
        f32x4 acc = (f32x4){0.f, 0.f, 0.f, 0.f};
        acc = mm16(Cs + ti * 16 * 136, 136, Bs + tj * 16 * 136, 136, 128, acc, fr, fq);
        const int i = ti * 16 + fr, j0 = tj * 16 + 4 * fq; const float ai = F[i]; float o[4];
#pragma unroll
        for (int jj = 0; jj < 4; ++jj) o[jj] = (i >= j0 + jj) ? acc[jj] * expf(ai - F[j0 + jj]) : 0.f;
        u32x2 w; w.x = pk2(o[0], o[1]); w.y = pk2(o[2], o[3]); *(LAS u32x2*)(Ms + i * 72 + j0) = w; }
    WG_SYNC();
    { const float Dh = p.in(15)[layer * 12 + h]; float* YS = (float*)(p.ws() + WS_XN);
      for (int t = wave * 2; t < wave * 2 + 2; ++t) { const int ti = t >> 2, tp = t & 3;
          f32x4 yd = (f32x4){0.f, 0.f, 0.f, 0.f}, yo = yd;
          yd = mm16(Ms + ti * 16 * 72, 72, XdT + tp * 16 * 72, 72, 64, yd, fr, fq);
          yo = mm16(Cs + ti * 16 * 136, 136, Sp + tp * 16 * 136, 136, 128, yo, fr, fq);
          const int i = ti * 16 + fr, p0 = tp * 16 + 4 * fq; const float ea = expf(F[i]);
          const u32x2 xv = *(const LAS u32x2*)(XsN + i * 72 + p0);
          const u32x2 zv = *(const u32x2*)(proj + (size_t)(tok0 + i) * PINP + PSZ + h * 64 + p0);
          const float xs0 = bf2f(xv.x & 0xffffu), xs1 = __uint_as_float(xv.x & 0xffff0000u), xs2 = bf2f(xv.y & 0xffffu), xs3 = __uint_as_float(xv.y & 0xffff0000u);
          const float z0 = bf2f(zv.x & 0xffffu), z1 = __uint_as_float(zv.x & 0xffff0000u), z2 = bf2f(zv.y & 0xffffu), z3 = __uint_as_float(zv.y & 0xffff0000u);
          f32x4 y; y.x = (yd[0] + yo[0] * ea + Dh * xs0) * fsilu(z0); y.y = (yd[1] + yo[1] * ea + Dh * xs1) * fsilu(z1);
          y.z = (yd[2] + yo[2] * ea + Dh * xs2) * fsilu(z2); y.w = (yd[3] + yo[3] * ea + Dh * xs3) * fsilu(z3);
          *(f32x4*)(YS + (size_t)(tok0 + i) * 768 + h * 64 + p0) = y; }
    }
    WG_SYNC();
}

__device__ __forceinline__ void ssd_gates6(const KPV& p, int layer, const bf16_t* proj, int tok0, int g, LAS float* F, int wave, int lane) {
    if (wave < 6) { const int h = g * 6 + wave;
        const float dtr = bf2f(proj[(size_t)(tok0 + lane) * PINP + PSDT + h]);
        const float dt = fsoftplus(dtr + p.in(14)[layer * 12 + h]);
        const float a = -expf(p.in(13)[layer * 12 + h]) * dt;
        F[wave * 64 + lane] = wave_incl_scan(a, lane); F[384 + wave * 64 + lane] = dt; }
}
constexpr int SG_RAWB = 0, SG_RAWX = 17152, SG_BT = 68608, SG_XDT = 87040, SG_F = 142336;
__device__ __forceinline__ void ssd_pre_g(const KPV& p, int layer, int unit, LAS unsigned char* lds, int tid, int wave, int lane) {
    const int b = unit / (NCH * 2), n = (unit >> 1) % NCH, g = unit & 1;
    const int tok0 = b * SEQ + n * CH;
    const bf16_t* proj = (const bf16_t*)(p.ws() + WS_AP);
    LAS bf16_t* rawB = (LAS bf16_t*)(lds + SG_RAWB); LAS bf16_t* rawX = (LAS bf16_t*)(lds + SG_RAWX);
    LAS bf16_t* BT = (LAS bf16_t*)(lds + SG_BT); LAS bf16_t* XdT = (LAS bf16_t*)(lds + SG_XDT); LAS float* F = (LAS float*)(lds + SG_F);
    { u32x4 vb[3], vx[7];
      ssd_raw_ld<16, 3>(proj, tok0, n, PSB + g * 128, tid, vb); ssd_raw_ld<48, 7>(proj, tok0, n, PSX + g * 384, tid, vx);
      ssd_gates6(p, layer, proj, tok0, g, F, wave, lane);
      ssd_raw_st<16, 3>(rawB, tid, vb); ssd_raw_st<48, 7>(rawX, tid, vx); }
    WG_SYNC();
    { const float* cw = p.in(11) + (size_t)layer * 4 * 1280; const float* cb = p.in(12) + (size_t)layer * 1280;
      const int tok = tid >> 3, sub = tid & 7; float o[8];
#pragma unroll
      for (int half = 0; half < 2; ++half) { const int ch0 = sub * 16 + half * 8;
          ssd_conv8(rawB, 128, tok, ch0, cw, cb, 768 + g * 128 + ch0, o);
#pragma unroll
          for (int i = 0; i < 8; ++i) BT[(ch0 + i) * 72 + tok] = (bf16_t)f2bf(o[i]); }
#pragma unroll 1
      for (int hh = 0; hh < 6; ++hh) { const float sc = F[384 + hh * 64 + tok] * expf(F[hh * 64 + 63] - F[hh * 64 + tok]);
          ssd_conv8(rawX, 384, tok, hh * 64 + sub * 8, cw, cb, (g * 6 + hh) * 64 + sub * 8, o);
#pragma unroll
          for (int i = 0; i < 8; ++i) XdT[(hh * 64 + sub * 8 + i) * 72 + tok] = (bf16_t)f2bf(o[i] * sc); }
    }
    WG_SYNC();
    { const int fr = lane & 15, fq = lane >> 4; bf16_t* stb = (bf16_t*)(p.ws() + WS_ST);
      for (int job = wave * 24; job < wave * 24 + 24; ++job) { const int hh = job >> 5, pt = (job >> 3) & 3, kt = job & 7;
          f32x4 acc = (f32x4){0.f, 0.f, 0.f, 0.f};
          acc = mm16(XdT + (hh * 64 + pt * 16) * 72, 72, BT + kt * 16 * 72, 72, 64, acc, fr, fq);
          u32x2 w; w.x = pk2(acc[0], acc[1]); w.y = pk2(acc[2], acc[3]);
          *(u32x2*)(stb + (size_t)((b * 12 + g * 6 + hh) * NCH + n) * 8192 + (pt * 16 + fr) * 128 + kt * 16 + 4 * fq) = w; }
      if (tid < 6) ((float*)(p.ws() + WS_CD))[(b * 12 + g * 6 + tid) * NCH + n] = expf(F[tid * 64 + 63]);
    }
    WG_SYNC();
}
constexpr int OG_RAWC = 0, OG_RAWB = 17152, OG_RAWX = 34304, OG_CS = 85760, OG_BS = 103168, OG_XDT = 120576, OG_XSN = 129792, OG_F = 139008, OG_SP = 0, OG_MS = 17408;
__device__ __forceinline__ void ssd_out_g(const KPV& p, int layer, int unit, LAS unsigned char* lds, int tid, int wave, int lane) {
    const int b = unit / (NCH * 2), n = (unit >> 1) % NCH, g = unit & 1;
    const int tok0 = b * SEQ + n * CH;
    const bf16_t* proj = (const bf16_t*)(p.ws() + WS_AP);
    LAS bf16_t* rawC = (LAS bf16_t*)(lds + OG_RAWC); LAS bf16_t* rawB = (LAS bf16_t*)(lds + OG_RAWB); LAS bf16_t* rawX = (LAS bf16_t*)(lds + OG_RAWX);
    LAS bf16_t* Cs = (LAS bf16_t*)(lds + OG_CS); LAS bf16_t* Bs = (LAS bf16_t*)(lds + OG_BS); LAS bf16_t* Sp = (LAS bf16_t*)(lds + OG_SP);
    LAS bf16_t* XdT = (LAS bf16_t*)(lds + OG_XDT); LAS bf16_t* XsN = (LAS bf16_t*)(lds + OG_XSN); LAS bf16_t* Ms = (LAS bf16_t*)(lds + OG_MS); LAS float* F = (LAS float*)(lds + OG_F);
    const float* cw = p.in(11) + (size_t)layer * 4 * 1280; const float* cb = p.in(12) + (size_t)layer * 1280;
    const int tok = tid >> 3, sub = tid & 7, fr = lane & 15, fq = lane >> 4;
    { u32x4 vc[3], vb[3], vx[7];
      ssd_raw_ld<16, 3>(proj, tok0, n, PSC + g * 128, tid, vc); ssd_raw_ld<16, 3>(proj, tok0, n, PSB + g * 128, tid, vb); ssd_raw_ld<48, 7>(proj, tok0, n, PSX + g * 384, tid, vx);
      ssd_gates6(p, layer, proj, tok0, g, F, wave, lane);
      ssd_raw_st<16, 3>(rawC, tid, vc); ssd_raw_st<16, 3>(rawB, tid, vb); ssd_raw_st<48, 7>(rawX, tid, vx); }
    WG_SYNC();
    { float o[8];
#pragma unroll
      for (int half = 0; half < 2; ++half) { const int ch0 = sub * 16 + half * 8; u32x4 w;
          ssd_conv8(rawC, 128, tok, ch0, cw, cb, 1024 + g * 128 + ch0, o);
          w.x = pk2(o[0], o[1]); w.y = pk2(o[2], o[3]); w.z = pk2(o[4], o[5]); w.w = pk2(o[6], o[7]); *(LAS u32x4*)(Cs + tok * 136 + ch0) = w;
          ssd_conv8(rawB, 128, tok, ch0, cw, cb, 768 + g * 128 + ch0, o);
          w.x = pk2(o[0], o[1]); w.y = pk2(o[2], o[3]); w.z = pk2(o[4], o[5]); w.w = pk2(o[6], o[7]); *(LAS u32x4*)(Bs + tok * 136 + ch0) = w; } }
    WG_SYNC();
    f32x4 cbt[2];
#pragma unroll
    for (int q = 0; q < 2; ++q) { const int t = wave * 2 + q, ti = t >> 2, tj = t & 3; cbt[q] = (f32x4){0.f, 0.f, 0.f, 0.f};
        cbt[q] = mm16(Cs + ti * 16 * 136, 136, Bs + tj * 16 * 136, 136, 128, cbt[q], fr, fq); }
    const bf16_t* stb = (const bf16_t*)(p.ws() + WS_ST); float* YS = (float*)(p.ws() + WS_XN);
    u32x4 vs[2];
#pragma unroll
    for (int k = 0; k < 2; ++k) { const int c = tid + 512 * k; vs[k] = *(const u32x4*)(stb + (size_t)((b * 12 + g * 6) * NCH + n) * 8192 + (c >> 4) * 128 + (c & 15) * 8); }
#pragma unroll 1
    for (int hh = 0; hh < 6; ++hh) { const int h = g * 6 + hh;
#pragma unroll
        for (int k = 0; k < 2; ++k) { const int c = tid + 512 * k; *(LAS u32x4*)(Sp + (c >> 4) * 136 + (c & 15) * 8) = vs[k]; }
        if (hh + 1 < 6) {
#pragma unroll
            for (int k = 0; k < 2; ++k) { const int c = tid + 512 * k; vs[k] = *(const u32x4*)(stb + (size_t)((b * 12 + h + 1) * NCH + n) * 8192 + (c >> 4) * 128 + (c & 15) * 8); } }
        u32x2 zv[2];
#pragma unroll
        for (int q = 0; q < 2; ++q) { const int t = wave * 2 + q, ti = t >> 2, tp = t & 3; zv[q] = *(const u32x2*)(proj + (size_t)(tok0 + ti * 16 + fr) * PINP + PSZ + h * 64 + tp * 16 + 4 * fq); }
        { float o[8]; const float dt = F[384 + hh * 64 + tok];
          ssd_conv8(rawX, 384, tok, hh * 64 + sub * 8, cw, cb, h * 64 + sub * 8, o);
          u32x4 w; w.x = pk2(o[0], o[1]); w.y = pk2(o[2], o[3]); w.z = pk2(o[4], o[5]); w.w = pk2(o[6], o[7]); *(LAS u32x4*)(XsN + tok * 72 + sub * 8) = w;
#pragma unroll
          for (int i = 0; i < 8; ++i) XdT[(sub * 8 + i) * 72 + tok] = (bf16_t)f2bf(o[i] * dt); }
#pragma unroll
        for (int q = 0; q < 2; ++q) { const int t = wave * 2 + q, ti = t >> 2, tj = t & 3, i = ti * 16 + fr, j0 = tj * 16 + 4 * fq; const float ai = F[hh * 64 + i]; float o[4];
#pragma unroll
            for (int jj = 0; jj < 4; ++jj) o[jj] = (i >= j0 + jj) ? cbt[q][jj] * expf(ai - F[hh * 64 + j0 + jj]) : 0.f;
            u32x2 w; w.x = pk2(o[0], o[1]); w.y = pk2(o[2], o[3]); *(LAS u32x2*)(Ms + i * 72 + j0) = w; }
        WG_SYNC();
        { const float Dh = p.in(15)[layer * 12 + h];
#pragma unroll
          for (int q = 0; q < 2; ++q) { const int t = wave * 2 + q, ti = t >> 2, tp = t & 3;
              f32x4 yd = (f32x4){0.f, 0.f, 0.f, 0.f}, yo = yd;
              yd = mm16(Ms + ti * 16 * 72, 72, XdT + tp * 16 * 72, 72, 64, yd, fr, fq);
              yo = mm16(Cs + ti * 16 * 136, 136, Sp + tp * 16 * 136, 136, 128, yo, fr, fq);
              const int i = ti * 16 + fr, p0 = tp * 16 + 4 * fq; const float ea = expf(F[hh * 64 + i]);
              const u32x2 xv = *(const LAS u32x2*)(XsN + i * 72 + p0); const u32x2 z2 = zv[q];
              const float xs0 = bf2f(xv.x & 0xffffu), xs1 = __uint_as_float(xv.x & 0xffff0000u), xs2 = bf2f(xv.y & 0xffffu), xs3 = __uint_as_float(xv.y & 0xffff0000u);
              const float z0 = bf2f(z2.x & 0xffffu), z1 = __uint_as_float(z2.x & 0xffff0000u), z2f = bf2f(z2.y & 0xffffu), z3 = __uint_as_float(z2.y & 0xffff0000u);
              f32x4 y; y.x = (yd[0] + yo[0] * ea + Dh * xs0) * fsilu(z0); y.y = (yd[1] + yo[1] * ea + Dh * xs1) * fsilu(z1);
              y.z = (yd[2] + yo[2] * ea + Dh * xs2) * fsilu(z2f); y.w = (yd[3] + yo[3] * ea + Dh * xs3) * fsilu(z3);
              *(f32x4*)(YS + (size_t)(tok0 + i) * 768 + h * 64 + p0) = y; }
        }
        WG_SYNC();
    }
}

constexpr int S5_WAVE_LDS = 12800, S5P2_WAVE_LDS = 17152;
struct S5Par { float abr, abi; float bbr[16], bbi[16]; };
__device__ __forceinline__ void s5_params(const KPV& p, int layer, int g, int n, S5Par& P) {
    const int gi = (layer * 32 + g) * 64 + n;
    const float are = p.in(17)[gi], aim = p.in(18)[gi], delta = expf(p.in(24)[layer * 32 + g]);
    const float mag = expf(are * delta); float sn, cs; sincosf(aim * delta, &sn, &cs);
    P.abr = mag * cs; P.abi = mag * sn;
    const float den = are * are + aim * aim, pre = P.abr - 1.f, pim = P.abi;
    const float fre = (pre * are + pim * aim) / den, fim = (pim * are - pre * aim) / den;
    const float* br = p.in(19) + (size_t)gi * 16; const float* bi = p.in(20) + (size_t)gi * 16;
#pragma unroll
    for (int i4 = 0; i4 < 4; ++i4) { const f32x4 r = *(const f32x4*)(br + 4 * i4), im = *(const f32x4*)(bi + 4 * i4);
#pragma unroll
        for (int j = 0; j < 4; ++j) { P.bbr[4 * i4 + j] = fre * r[j] - fim * im[j]; P.bbi[4 * i4 + j] = fre * im[j] + fim * r[j]; } }
}
__device__ __forceinline__ void s5_load_u(const bf16_t* proj, int tok0, int g, LAS float* Us, int lane) {
    const bf16_t* src = proj + (size_t)(tok0 + lane) * PINP + PU + g * 16;
    float x[16]; unpack8(*(const u32x4*)src, x); unpack8(*(const u32x4*)(src + 8), x + 8);
#pragma unroll
    for (int i4 = 0; i4 < 4; ++i4) *(LAS f32x4*)(Us + lane * 16 + 4 * i4) = (f32x4){x[4 * i4], x[4 * i4 + 1], x[4 * i4 + 2], x[4 * i4 + 3]};
    asm volatile("s_waitcnt lgkmcnt(0)" ::: "memory"); __builtin_amdgcn_wave_barrier();
}
__device__ __forceinline__ void s5_step(const S5Par& P, const LAS float* Us, int t, float& hr, float& hi) {
    float bur = 0.f, bui = 0.f;
#pragma unroll
    for (int i4 = 0; i4 < 4; ++i4) { const f32x4 u = *(const LAS f32x4*)(Us + t * 16 + 4 * i4);
#pragma unroll
        for (int j = 0; j < 4; ++j) { bur += u[j] * P.bbr[4 * i4 + j]; bui += u[j] * P.bbi[4 * i4 + j]; } }
    const float nr = P.abr * hr - P.abi * hi + bur, ni = P.abr * hi + P.abi * hr + bui; hr = nr; hi = ni;
}
__device__ __forceinline__ void s5_pass1(const KPV& p, int layer, int wu, LAS unsigned char* wl, int lane, const S5Par& P) {
    const int b = wu / (NCH * 32), c = (wu / 32) % NCH, g = wu % 32;
    const bf16_t* proj = (const bf16_t*)(p.ws() + WS_AP); LAS float* Us = (LAS float*)wl;
    s5_load_u(proj, b * SEQ + c * CH, g, Us, lane);
    float hr = 0.f, hi = 0.f;
#pragma unroll 4
    for (int t = 0; t < CH; ++t) s5_step(P, Us, t, hr, hi);
    ((f32x2*)(p.ws() + WS_E5))[(size_t)((b * NCH + c) * 32 + g) * 64 + lane] = (f32x2){hr, hi};
    asm volatile("s_waitcnt lgkmcnt(0)" ::: "memory"); __builtin_amdgcn_wave_barrier();
}
__device__ __forceinline__ void s5_shadow_unit(const KPV& p, int layer, int wu, LAS unsigned char* wl, int lane) { S5Par P; s5_params(p, layer, wu & 31, lane, P); s5_pass1(p, layer, wu, wl, lane, P); }
__device__ __forceinline__ float gelu_tanh(float y) { const float x = 0.7978845608028654f * (y + 0.044715f * y * y * y); const float t = 1.f - 2.f / (__expf(2.f * x) + 1.f); return 0.5f * y * (1.f + t); }
__device__ __forceinline__ void s5_setup_c(const KPV& p, int layer, int g, LAS unsigned char* wl, int lane) {
    LAS bf16_t* Cc = (LAS bf16_t*)(wl + 12800);
    const float* cr = p.in(21) + (size_t)(layer * 32 + g) * 16 * 64; const float* ci = p.in(22) + (size_t)(layer * 32 + g) * 16 * 64;
#pragma unroll
    for (int i = 0; i < 16; ++i) *(LAS unsigned*)(Cc + i * 136 + 2 * lane) = pk2(cr[i * 64 + lane], -ci[i * 64 + lane]);
}
struct S5Frag { bf16x8 y[8]; };
__device__ __forceinline__ void s5_bfrag(const KPV& p, int layer, int g, int lane, S5Frag& Fg) {
    const int fr = lane & 15, fq = lane >> 4; const float delta = expf(p.in(24)[layer * 32 + g]);
#pragma unroll
    for (int nt = 0; nt < 8; ++nt) { const int n = nt * 8 + (fr >> 1), gi = (layer * 32 + g) * 64 + n;
        const float are = p.in(17)[gi], aim = p.in(18)[gi]; const float mag = expf(are * delta); float sn, cs; sincosf(aim * delta, &sn, &cs);
        const float abr = mag * cs, abi = mag * sn, den = are * are + aim * aim, pre = abr - 1.f, pim = abi;
        const float fre = (pre * are + pim * aim) / den, fim = (pim * are - pre * aim) / den;
        const float* br = p.in(19) + (size_t)gi * 16 + (fq & 1) * 8; const float* bi = p.in(20) + (size_t)gi * 16 + (fq & 1) * 8;
        const f32x4 r0 = *(const f32x4*)br, r1 = *(const f32x4*)(br + 4), i0 = *(const f32x4*)bi, i1 = *(const f32x4*)(bi + 4);
        f32x4 v0, v1;
        if (fr & 1) { v0 = i0 * fre + r0 * fim; v1 = i1 * fre + r1 * fim; } else { v0 = r0 * fre - i0 * fim; v1 = r1 * fre - i1 * fim; }
        u32x4 w; w.x = pk2(v0[0], v0[1]); w.y = pk2(v0[2], v0[3]); w.z = pk2(v1[0], v1[1]); w.w = pk2(v1[2], v1[3]);
        if (fq >= 2) w = (u32x4){0u, 0u, 0u, 0u};
        Fg.y[nt] = __builtin_bit_cast(bf16x8, w); }
}
__device__ __forceinline__ void s5_pass2(const KPV& p, int layer, int wu, LAS unsigned char* wl, int lane, const S5Par& P, const S5Frag& Fg) {
    const int b = wu / (NCH * 32), c = (wu / 32) % NCH, g = wu % 32;
    const bf16_t* proj = (const bf16_t*)(p.ws() + WS_AP); LAS float* Bu = (LAS float*)wl; LAS bf16_t* Hs = (LAS bf16_t*)(wl + 8448); LAS bf16_t* Cc = (LAS bf16_t*)(wl + 12800);
    const int tok0 = b * SEQ + c * CH, fr = lane & 15, fq = lane >> 4;
    u32x4 xu[4]; u32x2 ud[4];
#pragma unroll
    for (int sb = 0; sb < 4; ++sb) { const bf16_t* row = proj + (size_t)(tok0 + sb * 16 + fr) * PINP + PU + g * 16;
        xu[sb] = (u32x4){0u, 0u, 0u, 0u}; if (fq < 2) xu[sb] = *(const u32x4*)(row + fq * 8);
        ud[sb] = *(const u32x2*)(row + 4 * fq); }
    float a64r = P.abr, a64i = P.abi;
#pragma unroll
    for (int s = 0; s < 6; ++s) { const float r = a64r * a64r - a64i * a64i, i2 = 2.f * a64r * a64i; a64r = r; a64i = i2; }
    float hr = 0.f, hi = 0.f;
    { const f32x2* E = (const f32x2*)(p.ws() + WS_E5) + (size_t)(b * NCH * 32 + g) * 64 + lane;
#pragma unroll 1
      for (int cc0 = 0; cc0 < c; cc0 += 8) { f32x2 e[8];
#pragma unroll
          for (int k = 0; k < 8; ++k) e[k] = (cc0 + k < c) ? E[(size_t)(cc0 + k) * 32 * 64] : (f32x2){0.f, 0.f};
#pragma unroll
          for (int k = 0; k < 8; ++k) if (cc0 + k < c) { const float nr = a64r * hr - a64i * hi + e[k].x, ni = a64r * hi + a64i * hr + e[k].y; hr = nr; hi = ni; } } }
    const f32x4 dsk = *(const f32x4*)(p.in(23) + layer * 512 + g * 16 + 4 * fq);
    bf16_t* G5 = (bf16_t*)(p.ws() + WS_G5);
#pragma unroll
    for (int sb = 0; sb < 4; ++sb) {
        const bf16x8 xf = __builtin_bit_cast(bf16x8, xu[sb]);
#pragma unroll
        for (int nt = 0; nt < 8; ++nt) { f32x4 a = (f32x4){0.f, 0.f, 0.f, 0.f};
            a = __builtin_amdgcn_mfma_f32_16x16x32_bf16(Fg.y[nt], xf, a, 0, 0, 0);
            *(LAS f32x4*)(Bu + fr * 132 + nt * 16 + 4 * fq) = a; }
        asm volatile("s_waitcnt lgkmcnt(0)" ::: "memory"); __builtin_amdgcn_wave_barrier();
#pragma unroll 4
        for (int t = 0; t < 16; ++t) { const f32x2 bu = *(const LAS f32x2*)(Bu + t * 132 + 2 * lane);
            const float nr = P.abr * hr - P.abi * hi + bu.x, ni = P.abr * hi + P.abi * hr + bu.y; hr = nr; hi = ni;
            *(LAS unsigned*)(Hs + t * 136 + 2 * lane) = pk2(hr, hi); }
        asm volatile("s_waitcnt lgkmcnt(0)" ::: "memory"); __builtin_amdgcn_wave_barrier();
        f32x4 acc = (f32x4){0.f, 0.f, 0.f, 0.f};
        acc = mm16(Hs, 136, Cc, 136, 128, acc, fr, fq);
        const float u0 = bf2f(ud[sb].x & 0xffffu), u1 = __uint_as_float(ud[sb].x & 0xffff0000u), u2 = bf2f(ud[sb].y & 0xffffu), u3 = __uint_as_float(ud[sb].y & 0xffff0000u);
        u32x2 w; w.x = pk2(gelu_tanh(acc[0] + dsk.x * u0), gelu_tanh(acc[1] + dsk.y * u1)); w.y = pk2(gelu_tanh(acc[2] + dsk.z * u2), gelu_tanh(acc[3] + dsk.w * u3));
        *(u32x2*)(G5 + (size_t)(tok0 + sb * 16 + fr) * 512 + g * 16 + 4 * fq) = w;
        asm volatile("s_waitcnt lgkmcnt(0)" ::: "memory"); __builtin_amdgcn_wave_barrier();
    }
}

__device__ __forceinline__ void gdn_finish(const KPV& p, int layer, int first, int stride, int lane) {
    const bf16_t* GO = (const bf16_t*)(p.ws() + WS_GO); const bf16_t* proj = (const bf16_t*)(p.ws() + WS_AP); bf16_t* MX = (bf16_t*)(p.ws() + WS_MIX);
    const int l = lane & 31; const f32x4 wv = *(const f32x4*)(p.in(10) + layer * 128 + 4 * l);
    constexpr int NIT = M * 6 / 2;
    for (int it0 = first; it0 < NIT; it0 += 4 * stride) { u32x2 ov[4], zv[4];
#pragma unroll
        for (int k = 0; k < 4; ++k) { const int it = it0 + k * stride; if (it < NIT) { const int th = it * 2 + (lane >> 5), tok = th / 6, h = th % 6;
            ov[k] = *(const u32x2*)(GO + (size_t)tok * 768 + h * 128 + 4 * l); zv[k] = *(const u32x2*)(proj + (size_t)tok * PINP + PZ + h * 128 + 4 * l); } }
#pragma unroll
        for (int k = 0; k < 4; ++k) { const int it = it0 + k * stride; if (it < NIT) { const int th = it * 2 + (lane >> 5), tok = th / 6, h = th % 6;
            const float o0 = bf2f(ov[k].x & 0xffffu), o1 = __uint_as_float(ov[k].x & 0xffff0000u), o2 = bf2f(ov[k].y & 0xffffu), o3 = __uint_as_float(ov[k].y & 0xffff0000u);
            const float z0 = bf2f(zv[k].x & 0xffffu), z1 = __uint_as_float(zv[k].x & 0xffff0000u), z2 = bf2f(zv[k].y & 0xffffu), z3 = __uint_as_float(zv[k].y & 0xffff0000u);
            float ss = (o0 * o0 + o1 * o1) + (o2 * o2 + o3 * o3);
            ss += __shfl_xor(ss, 1); ss += __shfl_xor(ss, 2); ss += __shfl_xor(ss, 4); ss += __shfl_xor(ss, 8); ss += __shfl_xor(ss, 16);
            const float r = rsqrtf(ss * (1.f / 128.f) + EPS);
            u32x2 w; w.x = pk2(o0 * r * wv.x * fsilu(z0), o1 * r * wv.y * fsilu(z1)); w.y = pk2(o2 * r * wv.z * fsilu(z2), o3 * r * wv.w * fsilu(z3));
            *(u32x2*)(MX + (size_t)tok * 2048 + h * 128 + 4 * l) = w; } }
    }
}
__device__ __forceinline__ void ssd_finish(const KPV& p, int layer, int first, int stride, int lane) {
    const float* YS = (const float*)(p.ws() + WS_XN); bf16_t* MX = (bf16_t*)(p.ws() + WS_MIX); const float* nw = p.in(16) + layer * 768;
    for (int it0 = first; it0 < M * 2; it0 += 4 * stride) { f32x2 v[4][3];
#pragma unroll
        for (int k = 0; k < 4; ++k) { const int it = it0 + k * stride; if (it < M * 2) { const float* y = YS + (size_t)(it >> 1) * 768 + (it & 1) * 384;
#pragma unroll
            for (int q = 0; q < 3; ++q) v[k][q] = *(const f32x2*)(y + 2 * lane + 128 * q); } }
#pragma unroll
        for (int k = 0; k < 4; ++k) { const int it = it0 + k * stride; if (it < M * 2) { const int tok = it >> 1, g = it & 1; float ss = 0.f;
#pragma unroll
            for (int q = 0; q < 3; ++q) ss += v[k][q].x * v[k][q].x + v[k][q].y * v[k][q].y;
            const float r = rsqrtf(wave_sum(ss) * (1.f / 384.f) + EPS);
#pragma unroll
            for (int q = 0; q < 3; ++q) { const f32x2 w = *(const f32x2*)(nw + g * 384 + 2 * lane + 128 * q);
                *(unsigned*)(MX + (size_t)tok * 2048 + 768 + g * 384 + 2 * lane + 128 * q) = pk2(v[k][q].x * r * w.x, v[k][q].y * r * w.y); } } }
    }
}

#define XB_TMO      128
#define XB_XCNT(j)  (256  + 64 * (j))
#define XB_XSUB(j)  (1280 + 64 * (j))
#define XB_XGEN(j)  (2304 + 64 * (j))
#define XB_TOP      3328
#define XB_TOPGEN   3392
#define XCD_BAR_WORDS 3456
#define XB_SPIN_CAP (1u << 18)

__device__ __forceinline__ unsigned xb_ld(unsigned* p)              { return __hip_atomic_load(p, __ATOMIC_RELAXED, __HIP_MEMORY_SCOPE_AGENT); }
__device__ __forceinline__ unsigned xb_add(unsigned* p, unsigned v) { return __hip_atomic_fetch_add(p, v, __ATOMIC_RELAXED, __HIP_MEMORY_SCOPE_AGENT); }
__device__ __forceinline__ unsigned xb_xcc_id() { return (unsigned)__builtin_amdgcn_s_getreg((3 << 11) | 20) & 0xFu; }
#define XB_SPIN(cond, bar) do { unsigned _sp = 0; while (cond) { __builtin_amdgcn_s_sleep(1); \
    if ((++_sp & 255u) == 0u) { if (xb_ld(&(bar)[XB_TMO])) break; if (_sp > XB_SPIN_CAP) { atomicAdd(&(bar)[XB_TMO], 1u); break; } } } } while (0)

struct XcdBarrier {
    unsigned* bar; unsigned x;
    volatile LAS unsigned* st;
};

__device__ __forceinline__ XcdBarrier xcd_barrier_post(unsigned* bar, volatile LAS unsigned* st) {
    XcdBarrier b; b.bar = bar; b.x = xb_xcc_id(); b.st = st;
    if (threadIdx.x == 0) (void)xb_add(&bar[XB_XCNT(b.x)], 1u);
    return b;
}
__device__ __forceinline__ void xcd_barrier_complete(unsigned* bar, unsigned x, unsigned& nloc, unsigned& nx) {
    const unsigned G = gridDim.x * gridDim.y * gridDim.z;
    unsigned sum, cnt, mine, sp = 0u;
    for (;;) {
        sum = 0u; cnt = 0u; mine = 0u;
#pragma unroll
        for (unsigned j = 0; j < 16; ++j) { const unsigned c = xb_ld(&bar[XB_XCNT(j)]); sum += c; cnt += (c > 0u) ? 1u : 0u; mine = (j == x) ? c : mine; }
        if (sum == G) break;
        __builtin_amdgcn_s_sleep(1);
        if ((++sp & 255u) == 0u) { if (xb_ld(&bar[XB_TMO])) break; if (sp > XB_SPIN_CAP) { atomicAdd(&bar[XB_TMO], 1u); break; } }
    }
    nloc = mine > 0u ? mine : 1u; nx = cnt > 0u ? cnt : 1u;
}

__device__ __forceinline__ void xcd_barrier(const XcdBarrier& b) {
    asm volatile("s_waitcnt vmcnt(0)" ::: "memory");
    __syncthreads();
    if (threadIdx.x == 0) {
        unsigned* bar = b.bar;
        __builtin_amdgcn_s_waitcnt(0);
        unsigned nloc = b.st[0], nx = b.st[1];
        if (nloc == 0u) { xcd_barrier_complete(bar, b.x, nloc, nx); b.st[0] = nloc; b.st[1] = nx; }
        const unsigned old = xb_add(&bar[XB_XSUB(b.x)], 1u);
        const unsigned gen = old / nloc;
        if (old + 1u == (gen + 1u) * nloc) {
            __builtin_amdgcn_fence(__ATOMIC_RELEASE, "agent");
            asm volatile("s_waitcnt vmcnt(0)" ::: "memory");
            const unsigned og = xb_add(&bar[XB_TOP], 1u);
            const unsigned tg = og / nx;
            if (og + 1u == (tg + 1u) * nx) xb_add(&bar[XB_TOPGEN], 1u);
            else XB_SPIN(xb_ld(&bar[XB_TOPGEN]) == tg, bar);
            __builtin_amdgcn_fence(__ATOMIC_ACQUIRE, "agent");
            xb_add(&bar[XB_XGEN(b.x)], 1u);
            asm volatile("s_waitcnt vmcnt(0)" ::: "memory");
        } else {
            XB_SPIN(xb_ld(&bar[XB_XGEN(b.x)]) == gen, bar);
            __builtin_amdgcn_fence(__ATOMIC_ACQUIRE, "agent");
            asm volatile("s_waitcnt vmcnt(0)" ::: "memory");
        }
    }
    __syncthreads();
}

constexpr int NPH_LAYER = 13, NPHASES = 2 * NPH_LAYER + 1;
template <int PH, int SEL = 7>
__device__ __forceinline__ void run_phase(LAS unsigned char* lds) {
    const AS4 KP* kp_ = (const AS4 KP*)__builtin_amdgcn_kernarg_segment_ptr();
    asm volatile("" : "+s"(kp_));
    const KPV p{kp_};
    int tid = threadIdx.x; asm volatile("" : "+v"(tid));
    int G = gridDim.x, bid = blockIdx.x; asm volatile("" : "+s"(G), "+s"(bid)); const int NGW = G * 8;
    const int lane = tid & 63, wave = __builtin_amdgcn_readfirstlane(tid >> 6), gw = bid * 8 + wave;
    unsigned char* ws = p.ws(); float* hbuf = p.out();
    bf16_t* HB = (bf16_t*)(ws + WS_H); bf16_t* AP = (bf16_t*)(ws + WS_AP); bf16_t* MX = (bf16_t*)(ws + WS_MIX);
    if constexpr (PH == NPHASES - 1) { norm_phase<true>(hbuf, p.in(32), nullptr, p.out(), gw, NGW, lane); return; }
    constexpr int layer = PH / NPH_LAYER, s = PH % NPH_LAYER;
    if constexpr (s == 0) {
        convert_phase(p, layer, lds, gw, NGW, wave, lane);
        if constexpr (layer == 0) { float* SSQ = (float*)(ws + WS_SSQ);
            norm_raw_phase(p.in(0), nullptr, HB, SSQ, gw, NGW, lane); }
    } else if constexpr (s == 1 || s == 11) {
        pg8::Gemm g{HB, (const bf16_t*)(ws + (s == 1 ? WS_WGU1 : WS_WGU2)), M, 2 * FF, D}; pg8::FixedOrder<64, 44> S{G, bid};
        pg8::rstd_table(S, (const float*)(ws + WS_SSQ) + (size_t)(layer * 3 + (s == 1 ? 0 : 2)) * M * 32, (LAS float*)(lds + 131072));
        pg8::EpiSwiGLU E{AP, FF, (const LAS float*)(lds + 131072)};
        pg8::gemm_phase<pg8::EpiSwiGLU, decltype(S), true, true>(lds, g, S, E);
    } else if constexpr (s == 2 || s == 12) {
        pg8::Gemm g{AP, (const bf16_t*)(ws + (s == 2 ? WS_WD1 : WS_WD2)), M, D, FF}; pg8::FixedOrder<64, 8> S{G, bid};
        if constexpr (layer == 1 && s == 12) { pg8::EpiResidOut E{HB, hbuf, D, 0.5f}; pg8::gemm_phase<pg8::EpiResidOut, decltype(S), true, true>(lds, g, S, E); }
        else { pg8::EpiResidH E{(layer == 0 && s == 2 && SEL != 0) ? p.in(0) : nullptr, HB, D, SEL == 0 ? 0.f : 0.5f,
                                (float*)(ws + WS_SSQ) + (size_t)(s == 2 ? layer * 3 + 1 : (layer + 1) * 3) * M * 32};
            pg8::gemm_phase<pg8::EpiResidH, decltype(S), true, true>(lds, g, S, E); }
    } else if constexpr (s == 4) {
        pg8::Gemm g{HB, (const bf16_t*)(ws + WS_WIN), M, PINP, D}; pg8::FixedOrder<64, 23> S{G, bid};
        pg8::rstd_table(S, (const float*)(ws + WS_SSQ) + (size_t)(layer * 3 + 1) * M * 32, (LAS float*)(lds + 131072));
        pg8::EpiBf16 E{AP, PINP, (const LAS float*)(lds + 131072)};
        pg8::gemm_phase<pg8::EpiBf16, decltype(S), true, true>(lds, g, S, E);
    } else if constexpr (s == 5) {
        int s5_done = 0;
        if (SEL & 1) for (int u = bid, it = 0; u < NBATCH * 6 * NCH; u += G, ++it) { int wu = -1;
            if ((SEL & 4) && wave > 0) { const int slot = it * 7 + (wave - 1); const int cand = bid * 8 + (slot & 7) + (slot >> 3) * NGW; if (cand < NBATCH * NCH * 32) wu = cand; }
            gdn_pre_unit(p, layer, u, lds, tid, wave, lane, wu); if (SEL & 4) s5_done = (it + 1) * 7; }
        if (SEL & 2) for (int u = bid; u < NBATCH * NCH * 2; u += G) ssd_pre_g(p, layer, u, lds, tid, wave, lane);
        if (SEL & 4) for (int slot = s5_done + wave; ; slot += 8) { const int wu = bid * 8 + (slot & 7) + (slot >> 3) * NGW; if (wu >= NBATCH * NCH * 32) break;
            s5_shadow_unit(p, layer, wu, lds + wave * S5_WAVE_LDS, lane); }
    } else if constexpr (s == 6) {
        const int NSC = NBATCH * 6 * 4;
        if (SEL & 1) for (int u = bid; u < NSC; u += G) gdn_scan_unit(p, u, lds, tid, wave, lane);
        if (SEL & 2) { if (G > NSC) { if (bid >= NSC) ssd_scan_items(p, (bid - NSC) * 512 + tid, (G - NSC) * 512); }
        else ssd_scan_items(p, bid * 512 + tid, G * 512); }
    } else if constexpr (s == 7) {
        if (SEL & 2) for (int u = bid; u < NBATCH * NCH * 2; u += G) ssd_out_g(p, layer, u, lds, tid, wave, lane);
        if (SEL & 4) { if ((NGW & 31) == 0) { S5Par P; s5_params(p, layer, gw & 31, lane, P); S5Frag Fg; s5_bfrag(p, layer, gw & 31, lane, Fg); s5_setup_c(p, layer, gw & 31, lds + wave * S5P2_WAVE_LDS, lane);
                for (int u = gw; u < NBATCH * NCH * 32; u += NGW) s5_pass2(p, layer, u, lds + wave * S5P2_WAVE_LDS, lane, P, Fg); }
            else for (int u = gw; u < NBATCH * NCH * 32; u += NGW) { S5Par P; s5_params(p, layer, u & 31, lane, P); S5Frag Fg; s5_bfrag(p, layer, u & 31, lane, Fg); s5_setup_c(p, layer, u & 31, lds + wave * S5P2_WAVE_LDS, lane); s5_pass2(p, layer, u, lds + wave * S5P2_WAVE_LDS, lane, P, Fg); } }
    } else if constexpr (s == 8) {
        pg8::Gemm g{(const bf16_t*)(ws + WS_G5), (const bf16_t*)(ws + WS_WGLU), M, 512, 512}; pg8::FixedOrder<64, 2> S{G, bid};
        pg8::EpiGlu E{(const bf16_t*)(ws + WS_G5), 512, MX, 2048, 1536, p.in(26) + layer * 512};
        pg8::gemm_phase<pg8::EpiGlu, decltype(S), true, true>(lds, g, S, E);
        if (G == 256) {
            if (bid < 128) { gdn_finish(p, layer, gw, 4096, lane); ssd_finish(p, layer, gw, 4096, lane); }
            else { const int v0 = 1024 + ((bid - 128) * 8 + wave) * 3;
#pragma unroll 1
                for (int r = 0; r < 3; ++r) gdn_finish(p, layer, v0 + r, 4096, lane);
#pragma unroll 1
                for (int r = 0; r < 3; ++r) ssd_finish(p, layer, v0 + r, 4096, lane); } }
        else { gdn_finish(p, layer, gw, NGW, lane); ssd_finish(p, layer, gw, NGW, lane); }
    } else if constexpr (s == 9) {
        pg8::Gemm g{MX, (const bf16_t*)(ws + WS_WOUT), M, D, D}; pg8::FixedOrder<64, 8> S{G, bid};
        pg8::EpiResidH E{nullptr, HB, D, SEL == 0 ? 0.f : 1.0f, (float*)(ws + WS_SSQ) + (size_t)(layer * 3 + 2) * M * 32};
        pg8::gemm_phase<pg8::EpiResidH, decltype(S), true, true>(lds, g, S, E);
    }
}
__global__ void __launch_bounds__(512) mk_fwd(KP pk) {
    extern __shared__ __attribute__((aligned(16))) unsigned char lds_raw[];
    LAS unsigned char* lds = (LAS unsigned char*)lds_raw;
    const int lo = pk.ph_lo, hi = pk.ph_hi;
    volatile LAS unsigned* xst = (volatile LAS unsigned*)(lds + LDS_BYTES - 64);
    if (threadIdx.x < 2) xst[threadIdx.x] = 0u;
    __syncthreads();
    XcdBarrier xbar = xcd_barrier_post((unsigned*)pk.ws, xst);
    bool first_sync = (pk.ph_hi < 0);
#ifndef DUP_MASK
#define DUP_MASK 0
#endif
#ifndef DUPSEL5
#define DUPSEL5 DUPSEL
#endif
#ifndef DUPSEL
#define DUPSEL 7
#endif
#ifndef DUP_MIXTO
#define DUP_MIXTO 0
#endif
#ifndef EXTRA_SYNCS
#define EXTRA_SYNCS 0
#endif
#define RUN(k) if (lo <= (k) && (k) < hi && (k) % NPH_LAYER != 3 && (k) % NPH_LAYER != 10) { if ((k) > lo) { if (first_sync) { cg::this_grid().sync(); first_sync = false; } else xcd_barrier(xbar); } for (int xs_ = 0; xs_ < EXTRA_SYNCS; ++xs_) xcd_barrier(xbar); run_phase<(k)>(lds); \
        if (((DUP_MASK >> ((k) % NPH_LAYER)) & 1) && (k) < NPHASES - 1) { xcd_barrier(xbar); run_phase<(k), (((k) % NPH_LAYER == 2 || (k) % NPH_LAYER == 9 || (k) % NPH_LAYER == 12) ? 0 : 7)>(lds); } \
        if ((k) % NPH_LAYER == 8 && (k) < NPHASES - 1) { \
            if (DUP_MIXTO >= 5) { cg::this_grid().sync(); run_phase<(k) - 3, DUPSEL5>(lds); } if (DUP_MIXTO >= 6) { cg::this_grid().sync(); run_phase<(k) - 2, DUPSEL>(lds); } \
            if (DUP_MIXTO >= 7) { cg::this_grid().sync(); run_phase<(k) - 1, DUPSEL>(lds); } if (DUP_MIXTO >= 8) { cg::this_grid().sync(); run_phase<(k)>(lds); } } }
    RUN(0) RUN(1) RUN(2) RUN(3) RUN(4) RUN(5) RUN(6) RUN(7) RUN(8) RUN(9) RUN(10) RUN(11) RUN(12)
    RUN(13) RUN(14) RUN(15) RUN(16) RUN(17) RUN(18) RUN(19) RUN(20) RUN(21) RUN(22) RUN(23) RUN(24) RUN(25) RUN(26)
#undef RUN
}

extern "C" void kernel_launch(void* const* d_in, const int* in_sizes, int n_in, void* d_out, int out_size, void* d_ws, size_t ws_size, hipStream_t stream) {
    static int grid = 0;
    if (grid == 0) {
        if (n_in != 33 || in_sizes[0] != M * D || out_size != M * D || ws_size < WS_END) { fprintf(stderr, "kernel_launch: unexpected shapes / workspace (n_in %d, ws %zu < %zu)\n", n_in, ws_size, (size_t)WS_END); grid = -1; return; }
        int dev = 0, cus = 0, per_cu = 0;
        hipGetDevice(&dev); hipDeviceGetAttribute(&cus, hipDeviceAttributeMultiprocessorCount, dev);
        if (hipFuncSetAttribute((const void*)mk_fwd, hipFuncAttributeMaxDynamicSharedMemorySize, LDS_BYTES) != hipSuccess) { fprintf(stderr, "kernel_launch: hipFuncSetAttribute failed\n"); grid = -1; return; }
        if (hipOccupancyMaxActiveBlocksPerMultiprocessor(&per_cu, (const void*)mk_fwd, 512, LDS_BYTES) != hipSuccess || per_cu < 1) { fprintf(stderr, "kernel_launch: occupancy query says %d\n", per_cu); per_cu = 1; }
        (void)hipGetLastError();
        grid = cus;
    }
    if (grid < 0) return;
    if (hipMemsetAsync(d_ws, 0, 16384, stream) != hipSuccess) { fprintf(stderr, "kernel_launch: memset of the barrier words failed\n"); return; }
    KP a{};
    for (int i = 0; i < 33; ++i) a.in[i] = (const float*)d_in[i];
    a.out = (float*)d_out; a.ws = (unsigned char*)d_ws;
#if MK_MULTI
    for (int ph = 0; ph < NPHASES; ++ph) { if (ph % NPH_LAYER == 3 || ph % NPH_LAYER == 10) continue; a.ph_lo = ph; a.ph_hi = ph + 1; hipLaunchKernelGGL(mk_fwd, dim3(grid), dim3(512), LDS_BYTES, stream, a); }
#else
    a.ph_lo = 0; a.ph_hi = NPHASES;
    void* args[] = {&a};
    hipError_t e = hipLaunchCooperativeKernel((const void*)mk_fwd, dim3(grid), dim3(512), args, LDS_BYTES, stream);
    if (e != hipSuccess) fprintf(stderr, "cooperative launch failed: %s (grid %d)\n", hipGetErrorString(e), grid);
#endif
}
```
